# Optimizing an MI355X kernel written in HIP

```python
import math
import jax, jax.numpy as jnp
from jax import lax
import numpy as np

D_MODEL = 1024
BATCH = 8
SEQ = 4096
DEPTH = 2

CHUNK = 64
Q_BLOCK = 128
DSA_Q_BLOCK = 64
ROPE_THETA = 10000.0
HEAD_DIM = 64
LN_EPS = 1e-5
DIFF_HEADS = 4
DIFF_V_DIM = 2 * HEAD_DIM
DSA_HEADS = 8
IDX_HEADS = 4
DSA_TOPK_MAX = 256
IDX_W_SCALE = (IDX_HEADS * HEAD_DIM) ** -0.5
FOX_HEADS = 8
N_BRANCH = 3
BRANCH_WIDTH = 512
N_EXPERTS = 32
N_GROUPS = 4
EXPERTS_PER_GROUP = N_EXPERTS // N_GROUPS
TOP_K = 2
D_EXPERT = 512
MOE_BLOCK = 128
DEEPNORM_ALPHA = (2 * DEPTH) ** 0.25
DEEPNORM_BETA = (8 * DEPTH) ** -0.25
DIFF_QK_WIDTH = DIFF_HEADS * 2 * HEAD_DIM
DIFF_V_WIDTH = DIFF_HEADS * DIFF_V_DIM
DSA_WIDTH = DSA_HEADS * HEAD_DIM
IDX_Q_WIDTH = IDX_HEADS * HEAD_DIM
FOX_WIDTH = FOX_HEADS * HEAD_DIM
IN_SPLITS = (DIFF_QK_WIDTH, DIFF_QK_WIDTH, DIFF_V_WIDTH,
             DSA_WIDTH, DSA_WIDTH, DSA_WIDTH,
             IDX_Q_WIDTH, HEAD_DIM, IDX_HEADS,
             FOX_WIDTH, FOX_WIDTH, FOX_WIDTH, FOX_HEADS,
             N_BRANCH * D_MODEL)
IN_WIDTH = sum(IN_SPLITS)

kernel_name = 'hybrid_diff_dsa_fox_grouped_moe'


def layer_norm(x, g, b):
    xf = x.astype(jnp.float32)
    mu = jnp.mean(xf, axis=-1, keepdims=True)
    var = jnp.mean(jnp.square(xf - mu), axis=-1, keepdims=True)
    return ((xf - mu) * lax.rsqrt(var + LN_EPS) * g + b).astype(x.dtype)


def rms_norm(x, g):
    xf = x.astype(jnp.float32)
    y = xf * lax.rsqrt(jnp.mean(jnp.square(xf), axis=-1, keepdims=True) + LN_EPS)
    return (y * g).astype(x.dtype)


def rope_tables(positions, dim, dtype):
    inv = ROPE_THETA ** (-jnp.arange(0, dim, 2, dtype=jnp.float32) / dim)
    ang = positions.astype(jnp.float32)[..., None] * inv
    return jnp.cos(ang).astype(dtype), jnp.sin(ang).astype(dtype)


def apply_rope(x, cos, sin):
    shp = cos.shape[:2] + (1,) * (x.ndim - 3) + cos.shape[-1:]
    c, s = cos.reshape(shp), sin.reshape(shp)
    half = x.shape[-1] // 2
    x1, x2 = x[..., :half], x[..., half:]
    return jnp.concatenate([x1 * c - x2 * s, x2 * c + x1 * s], axis=-1)


def to_blocks(x, size):
    B, S = x.shape[:2]
    return jnp.moveaxis(x.reshape((B, S // size, size) + x.shape[2:]), 1, 0)


def from_blocks(x):
    x = jnp.moveaxis(x, 0, 1)
    return x.reshape((x.shape[0], x.shape[1] * x.shape[2]) + x.shape[3:])


def chunk_visible(qpos, kpos):
    return kpos[None, :] < (qpos[:, None] // CHUNK + 1) * CHUNK


def diff_attention(q, k, v, lam, norm_g, lam_init):
    B, S = q.shape[:2]
    nb = S // Q_BLOCK
    scale = HEAD_DIM ** -0.5
    kpos = jnp.arange(S)

    def block(args):
        qb, i = args
        vis = chunk_visible(i * Q_BLOCK + jnp.arange(Q_BLOCK), kpos)
        sc = jnp.einsum('bqhmd,bkhmd->bhmqk', qb, k).astype(jnp.float32) * scale
        p = jax.nn.softmax(jnp.where(vis, sc, -jnp.inf), axis=-1)
        a = p[:, :, 0] - lam * p[:, :, 1]
        return jnp.einsum('bhqk,bkhd->bqhd', a.astype(v.dtype), v)

    o = from_blocks(lax.map(block, (to_blocks(q, Q_BLOCK), jnp.arange(nb))))
    o = rms_norm(o, norm_g) * (1.0 - lam_init)
    return o.reshape(B, S, DIFF_V_WIDTH)


def dsa_attention(q, k, v, iq, ik, iw):
    B, S = q.shape[:2]
    topk = min(DSA_TOPK_MAX, S // 4)
    nb = S // DSA_Q_BLOCK
    scale = HEAD_DIM ** -0.5
    kpos = jnp.arange(S)
    gather = jax.vmap(lambda t, idx: t[idx])

    def block(args):
        qb, iqb, iwb, i = args
        vis = chunk_visible(i * DSA_Q_BLOCK + jnp.arange(DSA_Q_BLOCK), kpos)
        logits = jnp.einsum('bqhd,bkd->bqhk', iqb, ik).astype(jnp.float32)
        score = jnp.einsum('bqh,bqhk->bqk', iwb.astype(jnp.float32), jax.nn.relu(logits))
        score = jnp.where(vis, score, -jnp.inf)
        top_val, top_idx = lax.top_k(score, topk)
        valid = jnp.isfinite(top_val)
        kg = gather(k, top_idx)
        vg = gather(v, top_idx)
        sc = jnp.einsum('bqhd,bqkhd->bhqk', qb, kg).astype(jnp.float32) * scale
        p = jax.nn.softmax(jnp.where(valid[:, None], sc, -jnp.inf), axis=-1)
        return jnp.einsum('bhqk,bqkhd->bqhd', p.astype(v.dtype), vg)

    o = lax.map(block, (to_blocks(q, DSA_Q_BLOCK), to_blocks(iq, DSA_Q_BLOCK),
                        to_blocks(iw, DSA_Q_BLOCK), jnp.arange(nb)))
    return from_blocks(o).reshape(B, S, DSA_WIDTH)


def forgetting_attention(q, k, v, log_f):
    B, S = q.shape[:2]
    nb = S // Q_BLOCK
    scale = HEAD_DIM ** -0.5
    kpos = jnp.arange(S)
    c = lax.cumsum(log_f, axis=1)
    cT = jnp.transpose(c, (0, 2, 1))

    def block(args):
        qb, cqb, i = args
        qpos = i * Q_BLOCK + jnp.arange(Q_BLOCK)
        causal = kpos[None, :] <= qpos[:, None]
        sc = jnp.einsum('bqhd,bkhd->bhqk', qb, k).astype(jnp.float32) * scale
        sc = sc + jnp.transpose(cqb, (0, 2, 1))[..., None] - cT[:, :, None, :]
        p = jax.nn.softmax(jnp.where(causal, sc, -jnp.inf), axis=-1)
        return jnp.einsum('bhqk,bkhd->bqhd', p.astype(v.dtype), v)

    o = lax.map(block, (to_blocks(q, Q_BLOCK), to_blocks(c, Q_BLOCK), jnp.arange(nb)))
    return from_blocks(o).reshape(B, S, FOX_WIDTH)


def hybrid_mixer(x, cos, sin, w_in, b_forget, diff_lam, diff_norm_g, w_br, w_o, lam_init):
    B, S, D = x.shape
    z = x @ w_in
    split_at = np.cumsum(IN_SPLITS)[:-1].tolist()
    dq, dk, dv, sq, sk, sv, iq, ik, iw, fq, fk, fv, ff, g = jnp.split(z, split_at, axis=-1)

    dq = apply_rope(dq.reshape(B, S, DIFF_HEADS, 2, HEAD_DIM), cos, sin)
    dk = apply_rope(dk.reshape(B, S, DIFF_HEADS, 2, HEAD_DIM), cos, sin)
    lamf = diff_lam.astype(jnp.float32)
    lam = (jnp.exp(jnp.sum(lamf[0] * lamf[1])) - jnp.exp(jnp.sum(lamf[2] * lamf[3]))
           + lam_init)
    o_diff = diff_attention(dq, dk, dv.reshape(B, S, DIFF_HEADS, DIFF_V_DIM),
                            lam, diff_norm_g, lam_init)

    sq = apply_rope(sq.reshape(B, S, DSA_HEADS, HEAD_DIM), cos, sin)
    sk = apply_rope(sk.reshape(B, S, DSA_HEADS, HEAD_DIM), cos, sin)
    iq = apply_rope(iq.reshape(B, S, IDX_HEADS, HEAD_DIM), cos, sin)
    ik = apply_rope(ik, cos, sin)
    o_dsa = dsa_attention(sq, sk, sv.reshape(B, S, DSA_HEADS, HEAD_DIM),
                          iq, ik, iw * IDX_W_SCALE)

    log_f = jax.nn.log_sigmoid(ff.astype(jnp.float32) + b_forget)
    o_fox = forgetting_attention(fq.reshape(B, S, FOX_HEADS, HEAD_DIM),
                                 fk.reshape(B, S, FOX_HEADS, HEAD_DIM),
                                 fv.reshape(B, S, FOX_HEADS, HEAD_DIM), log_f)

    gates = jax.nn.sigmoid(g.astype(jnp.float32)).astype(x.dtype).reshape(B, S, N_BRANCH, D)
    y = (gates[:, :, 0] * (o_diff @ w_br[0])
         + gates[:, :, 1] * (o_dsa @ w_br[1])
         + gates[:, :, 2] * (o_fox @ w_br[2]))
    return y @ w_o


def grouped_moe(x, w_router, b_router, w_gate, w_up, w_down):
    B, S, D = x.shape
    T = B * S
    A = T * TOP_K
    xt = x.reshape(T, D)
    aff = jax.nn.sigmoid((xt @ w_router).astype(jnp.float32))
    sel = (aff + b_router.astype(jnp.float32)).reshape(T, N_GROUPS, EXPERTS_PER_GROUP)
    grp_score = jnp.sum(lax.top_k(sel, 2)[0], axis=-1)
    g_idx = jnp.argmax(grp_score, axis=-1).astype(jnp.int32)
    in_grp = jnp.take_along_axis(sel, g_idx[:, None, None], axis=1)[:, 0]
    _, loc = lax.top_k(in_grp, TOP_K)
    e_idx = g_idx[:, None] * EXPERTS_PER_GROUP + loc
    wts = jnp.take_along_axis(aff, e_idx, axis=1)
    wts = wts / jnp.sum(wts, axis=-1, keepdims=True)

    flat_e = e_idx.reshape(A)
    order = jnp.argsort(flat_e)
    e_sorted = flat_e[order]
    tok_sorted = order // TOP_K
    w_sorted = wts.reshape(A)[order]
    counts = jnp.bincount(flat_e, length=N_EXPERTS)
    padded = (counts + MOE_BLOCK - 1) // MOE_BLOCK * MOE_BLOCK
    pad_end = jnp.cumsum(padded)
    pad_start = pad_end - padded
    start = jnp.cumsum(counts) - counts
    dest = pad_start[e_sorted] + jnp.arange(A) - start[e_sorted]
    R = -(-A // MOE_BLOCK) * MOE_BLOCK + N_EXPERTS * MOE_BLOCK
    nblk = R // MOE_BLOCK
    row_tok = jnp.full((R,), T, dtype=tok_sorted.dtype).at[dest].set(tok_sorted)
    x_rows = jnp.concatenate([xt, jnp.zeros((1, D), xt.dtype)], axis=0)[row_tok]
    x_rows = x_rows.reshape(nblk, MOE_BLOCK, D)
    blk_e = jnp.minimum(jnp.searchsorted(pad_end, jnp.arange(nblk) * MOE_BLOCK, side='right'),
                        N_EXPERTS - 1)

    def expert_block(args):
        xb, e = args
        h = jax.nn.silu(xb @ w_gate[e]) * (xb @ w_up[e])
        return h @ w_down[e]

    y_rows = lax.map(expert_block, (x_rows, blk_e)).reshape(R, D)
    y = y_rows[dest] * w_sorted[:, None].astype(x.dtype)
    return jnp.zeros((T, D), x.dtype).at[tok_sorted].add(y).reshape(B, S, D)


def setup_inputs(seed: int = 0) -> dict:
    key = jax.random.key(seed)
    ks = jax.random.split(key, 20)

    def nrm(k, shape, scale):
        return jax.random.normal(k, shape, jnp.float32) * scale

    x = nrm(ks[0], (BATCH, SEQ, D_MODEL), 1.0)
    offset = jax.random.randint(ks[1], (BATCH, 1), 0, SEQ, dtype=jnp.int32)
    positions = offset + jnp.arange(SEQ, dtype=jnp.int32)[None, :]
    return {
        'x': x,
        'positions': positions,
        'ln_in_g': 1.0 + nrm(ks[2], (D_MODEL,), 0.02),
        'ln_in_b': nrm(ks[3], (D_MODEL,), 0.02),
        'w_in': nrm(ks[4], (DEPTH, D_MODEL, IN_WIDTH), D_MODEL ** -0.5),
        'b_forget': 3.0 + nrm(ks[5], (DEPTH, FOX_HEADS), 0.5),
        'diff_lam': nrm(ks[6], (DEPTH, 4, HEAD_DIM), 0.1),
        'diff_norm_g': 1.0 + nrm(ks[7], (DEPTH, DIFF_V_DIM), 0.02),
        'w_br': nrm(ks[8], (DEPTH, N_BRANCH, BRANCH_WIDTH, D_MODEL),
                    BRANCH_WIDTH ** -0.5 * DEEPNORM_BETA),
        'w_o': nrm(ks[9], (DEPTH, D_MODEL, D_MODEL), D_MODEL ** -0.5 * DEEPNORM_BETA),
        'ln1_g': 1.0 + nrm(ks[10], (DEPTH, D_MODEL), 0.02),
        'ln1_b': nrm(ks[11], (DEPTH, D_MODEL), 0.02),
        'w_router': nrm(ks[12], (D_MODEL, N_EXPERTS), D_MODEL ** -0.5),
        'b_router': nrm(ks[13], (N_EXPERTS,), 0.01),
        'w_gate': nrm(ks[14], (DEPTH, N_EXPERTS, D_MODEL, D_EXPERT), D_MODEL ** -0.5),
        'w_up': nrm(ks[15], (DEPTH, N_EXPERTS, D_MODEL, D_EXPERT), D_MODEL ** -0.5),
        'w_down': nrm(ks[16], (DEPTH, N_EXPERTS, D_EXPERT, D_MODEL),
                      D_EXPERT ** -0.5 * DEEPNORM_BETA),
        'ln2_g': 1.0 + nrm(ks[17], (DEPTH, D_MODEL), 0.02),
        'ln2_b': nrm(ks[18], (DEPTH, D_MODEL), 0.02),
    }


def reference(x, positions, ln_in_g, ln_in_b, w_in, b_forget, diff_lam, diff_norm_g,
              w_br, w_o, ln1_g, ln1_b, w_router, b_router, w_gate, w_up, w_down,
              ln2_g, ln2_b):
    cos, sin = rope_tables(positions, HEAD_DIM, x.dtype)
    h = layer_norm(x, ln_in_g, ln_in_b)
    for l in range(DEPTH):
        lam_init = 0.8 - 0.6 * math.exp(-0.3 * l)
        m = hybrid_mixer(h, cos, sin, w_in[l], b_forget[l], diff_lam[l], diff_norm_g[l],
                         w_br[l], w_o[l], lam_init)
        h = layer_norm(DEEPNORM_ALPHA * h + m, ln1_g[l], ln1_b[l])
        f = grouped_moe(h, w_router, b_router, w_gate[l], w_up[l], w_down[l])
        h = layer_norm(DEEPNORM_ALPHA * h + f, ln2_g[l], ln2_b[l])
    return h
```

```cpp
#include <hip/hip_runtime.h>
#include <hip/hip_bf16.h>
#include <cstdio>
#include <cstdint>
#include <cmath>

namespace cfg {
constexpr int D = 1024, NB = 8, S = 4096, T = NB * S, DEPTH = 2, INW = 8012;
constexpr int O_DQ = 0, O_DK = 512, O_DV = 1024, O_SQ = 1536, O_SK = 2048, O_SV = 2560, O_IQ = 3072, O_IK = 3328,
              O_IW = 3392, O_FQ = 3396, O_FK = 3908, O_FV = 4420, O_FF = 4932, O_G = 4940;
constexpr float LN_EPS = 1e-5f;
constexpr float ALPHA = 1.41421356237309515f;
constexpr float LOG2E = 1.4426950408889634f;
constexpr float C2 = 0.125f * LOG2E;
constexpr int NE = 32, DE = 512;
constexpr int NPROJ = 5120;
constexpr int RMAX = 2 * T + NE * 256 - NE;
constexpr int NRT_MAX = 288;
constexpr int RPAD = NRT_MAX * 256;
constexpr size_t MiB = 1u << 20;
constexpr size_t WS_CTL = 0, CTL_ZERO_BYTES = 1 * MiB;
constexpr size_t WS_CS = 1 * MiB;
constexpr size_t WS_SN = 5 * MiB;
constexpr size_t WS_LF = 9 * MiB;
constexpr size_t WS_CB = 10 * MiB;
constexpr size_t WS_IW = 11 * MiB;
constexpr size_t WS_EIDX = 11 * MiB + 512 * 1024;
constexpr size_t WS_WTS = 11 * MiB + 768 * 1024;
constexpr size_t WS_POS = 12 * MiB;
constexpr size_t WS_ROWTOK = 12 * MiB + 256 * 1024;
constexpr size_t WS_HIST = 12 * MiB + 640 * 1024;
constexpr size_t WS_TILEE = 12 * MiB + 704 * 1024;
constexpr size_t WS_W = 16 * MiB;
constexpr size_t WS_WIN = WS_W, WS_WBR = WS_W + 16 * MiB, WS_WO = WS_W + 19 * MiB;
constexpr size_t WS_XN = 38 * MiB;
constexpr size_t WS_MASK = 102 * MiB;
constexpr size_t WS_O = 118 * MiB;
constexpr size_t WS_OS = WS_O, WS_OF = WS_O + 32 * MiB;
constexpr size_t WS_OD = 182 * MiB;
constexpr size_t WS_Z = 246 * MiB;
constexpr size_t ZG = 32 * MiB;
constexpr size_t WS_IQ = WS_Z + 9 * ZG, WS_IK = WS_IQ + 16 * MiB, WS_ZEND = WS_IK + 4 * MiB;
constexpr size_t WS_U = WS_Z;
constexpr size_t WS_Y = WS_Z + 192 * MiB;
constexpr size_t WS_ODC = WS_Z + 256 * MiB;
constexpr size_t WS_EW = WS_O;
constexpr size_t WS_EWD = WS_EW + 64 * MiB;
constexpr size_t WS_HID = WS_Z;
constexpr size_t WS_YR = WS_Z + 72 * MiB;
constexpr size_t WS_MASK1 = WS_ZEND;
constexpr size_t WS_END = WS_ZEND + 16 * MiB;
static_assert(WS_ODC + 32 * MiB <= WS_ZEND && WS_YR + 144 * MiB <= WS_ZEND && WS_EWD + 32 * MiB <= WS_Z, "ws map");
constexpr int CW_BAR = 4096;
}
using namespace cfg;

#define GAS __attribute__((address_space(1)))
#define LAS __attribute__((address_space(3)))
typedef unsigned short bf16;
typedef unsigned v4u __attribute__((ext_vector_type(4)));
typedef unsigned v2u __attribute__((ext_vector_type(2)));
typedef float f32x4 __attribute__((ext_vector_type(4)));
typedef float f32x2 __attribute__((ext_vector_type(2)));
typedef short bf16x8 __attribute__((ext_vector_type(8)));
typedef GAS unsigned gu32;
#define RLX_AGENT __ATOMIC_RELAXED, __HIP_MEMORY_SCOPE_AGENT
#define LDS_WAIT() asm volatile("s_waitcnt lgkmcnt(0)" ::: "memory")
#define VM_WAIT() asm volatile("s_waitcnt vmcnt(0)" ::: "memory")
__device__ __forceinline__ unsigned f2bf(float f) { unsigned u = __builtin_bit_cast(unsigned, f); return (u + 0x7fffu + ((u >> 16) & 1u)) >> 16; }
__device__ __forceinline__ unsigned pk2(float lo, float hi) { return f2bf(lo) | (f2bf(hi) << 16); }
__device__ __forceinline__ float bf2f(unsigned short h) { return __builtin_bit_cast(float, (unsigned)h << 16); }
__device__ __forceinline__ float bflo(unsigned w) { return __builtin_bit_cast(float, w << 16); }
__device__ __forceinline__ float bfhi(unsigned w) { return __builtin_bit_cast(float, w & 0xffff0000u); }
__device__ __forceinline__ unsigned cvt_pk_bf16(float lo, float hi) { unsigned r; asm volatile("v_cvt_pk_bf16_f32 %0, %1, %2" : "=v"(r) : "v"(lo), "v"(hi)); return r; }
__device__ __forceinline__ float wave_sum(float v) {
#pragma unroll
    for (int o = 1; o < 64; o <<= 1) v += __shfl_xor(v, o);
    return v;
}
__device__ __forceinline__ float sigmoidf_(float x) { return 1.f / (1.f + __expf(-x)); }
namespace pg8 {
#define PG8_LAS __attribute__((address_space(3)))
constexpr int BM = 256, BK = 64, HALF = 128, HTB = HALF * BK * 2  , STAGE_BYTES = 8 * HTB, NXCD = 8, WGM = 8;
__host__ __device__ __forceinline__ int lds_byte(int r, int c) { const int st = (r >> 4) * 2 + (c >> 5), rr = r & 15, cc = c & 31, ob = rr * 64 + cc * 2; return st * 1024 + (ob ^ (((ob >> 9) & 1) << 5)); }
__host__ __device__ __forceinline__ void stage_rc(int b, int& R, int& C) { const int st = b / 1024, sb = b % 1024, swz = sb ^ (((sb >> 9) & 1) << 5); R = (st >> 1) * 16 + swz / 64; C = (st & 1) * 32 + (swz % 64) / 2; }
__host__ __device__ __forceinline__ int perm32(int rho) { const int n = rho >> 4, i = rho & 15; return 8 * (i >> 2) + 4 * n + (i & 3); }

struct Unit { int pm, pn, aux; };

__device__ __forceinline__ void map_unit(int L, int nM, int nN, int& pm, int& pn) {
    const int nwg = nM * nN; int wgid = L;
    { const int q = nwg / NXCD, r = nwg % NXCD, xcd = wgid % NXCD, off = wgid / NXCD; wgid = (xcd < r ? xcd * (q + 1) : r * (q + 1) + (xcd - r) * q) + off; }
    const int nig = WGM * nN, gid = wgid / nig, fm = gid * WGM, gsz = (nM - fm) < WGM ? (nM - fm) : WGM;
    pm = fm + ((wgid % nig) % gsz); pn = (wgid % nig) / gsz;
}

template <class G, class Epi, class Sched, bool ALIGN_EPI>
__device__ __forceinline__ void gemm_phase(PG8_LAS unsigned char* lds, const G& g, const Sched& S, const Epi& E, int tid_in) {
    int tid_ = tid_in; asm volatile("" : "+v"(tid_));
    const int tid = tid_, wid = __builtin_amdgcn_readfirstlane(tid >> 6), lane = tid & 63, wr = wid >> 2, wc = wid & 3, fr = lane & 15, fq = lane >> 4;
    const int K = g.K, nt = K / BK;
    constexpr bool GA = G::GATHER;
    unsigned voffB[2], voffA[2];
#pragma unroll
    for (int i = 0; i < 2; ++i) { int R, C; stage_rc(tid * 16 + i * 8192, R, C); const int Rb = (R & ~31) + perm32(R & 31); voffB[i] = (unsigned)(Rb * K + C) * 2u;
        if constexpr (!GA) voffA[i] = (unsigned)(R * g.lda + C) * 2u; else voffA[i] = 0u; }
    const size_t kstep = (size_t)(BK * 2);
    const size_t hstep = (size_t)HALF * K * 2;
    size_t hstepA = 0; if constexpr (!GA) hstepA = (size_t)HALF * g.lda * 2;
    const unsigned ldsw = (unsigned)wid * 1024u;
    const int aoff = lds_byte(wr * 64 + fr, fq * 8), boff = lds_byte(wc * 32 + fr, fq * 8);
#define PG8_SA(b, h) (((b) * 2 + (h)) * HTB)
#define PG8_SB(b, h) ((4 + (b) * 2 + (h)) * HTB)
#define PG8_STAGE(bufoff, gbase, voff) do { _Pragma("unroll") for (int _i = 0; _i < 2; ++_i) \
        __builtin_amdgcn_global_load_lds((const unsigned*)((const char*)(gbase) + (voff)[_i]), (PG8_LAS unsigned*)(lds + (bufoff) + ldsw + _i * 8192), 16, 0, 0); } while (0)
#define PG8_LDA(dst, b, h) do { _Pragma("unroll") for (int m = 0; m < 4; ++m) _Pragma("unroll") for (int k = 0; k < 2; ++k) dst[m][k] = *(const PG8_LAS bf16x8*)(lds + PG8_SA(b, h) + aoff + m * 2048 + k * 1024); } while (0)
#define PG8_LDB(dst, b, h) do { _Pragma("unroll") for (int n = 0; n < 2; ++n) _Pragma("unroll") for (int k = 0; k < 2; ++k) dst[n][k] = *(const PG8_LAS bf16x8*)(lds + PG8_SB(b, h) + boff + n * 2048 + k * 1024); } while (0)
#define PG8_MMA(ai, bj, At, Bt) do { __builtin_amdgcn_s_setprio(1); _Pragma("unroll") for (int m = 0; m < 4; ++m) _Pragma("unroll") for (int n = 0; n < 2; ++n) _Pragma("unroll") for (int k = 0; k < 2; ++k) \
        acc[ai][bj][m][n] = __builtin_amdgcn_mfma_f32_16x16x32_bf16(Bt[n][k], At[m][k], acc[ai][bj][m][n], 0, 0, 0); __builtin_amdgcn_s_setprio(0); } while (0)
#define PG8_WAIT_V(n) asm volatile("s_waitcnt vmcnt(" #n ")" ::: "memory")
#define PG8_WAIT_L(n) asm volatile("s_waitcnt lgkmcnt(" #n ")" ::: "memory")
#define PG8_BAR __builtin_amdgcn_s_barrier()
#define PG8_SCHED __builtin_amdgcn_sched_barrier(0)
    Unit cur, nxt; int ui = 0;
    if (!S.next(0, cur)) return;
    f32x4 acc[2][2][4][2];
#pragma unroll
    for (int a = 0; a < 2; ++a)
#pragma unroll
        for (int b = 0; b < 2; ++b)
#pragma unroll
            for (int m = 0; m < 4; ++m)
#pragma unroll
                for (int n = 0; n < 2; ++n) acc[a][b][m][n] = (f32x4){0.f, 0.f, 0.f, 0.f};
    bf16x8 At[4][2], B0[2][2], B1[2][2];
    unsigned vC0[2], vC1[2], vN0[2], vN1[2];
    const char* cA0; const char* cA1;
    if constexpr (GA) {
#pragma unroll
        for (int i = 0; i < 2; ++i) { int R, C; stage_rc(tid * 16 + i * 8192, R, C); vC0[i] = g.a_off(cur, 0, 0, R, C); vC1[i] = g.a_off(cur, 0, 1, R, C); }
        cA0 = g.a_base; cA1 = g.a_base;
    } else {
#pragma unroll
        for (int i = 0; i < 2; ++i) { vC0[i] = voffA[i]; vC1[i] = voffA[i]; vN0[i] = voffA[i]; vN1[i] = voffA[i]; }
        cA0 = g.a_ptr(cur); cA1 = cA0 + hstepA;
    }
    const char* cB = g.b_ptr(cur);
    PG8_STAGE(PG8_SB(0, 0), cB, voffB); PG8_STAGE(PG8_SB(0, 1), cB + hstep, voffB); PG8_STAGE(PG8_SA(0, 0), cA0, vC0); PG8_STAGE(PG8_SA(0, 1), cA1, vC1);
    if (wr == 1) PG8_BAR;
    PG8_WAIT_V(2); PG8_BAR;
    PG8_STAGE(PG8_SB(1, 0), cB + kstep, voffB); PG8_STAGE(PG8_SA(1, 0), cA0 + kstep, vC0); PG8_STAGE(PG8_SB(1, 1), cB + hstep + kstep, voffB);
    PG8_WAIT_V(6); PG8_BAR;
    for (;;) {
        const bool has_next = S.next(ui + 1, nxt);
        const char* nB = cB; const char* nA0 = cA0; const char* nA1 = cA1;
        if (has_next) {
            if constexpr (GA) {
#pragma unroll
                for (int i = 0; i < 2; ++i) { int R, C; stage_rc(tid * 16 + i * 8192, R, C); vN0[i] = g.a_off(nxt, ui + 1, 0, R, C); vN1[i] = g.a_off(nxt, ui + 1, 1, R, C); }
            } else { nA0 = g.a_ptr(nxt); nA1 = nA0 + hstepA; }
            nB = g.b_ptr(nxt);
        } else {
            if constexpr (GA) {
#pragma unroll
                for (int i = 0; i < 2; ++i) { vN0[i] = vC0[i]; vN1[i] = vC1[i]; }
            }
        }
        for (int t = 0; t < nt; t += 2) {
            const bool last = (t == nt - 2);
            const char* a1 = cA1 + (size_t)(t + 1) * kstep;
            const char* a20 = last ? nA0 : cA0 + (size_t)(t + 2) * kstep; const char* a21 = last ? nA1 : cA1 + (size_t)(t + 2) * kstep;
            const char* b2 = last ? nB : cB + (size_t)(t + 2) * kstep;
            const char* a30 = a20 + kstep; const char* b3 = b2 + kstep;
            unsigned w0[2], w1[2];
#pragma unroll
            for (int i = 0; i < 2; ++i) { if constexpr (GA) { w0[i] = last ? vN0[i] : vC0[i]; w1[i] = last ? vN1[i] : vC1[i]; } else { w0[i] = voffA[i]; w1[i] = voffA[i]; } }
            PG8_LDB(B0, 0, 0); PG8_LDB(B1, 0, 1); PG8_SCHED; PG8_LDA(At, 0, 0); PG8_STAGE(PG8_SA(1, 1), a1, vC1);
            PG8_WAIT_V(8); PG8_WAIT_L(0); PG8_BAR; PG8_MMA(0, 0, At, B0); PG8_MMA(0, 1, At, B1); PG8_BAR; PG8_SCHED;
            PG8_LDA(At, 0, 1); PG8_STAGE(PG8_SB(0, 0), b2, voffB); PG8_STAGE(PG8_SB(0, 1), b2 + hstep, voffB); PG8_STAGE(PG8_SA(0, 0), a20, w0);
            PG8_WAIT_V(8); PG8_WAIT_L(0); PG8_BAR; PG8_MMA(1, 0, At, B0); PG8_MMA(1, 1, At, B1); PG8_BAR; PG8_SCHED;
            PG8_LDB(B0, 1, 0); PG8_LDB(B1, 1, 1); PG8_SCHED; PG8_LDA(At, 1, 0); PG8_STAGE(PG8_SA(0, 1), a21, w1);
            PG8_WAIT_V(8); PG8_WAIT_L(0); PG8_BAR; PG8_MMA(0, 0, At, B0); PG8_MMA(0, 1, At, B1); PG8_BAR; PG8_SCHED;
            PG8_LDA(At, 1, 1); PG8_STAGE(PG8_SB(1, 0), b3, voffB); PG8_STAGE(PG8_SB(1, 1), b3 + hstep, voffB); PG8_STAGE(PG8_SA(1, 0), a30, w0);
            PG8_WAIT_V(8); PG8_WAIT_L(0); PG8_BAR; PG8_MMA(1, 0, At, B0); PG8_MMA(1, 1, At, B1); PG8_BAR; PG8_SCHED;
        }
        if constexpr (ALIGN_EPI) { if (wr == 0) PG8_BAR; }
        E(acc, cur, wr, wc, fr, fq);
        if (!has_next) break;
#pragma unroll
        for (int a = 0; a < 2; ++a)
#pragma unroll
            for (int b = 0; b < 2; ++b)
#pragma unroll
                for (int m = 0; m < 4; ++m)
#pragma unroll
                    for (int n = 0; n < 2; ++n) acc[a][b][m][n] = (f32x4){0.f, 0.f, 0.f, 0.f};
        cur = nxt; cB = nB; cA0 = nA0; cA1 = nA1; ++ui;
        if constexpr (GA) {
#pragma unroll
            for (int i = 0; i < 2; ++i) { vC0[i] = vN0[i]; vC1[i] = vN1[i]; }
        }
        if constexpr (ALIGN_EPI) { if (wr == 1) PG8_BAR; }
    }
    PG8_WAIT_V(0);
    if constexpr (!ALIGN_EPI) { if (wr == 0) PG8_BAR; }
    PG8_BAR;
#undef PG8_SA
#undef PG8_SB
#undef PG8_STAGE
#undef PG8_LDA
#undef PG8_LDB
#undef PG8_MMA
#undef PG8_WAIT_V
#undef PG8_WAIT_L
#undef PG8_BAR
#undef PG8_SCHED
}
}
#define XB_TMO      128
#define XB_XCNT(j)  (256  + 64 * (j))
#define XB_XSUB(j)  (1280 + 64 * (j))
#define XB_XGEN(j)  (2304 + 64 * (j))
#define XB_TOP      3328
#define XB_TOPGEN   3392
#define XCD_BAR_WORDS 3456
#define XB_SPIN_CAP (1u << 18)

__device__ __forceinline__ unsigned xb_ld(unsigned* p)              { return __hip_atomic_load(p, __ATOMIC_RELAXED, __HIP_MEMORY_SCOPE_AGENT); }
__device__ __forceinline__ unsigned xb_add(unsigned* p, unsigned v) { return __hip_atomic_fetch_add(p, v, __ATOMIC_RELAXED, __HIP_MEMORY_SCOPE_AGENT); }
__device__ __forceinline__ unsigned xb_xcc_id() { return (unsigned)__builtin_amdgcn_s_getreg((3 << 11) | 20) & 0xFu; }
#define XB_SPIN(cond, bar) do { unsigned _sp = 0; while (cond) { __builtin_amdgcn_s_sleep(1); \
    if ((++_sp & 255u) == 0u) { if (xb_ld(&(bar)[XB_TMO])) break; if (_sp > XB_SPIN_CAP) { atomicAdd(&(bar)[XB_TMO], 1u); break; } } } } while (0)

struct XcdBarrier {
    unsigned* bar; unsigned x; unsigned tid;
    volatile LAS unsigned* st;
};

__device__ __forceinline__ XcdBarrier xcd_barrier_post(unsigned* bar, volatile LAS unsigned* st) {
    XcdBarrier b; b.bar = bar; b.x = xb_xcc_id(); b.st = st;
    if (threadIdx.x == 0) (void)xb_add(&bar[XB_XCNT(b.x)], 1u);
    return b;
}
__device__ __forceinline__ void xcd_barrier_complete(unsigned* bar, unsigned x, unsigned& nloc, unsigned& nx) {
    const unsigned G = gridDim.x * gridDim.y * gridDim.z;
    unsigned sum, cnt, mine, sp = 0u;
    for (;;) {
        sum = 0u; cnt = 0u; mine = 0u;
#pragma unroll
        for (unsigned j = 0; j < 16; ++j) { const unsigned c = xb_ld(&bar[XB_XCNT(j)]); sum += c; cnt += (c > 0u) ? 1u : 0u; mine = (j == x) ? c : mine; }
        if (sum == G) break;
        __builtin_amdgcn_s_sleep(1);
        if ((++sp & 255u) == 0u) { if (xb_ld(&bar[XB_TMO])) break; if (sp > XB_SPIN_CAP) { atomicAdd(&bar[XB_TMO], 1u); break; } }
    }
    nloc = mine > 0u ? mine : 1u; nx = cnt > 0u ? cnt : 1u;
}

__device__ __forceinline__ void xcd_barrier(const XcdBarrier& b) {
    asm volatile("s_waitcnt vmcnt(0)" ::: "memory");
    __syncthreads();
    if (b.tid == 0u) {
        unsigned* bar = b.bar;
        __builtin_amdgcn_s_waitcnt(0);
        unsigned nloc = b.st[0], nx = b.st[1];
        if (nloc == 0u) { xcd_barrier_complete(bar, b.x, nloc, nx); b.st[0] = nloc; b.st[1] = nx; }
        const unsigned old = xb_add(&bar[XB_XSUB(b.x)], 1u);
        const unsigned gen = old / nloc;
        if (old + 1u == (gen + 1u) * nloc) {
            __builtin_amdgcn_fence(__ATOMIC_RELEASE, "agent");
            asm volatile("s_waitcnt vmcnt(0)" ::: "memory");
            const unsigned og = xb_add(&bar[XB_TOP], 1u);
            const unsigned tg = og / nx;
            if (og + 1u == (tg + 1u) * nx) xb_add(&bar[XB_TOPGEN], 1u);
            else XB_SPIN(xb_ld(&bar[XB_TOPGEN]) == tg, bar);
            __builtin_amdgcn_fence(__ATOMIC_ACQUIRE, "agent");
            xb_add(&bar[XB_XGEN(b.x)], 1u);
            asm volatile("s_waitcnt vmcnt(0)" ::: "memory");
        } else {
            XB_SPIN(xb_ld(&bar[XB_XGEN(b.x)]) == gen, bar);
            __builtin_amdgcn_fence(__ATOMIC_ACQUIRE, "agent");
            asm volatile("s_waitcnt vmcnt(0)" ::: "memory");
        }
    }
    __syncthreads();
}
constexpr int NWAVES = 8;
constexpr int RING_OFF = 0, RING_BYTES = 131072;
constexpr int LDSCTL_OFF = RING_BYTES, MISC_OFF = LDSCTL_OFF + 320;
constexpr int TAB_OFF = LDSCTL_OFF + 1024;
constexpr int LDS_BYTES = 147456;
static_assert(TAB_OFF + 8 * 1024 <= LDS_BYTES, "LDS map");

struct Frame {
    LAS unsigned char* lds;
    volatile LAS unsigned* MISC;
    gu32* ctl;
    int tid, lane, wave, vcu, G;
    unsigned char* ws; float* out;
    const float* const* in;
};
enum { I_X = 0, I_POS, I_LNG, I_LNB, I_WIN, I_BF, I_LAM, I_DNG, I_WBR, I_WO, I_LN1G, I_LN1B, I_WR, I_BR, I_WG, I_WU, I_WD, I_LN2G, I_LN2B };

__device__ __forceinline__ int win_src(int n) {
    if (n < 4608) {
        const int g = n >> 9, c = n & 511;
        const int base = g == 0 ? O_DQ : g == 1 ? O_DK : g == 2 ? O_DV : g == 3 ? O_SQ : g == 4 ? O_SK : g == 5 ? O_SV : g == 6 ? O_FQ : g == 7 ? O_FK : O_FV;
        const bool rope = (g == 0) | (g == 1) | (g == 3) | (g == 4);
        if (rope) { const int j = c & 63; return base + (c & ~63) + (j >> 1) + 32 * (j & 1); }
        return base + c;
    }
    if (n < 4864) { const int c = n - 4608, j = c & 63; return O_IQ + (c & ~63) + (j >> 1) + 32 * (j & 1); }
    if (n < 4928) { const int j = n - 4864; return O_IK + (j >> 1) + 32 * (j & 1); }
    if (n < 4932) return O_IW + (n - 4928);
    if (n < 4940) return O_FF + (n - 4932);
    if (n < NPROJ) return -1;
    return O_G + (n - NPROJ);
}
template <bool MAPPED>
__device__ __forceinline__ void transpose_item(const float* W, int ldw, int k0, int n0, bf16* WT, int ldt, int drow0, LAS float* scr, int lane) {
    int sc = n0 + (lane & 31);
    if (MAPPED) sc = win_src(sc);
#pragma unroll 8
    for (int i = 0; i < 32; ++i) { const int kk = 2 * i + (lane >> 5); scr[kk * 33 + (lane & 31)] = (sc >= 0) ? W[(size_t)(k0 + kk) * ldw + sc] : 0.f; }
    LDS_WAIT(); asm volatile("" ::: "memory");
    const int c = lane & 7;
#pragma unroll
    for (int j = 0; j < 4; ++j) { const int n = (lane >> 3) + 8 * j; const LAS float* s = scr + (8 * c) * 33 + n;
        v4u o; o.x = pk2(s[0 * 33], s[1 * 33]); o.y = pk2(s[2 * 33], s[3 * 33]); o.z = pk2(s[4 * 33], s[5 * 33]); o.w = pk2(s[6 * 33], s[7 * 33]);
        *(GAS v4u*)(WT + (size_t)(drow0 + n) * ldt + k0 + 8 * c) = o; }
    LDS_WAIT(); asm volatile("" ::: "memory");
}
__device__ __forceinline__ void convert_layer_weights(Frame& F, int l, int gw, int NGW) {
    LAS float* scr = (LAS float*)(F.lds + RING_OFF + F.wave * 16384);
    constexpr int I_IN = 16 * 256, I_BRN = 3 * 8 * 32, I_ON = 16 * 32;
    for (int it = gw; it < I_IN + I_BRN + I_ON; it += NGW) {
        int r = it;
        if (r < I_IN) { const int kb = r >> 8, nb = r & 255; transpose_item<true>(F.in[I_WIN] + (size_t)l * D * INW, INW, 64 * kb, 32 * nb, (bf16*)(F.ws + WS_WIN), D, 32 * nb, scr, F.lane); continue; } r -= I_IN;
        if (r < I_BRN) { const int br = r >> 8, q = r & 255, kb = q >> 5, nb = q & 31;
            transpose_item<false>(F.in[I_WBR] + ((size_t)l * 3 + br) * 512 * D, D, 64 * kb, 32 * nb, (bf16*)(F.ws + WS_WBR) + (size_t)br * D * 512, 512, 32 * nb, scr, F.lane); continue; } r -= I_BRN;
        { const int kb = r >> 5, nb = r & 31; transpose_item<false>(F.in[I_WO] + (size_t)l * D * D, D, 64 * kb, 32 * nb, (bf16*)(F.ws + WS_WO), D, 32 * nb, scr, F.lane); }
    }
}
__device__ __forceinline__ void convert_expert_weights(Frame& F, int l, int gw, int NGW) {
    LAS float* scr = (LAS float*)(F.lds + RING_OFF + F.wave * 16384);
    constexpr int PER = 256;
    for (int it = gw; it < 3 * NE * PER; it += NGW) {
        const int which = it / (NE * PER), r = it % (NE * PER), e = r / PER, q = r % PER;
        if (which < 2) { const int kb = q >> 4, nb = q & 15, n0 = 32 * nb;
            const float* W = F.in[which == 0 ? I_WG : I_WU] + ((size_t)l * NE + e) * D * DE;
            transpose_item<false>(W, DE, 64 * kb, n0, (bf16*)(F.ws + WS_EW) + (size_t)e * 1024 * D, D, (n0 >> 7) * 256 + (n0 & 127) + which * 128, scr, F.lane);
        } else { const int kb = q >> 5, nb = q & 31;
            const float* W = F.in[I_WD] + ((size_t)l * NE + e) * DE * D;
            transpose_item<false>(W, D, 64 * kb, 32 * nb, (bf16*)(F.ws + WS_EWD) + (size_t)e * D * DE, DE, 32 * nb, scr, F.lane);
        }
    }
}

__device__ __forceinline__ void ln_row(f32x4 (&v)[4], const float* g, const float* b, int lane) {
    float s = 0.f;
#pragma unroll
    for (int j = 0; j < 4; ++j) s += (v[j].x + v[j].y) + (v[j].z + v[j].w);
    const float mean = wave_sum(s) * (1.f / D); float s2 = 0.f;
#pragma unroll
    for (int j = 0; j < 4; ++j) { v[j] = v[j] - mean; s2 += (v[j].x * v[j].x + v[j].y * v[j].y) + (v[j].z * v[j].z + v[j].w * v[j].w); }
    const float rstd = 1.f / sqrtf(wave_sum(s2) * (1.f / D) + LN_EPS);
#pragma unroll
    for (int j = 0; j < 4; ++j) { const f32x4 gg = *(const f32x4*)(g + 256 * j + 4 * lane), bb = *(const f32x4*)(b + 256 * j + 4 * lane); v[j] = v[j] * rstd * gg + bb; }
}
__device__ __forceinline__ void store_row(const f32x4 (&v)[4], float* of32, bf16* obf, int lane) {
    if (of32) {
#pragma unroll
        for (int j = 0; j < 4; ++j) *((GAS f32x4*)of32 + 64 * j + lane) = v[j];
    }
    if (obf) {
        GAS unsigned long long* o8 = (GAS unsigned long long*)obf + lane;
#pragma unroll
        for (int j = 0; j < 4; ++j) o8[64 * j] = (unsigned long long)pk2(v[j].x, v[j].y) | ((unsigned long long)pk2(v[j].z, v[j].w) << 32);
    }
}

__device__ __forceinline__ void sincos_tab(double a, float& c, float& s) {
    const double q = rint(a * 0.63661977236758134308);
    double r = fma(-q, 1.57079632679489655800e+00, a); r = fma(-q, 6.12323399573676603587e-17, r);
    const double r2 = r * r;
    double sp = -1.0 / 1307674368000.0; sp = fma(sp, r2, 1.0 / 6227020800.0); sp = fma(sp, r2, -1.0 / 39916800.0); sp = fma(sp, r2, 1.0 / 362880.0); sp = fma(sp, r2, -1.0 / 5040.0); sp = fma(sp, r2, 1.0 / 120.0); sp = fma(sp, r2, -1.0 / 6.0); sp = fma(sp * r2, r, r);
    double cp = 1.0 / 20922789888000.0; cp = fma(cp, r2, -1.0 / 87178291200.0); cp = fma(cp, r2, 1.0 / 479001600.0); cp = fma(cp, r2, -1.0 / 3628800.0); cp = fma(cp, r2, 1.0 / 40320.0); cp = fma(cp, r2, -1.0 / 720.0); cp = fma(cp, r2, 1.0 / 24.0); cp = fma(cp, r2, -0.5); cp = fma(cp, r2, 1.0);
    const int n = (int)q & 3;
    const double sn_ = (n & 1) ? cp : sp, cn_ = (n & 1) ? sp : cp;
    s = (float)((n & 2) ? -sn_ : sn_); c = (float)(((n + 1) & 2) ? -cn_ : cn_);
}
__device__ __forceinline__ void p0_prologue(Frame& F) {
    const int gw = F.vcu * NWAVES + F.wave, NGW = F.G * NWAVES;
    convert_layer_weights(F, 0, gw, NGW);
    for (int m = gw; m < T; m += NGW) {
        f32x4 v[4];
#pragma unroll
        for (int j = 0; j < 4; ++j) v[j] = *((const GAS f32x4*)(F.in[I_X] + (size_t)m * D) + 64 * j + F.lane);
        ln_row(v, F.in[I_LNG], F.in[I_LNB], F.lane);
        store_row(v, F.out + (size_t)m * D, (bf16*)(F.ws + WS_XN) + (size_t)m * D, F.lane);
    }
    const int* positions = (const int*)F.in[I_POS];
    float* cs = (float*)(F.ws + WS_CS); float* sn = (float*)(F.ws + WS_SN);
    for (int i = (F.vcu * NWAVES * 64) + F.tid; i < T * 32; i += F.G * NWAVES * 64) {
        const int t = i >> 5, k = i & 31;
        const float inv = powf(10000.0f, -(float)(2 * k) / 64.0f);
        const float ang = (float)positions[t] * inv;
        sincos_tab((double)ang, cs[i], sn[i]);
    }
}

__device__ __forceinline__ void fox_scan(Frame& F) {
    const int gw = F.vcu * NWAVES + F.wave;
    if (gw >= NB * 8) return;
    const int b = gw >> 3, h = gw & 7;
    const float* lf = (const float*)(F.ws + WS_LF) + (size_t)b * S * 8 + h;
    float* cb = (float*)(F.ws + WS_CB) + (size_t)gw * S;
    const int t0 = F.lane * 64;
    double tot = 0.0;
    for (int i = 0; i < 64; ++i) tot += (double)lf[(size_t)(t0 + i) * 8];
    double inc = tot;
#pragma unroll
    for (int o = 1; o < 64; o <<= 1) { const double n = __shfl_up(inc, o); if (F.lane >= o) inc += n; }
    double run = inc - tot;
    for (int i = 0; i < 64; ++i) { run += (double)lf[(size_t)(t0 + i) * 8]; cb[t0 + i] = (float)run; }
}

__device__ __forceinline__ void diff_combine(Frame& F, int l) {
    const int gw = F.vcu * NWAVES + F.wave, NGW = F.G * NWAVES, lane = F.lane;
    const float* lamp = F.in[I_LAM] + l * 256; const float* g = F.in[I_DNG] + l * 128;
    const float lam_init = 0.8f - 0.6f * expf(-0.3f * (float)l);
    const float s1 = wave_sum(lamp[lane] * lamp[64 + lane]), s2 = wave_sum(lamp[128 + lane] * lamp[192 + lane]);
    const float lam = expf(s1) - expf(s2) + lam_init;
    const float g0 = g[2 * lane], g1 = g[2 * lane + 1];
    const unsigned* od = (const unsigned*)(F.ws + WS_OD); unsigned* oc = (unsigned*)(F.ws + WS_ODC);
    for (int w = gw; w < T * 4; w += NGW) {
        const int t = w >> 2, h = w & 3;
        const unsigned a = od[(size_t)t * 512 + h * 128 + lane], b = od[(size_t)t * 512 + h * 128 + 64 + lane];
        const float v0 = bflo(a) - lam * bflo(b), v1 = bfhi(a) - lam * bfhi(b);
        const float ms = wave_sum(v0 * v0 + v1 * v1) * (1.f / 128.f);
        const float r = (1.f / sqrtf(ms + LN_EPS)) * (1.f - lam_init);
        oc[(size_t)t * 256 + h * 64 + lane] = pk2(v0 * r * g0, v1 * r * g1);
    }
}

__device__ __forceinline__ void p8_ln1_router(Frame& F, int l) {
    const int lane = F.lane;
    LAS float* wrt = (LAS float*)(F.lds + RING_OFF);
    LAS int* cnt = (LAS int*)(F.lds + TAB_OFF);
    const float* Wr = F.in[I_WR];
    for (int i = F.tid; i < D * NE; i += NWAVES * 64) { const int d = i >> 5, e = i & 31; wrt[e * D + d] = Wr[i]; }
    if (F.tid < NE) cnt[F.tid] = 0;
    __syncthreads();
    const float* br = F.in[I_BR];
    const float* g1 = F.in[I_LN1G] + l * D; const float* b1 = F.in[I_LN1B] + l * D;
    int* eidx = (int*)(F.ws + WS_EIDX); float* wts = (float*)(F.ws + WS_WTS);
    for (int rr = 0; rr < 16; ++rr) {
        const int m = (int)blockIdx.x * 128 + F.wave * 16 + rr;
        f32x4 v[4];
#pragma unroll
        for (int j = 0; j < 4; ++j) v[j] = *((const GAS f32x4*)(F.out + (size_t)m * D) + 64 * j + lane);
        ln_row(v, g1, b1, lane);
        store_row(v, F.out + (size_t)m * D, (bf16*)(F.ws + WS_XN) + (size_t)m * D, lane);
        float sel[NE], aff[NE];
#pragma unroll
        for (int e = 0; e < NE; ++e) {
            float a = 0.f;
#pragma unroll
            for (int j = 0; j < 4; ++j) { const f32x4 w = *(const LAS f32x4*)(wrt + e * D + 256 * j + 4 * lane); a += (v[j].x * w.x + v[j].y * w.y) + (v[j].z * w.z + v[j].w * w.w); }
            a = wave_sum(a);
            aff[e] = 1.f / (1.f + expf(-a)); sel[e] = aff[e] + br[e];
        }
        int gbest = 0; float gs = -INFINITY;
#pragma unroll
        for (int g = 0; g < 4; ++g) {
            float m1 = -INFINITY, m2 = -INFINITY;
#pragma unroll
            for (int i = 0; i < 8; ++i) { const float x = sel[g * 8 + i]; if (x > m1) { m2 = m1; m1 = x; } else if (x > m2) m2 = x; }
            const float sc = m1 + m2;
            if (sc > gs) { gs = sc; gbest = g; }
        }
        int i1 = 0, i2 = 0; float m1 = -INFINITY, m2 = -INFINITY, a1 = 0.f, a2 = 0.f;
#pragma unroll
        for (int g = 0; g < 4; ++g) {
            if (g == gbest) {
#pragma unroll
                for (int i = 0; i < 8; ++i) { const float x = sel[g * 8 + i], af = aff[g * 8 + i];
                    if (x > m1) { m2 = m1; i2 = i1; a2 = a1; m1 = x; i1 = i; a1 = af; } else if (x > m2) { m2 = x; i2 = i; a2 = af; } }
            }
        }
        const int e1 = gbest * 8 + i1, e2 = gbest * 8 + i2; const float sum = a1 + a2;
        if (lane == 0) { eidx[m * 2] = e1; eidx[m * 2 + 1] = e2; wts[m * 2] = a1 / sum; wts[m * 2 + 1] = a2 / sum; __hip_atomic_fetch_add(&cnt[e1], 1, __ATOMIC_RELAXED, __HIP_MEMORY_SCOPE_WORKGROUP); __hip_atomic_fetch_add(&cnt[e2], 1, __ATOMIC_RELAXED, __HIP_MEMORY_SCOPE_WORKGROUP); }
    }
    __syncthreads();
    if (F.tid < NE) ((int*)(F.ws + WS_HIST))[blockIdx.x * NE + F.tid] = cnt[F.tid];
    int* row_tok = (int*)(F.ws + WS_ROWTOK);
    for (int i = F.tid; i < RPAD / 256; i += NWAVES * 64) row_tok[blockIdx.x * (RPAD / 256) + i] = 0;
    __syncthreads();
    const int gw = F.vcu * NWAVES + F.wave, NGW = F.G * NWAVES;
    convert_expert_weights(F, l, gw, NGW);
    if (l + 1 < DEPTH) convert_layer_weights(F, l + 1, gw, NGW);
}

__device__ __forceinline__ void p9_placement(Frame& F) {
    LAS int* tot = (LAS int*)(F.lds + RING_OFF); LAS int* before = tot + 32; LAS int* start = tot + 64; LAS int* earr = tot + 128;
    const int* hist = (const int*)(F.ws + WS_HIST);
    const int blk = blockIdx.x;
    if (F.tid < NE) { int t = 0, bfr = 0; for (int b = 0; b < F.G; ++b) { const int c = __hip_atomic_load(hist + b * NE + F.tid, RLX_AGENT); t += c; if (b < blk) bfr += c; } tot[F.tid] = t; before[F.tid] = bfr; }
    __syncthreads();
    if (F.tid == 0) { int run = 0; for (int e = 0; e < NE; ++e) { start[e] = run; run += (tot[e] + 255) & ~255; } start[NE] = run; }
    __syncthreads();
    const int* eidx = (const int*)(F.ws + WS_EIDX);
    int e = 0;
    if (F.tid < 256) { e = eidx[blk * 256 + F.tid]; earr[F.tid] = e; }
    __syncthreads();
    if (F.tid < 256) {
        int rank = 0;
        for (int a = 0; a < 256; ++a) rank += (a < F.tid && earr[a] == e) ? 1 : 0;
        const int p = start[e] + before[e] + rank;
        ((int*)(F.ws + WS_ROWTOK))[p] = blk * 128 + (F.tid >> 1);
        ((int*)(F.ws + WS_POS))[blk * 256 + F.tid] = p;
    }
    if (blk == 0) {
        int* tile_e = (int*)(F.ws + WS_TILEE);
        if (F.tid < NE) { const int t0 = start[F.tid] >> 8, t1 = start[F.tid + 1] >> 8; for (int t = t0; t < t1; ++t) tile_e[t] = F.tid; }
        if (F.tid == 0) tile_e[NRT_MAX] = start[NE] >> 8;
    }
    __syncthreads();
}

__device__ __forceinline__ void p12_combine_ln2(Frame& F, int l) {
    const int gw = F.vcu * NWAVES + F.wave, NGW = F.G * NWAVES, lane = F.lane;
    const float* g2 = F.in[I_LN2G] + l * D; const float* b2 = F.in[I_LN2B] + l * D;
    const int* pos = (const int*)(F.ws + WS_POS); const float* wts = (const float*)(F.ws + WS_WTS);
    const bf16* yr = (const bf16*)(F.ws + WS_YR);
    for (int m = gw; m < T; m += NGW) {
        const int p0 = pos[m * 2], p1 = pos[m * 2 + 1]; const float w0 = wts[m * 2], w1 = wts[m * 2 + 1];
        f32x4 v[4];
#pragma unroll
        for (int j = 0; j < 4; ++j) {
            const f32x4 h = *((const GAS f32x4*)(F.out + (size_t)m * D) + 64 * j + lane);
            const v2u a = *((const GAS v2u*)(yr + (size_t)p0 * D) + 64 * j + lane), b = *((const GAS v2u*)(yr + (size_t)p1 * D) + 64 * j + lane);
            v[j].x = ALPHA * h.x + (w0 * bflo(a.x) + w1 * bflo(b.x)); v[j].y = ALPHA * h.y + (w0 * bfhi(a.x) + w1 * bfhi(b.x));
            v[j].z = ALPHA * h.z + (w0 * bflo(a.y) + w1 * bflo(b.y)); v[j].w = ALPHA * h.w + (w0 * bfhi(a.y) + w1 * bfhi(b.y));
        }
        ln_row(v, g2, b2, lane);
        store_row(v, F.out + (size_t)m * D, (l + 1 < DEPTH) ? (bf16*)(F.ws + WS_XN) + (size_t)m * D : (bf16*)nullptr, lane);
    }
}
using pg8::Unit;
struct SchedGrid {
    int nM, nN, G, c;
    __device__ __forceinline__ bool next(int i, Unit& u) const { const int L = i * G + c; if (L >= nM * nN) return false; pg8::map_unit(L, nM, nN, u.pm, u.pn); u.aux = 0; return true; }
};
struct SchedU {
    int G, c;
    __device__ __forceinline__ bool next(int i, Unit& u) const { const int L = i * G + c; if (L >= 3 * 512) return false; u.aux = L >> 9; pg8::map_unit(L & 511, 128, 4, u.pm, u.pn); return true; }
};
struct SchedY {
    int G, c;
    __device__ __forceinline__ bool next(int i, Unit& u) const { const int slot = i / 3, br = i - 3 * slot; const int L = slot * G + c; if (L >= 512) return false; pg8::map_unit(L, 128, 4, u.pm, u.pn); u.aux = br; return true; }
};
struct SchedMoe {
    const int* tile_e; int ntiles, G, c;
    __device__ __forceinline__ bool next(int i, Unit& u) const { const int L = i * G + c; if (L >= ntiles * 4) return false; u.pm = L >> 2; u.pn = L & 3; u.aux = __builtin_amdgcn_readfirstlane(__hip_atomic_load(tile_e + u.pm, RLX_AGENT)); return true; }
};

struct GPlain {
    static constexpr bool GATHER = false;
    const char* a_base; const char* b_base; int K, lda;
    __device__ __forceinline__ const char* a_ptr(const Unit& u) const { return a_base + (size_t)u.pm * 256 * lda * 2; }
    __device__ __forceinline__ const char* b_ptr(const Unit& u) const { return b_base + (size_t)u.pn * 256 * K * 2; }
};
struct GBranch {
    static constexpr bool GATHER = false;
    const char* a_base; const char* b_base; int K, lda;
    __device__ __forceinline__ const char* a_ptr(const Unit& u) const {
        const size_t base = u.aux == 0 ? WS_ODC : u.aux == 1 ? WS_OS : WS_OF;
        return a_base + base + (size_t)u.pm * 256 * 512 * 2;
    }
    __device__ __forceinline__ const char* b_ptr(const Unit& u) const { return b_base + ((size_t)u.aux * 1024 + (size_t)u.pn * 256) * 512 * 2; }
};
struct GGate {
    static constexpr bool GATHER = false;
    const char* a_base; const char* b_base; int K, lda;
    __device__ __forceinline__ const char* a_ptr(const Unit& u) const { return a_base + (size_t)u.pm * 256 * 1024 * 2; }
    __device__ __forceinline__ const char* b_ptr(const Unit& u) const { return b_base + ((size_t)NPROJ + (size_t)u.aux * 1024 + (size_t)u.pn * 256) * 1024 * 2; }
};
struct GMoe1 {
    static constexpr bool GATHER = true;
    const char* a_base; const char* b_base; int K; const LAS int* tab;
    __device__ __forceinline__ unsigned a_off(const Unit&, int ui, int half, int R, int C) const { return (unsigned)tab[ui * 256 + half * 128 + R] * 2048u + (unsigned)C * 2u; }
    __device__ __forceinline__ const char* b_ptr(const Unit& u) const { return b_base + ((size_t)u.aux * 1024 + (size_t)u.pn * 256) * 1024 * 2; }
};
struct GMoe2 {
    static constexpr bool GATHER = false;
    const char* a_base; const char* b_base; int K, lda;
    __device__ __forceinline__ const char* a_ptr(const Unit& u) const { return a_base + (size_t)u.pm * 256 * 512 * 2; }
    __device__ __forceinline__ const char* b_ptr(const Unit& u) const { return b_base + ((size_t)u.aux * 1024 + (size_t)u.pn * 256) * 512 * 2; }
};

typedef const f32x4 (&AccRef)[2][2][4][2];
__device__ __forceinline__ v4u pack8(f32x4 a, f32x4 b) { v4u w; w.x = cvt_pk_bf16(a[0], a[1]); w.y = cvt_pk_bf16(a[2], a[3]); w.z = cvt_pk_bf16(b[0], b[1]); w.w = cvt_pk_bf16(b[2], b[3]); return w; }
__device__ __forceinline__ void rope8(f32x4& a, f32x4& b, const float* cs, const float* sn) {
    const f32x4 c = *(const f32x4*)cs, s = *(const f32x4*)sn;
    const f32x4 a2 = {a[0] * c[0] - a[1] * s[0], a[1] * c[0] + a[0] * s[0], a[2] * c[1] - a[3] * s[1], a[3] * c[1] + a[2] * s[1]};
    const f32x4 b2 = {b[0] * c[2] - b[1] * s[2], b[1] * c[2] + b[0] * s[2], b[2] * c[3] - b[3] * s[3], b[3] * c[3] + b[2] * s[3]};
    a = a2; b = b2;
}
struct EpiProj {
    unsigned char* ws; const float* bforget;
    __device__ __forceinline__ void operator()(AccRef acc, const Unit& u, int wr, int wc, int fr, int fq) const {
        const float* cs = (const float*)(ws + WS_CS); const float* sn = (const float*)(ws + WS_SN);
        const int pn = u.pn, row0 = u.pm * 256 + wr * 64 + fr, cw = wc * 32 + 8 * fq;
        if (pn < 19) {
            const int grp = pn >> 1;
            const bool rope = (grp == 0) | (grp == 1) | (grp == 3) | (grp == 4) | (pn == 18);
            const float sc = ((grp == 0) | (grp == 3) | (grp == 6)) ? C2 : 1.f;
            bf16* base = pn < 18 ? (bf16*)(ws + WS_Z + (size_t)grp * ZG) + (pn & 1) * 256 : (bf16*)(ws + WS_IQ);
            const int pitch = pn < 18 ? 512 : 256;
#pragma unroll
            for (int ai = 0; ai < 2; ++ai)
#pragma unroll
                for (int m = 0; m < 4; ++m) { const int row = row0 + ai * 128 + m * 16;
#pragma unroll
                    for (int bj = 0; bj < 2; ++bj) { const int col = bj * 128 + cw; f32x4 v0 = acc[ai][bj][m][0], v1 = acc[ai][bj][m][1];
                        if (rope) { const int i0 = (col & 63) >> 1; rope8(v0, v1, cs + (size_t)row * 32 + i0, sn + (size_t)row * 32 + i0); }
                        v0 = v0 * sc; v1 = v1 * sc;
                        *(v4u*)(base + (size_t)row * pitch + col) = pack8(v0, v1); }
                    asm volatile("" ::: "memory"); }
        } else {
            bf16* ik = (bf16*)(ws + WS_IK); float* iw = (float*)(ws + WS_IW); float* lf = (float*)(ws + WS_LF);
#pragma unroll
            for (int ai = 0; ai < 2; ++ai)
#pragma unroll
                for (int m = 0; m < 4; ++m) { const int row = row0 + ai * 128 + m * 16;
                    f32x4 v0 = acc[ai][0][m][0], v1 = acc[ai][0][m][1];
                    if (cw < 64) { const int i0 = cw >> 1; rope8(v0, v1, cs + (size_t)row * 32 + i0, sn + (size_t)row * 32 + i0); *(v4u*)(ik + (size_t)row * 64 + cw) = pack8(v0, v1); }
                    else if (cw == 64) { *(f32x4*)(iw + (size_t)row * 4) = v0 * 0.0625f;
                        f32x4 o;
#pragma unroll
                        for (int j = 0; j < 4; ++j) { const float x = v1[j] + bforget[j]; o[j] = LOG2E * (fminf(x, 0.f) - log1pf(expf(-fabsf(x)))); }
                        *(f32x4*)(lf + (size_t)row * 8) = o; }
                    else if (cw == 72) { f32x4 o;
#pragma unroll
                        for (int j = 0; j < 4; ++j) { const float x = v0[j] + bforget[4 + j]; o[j] = LOG2E * (fminf(x, 0.f) - log1pf(expf(-fabsf(x)))); }
                        *(f32x4*)(lf + (size_t)row * 8 + 4) = o; } }
        }
    }
};
struct EpiPlain {
    bf16* O; int ldc, aux_cols;
    __device__ __forceinline__ void operator()(AccRef acc, const Unit& u, int wr, int wc, int fr, int fq) const {
        const int row0 = u.pm * 256 + wr * 64 + fr, col0 = u.aux * aux_cols + u.pn * 256 + wc * 32 + 8 * fq;
#pragma unroll
        for (int ai = 0; ai < 2; ++ai)
#pragma unroll
            for (int m = 0; m < 4; ++m) { bf16* rowp = O + (size_t)(row0 + ai * 128 + m * 16) * ldc + col0;
#pragma unroll
                for (int bj = 0; bj < 2; ++bj) *(v4u*)(rowp + bj * 128) = pack8(acc[ai][bj][m][0], acc[ai][bj][m][1]); }
    }
};
struct EpiGate {
    const bf16* U; bf16* Y;
    __device__ __forceinline__ void operator()(AccRef acc, const Unit& u, int wr, int wc, int fr, int fq) const {
        const int row0 = u.pm * 256 + wr * 64 + fr, col0 = u.pn * 256 + wc * 32 + 8 * fq;
#pragma unroll
        for (int ai = 0; ai < 2; ++ai)
#pragma unroll
            for (int m = 0; m < 4; ++m) { const size_t row = (size_t)(row0 + ai * 128 + m * 16);
#pragma unroll
                for (int bj = 0; bj < 2; ++bj) { const int col = col0 + bj * 128;
                    const v4u uu = *(const v4u*)(U + row * 3072 + u.aux * 1024 + col);
                    f32x4 a = acc[ai][bj][m][0], b = acc[ai][bj][m][1];
#pragma unroll
                    for (int j = 0; j < 4; ++j) { a[j] = sigmoidf_(a[j]); b[j] = sigmoidf_(b[j]); }
                    a[0] *= bflo(uu.x); a[1] *= bfhi(uu.x); a[2] *= bflo(uu.y); a[3] *= bfhi(uu.y);
                    b[0] *= bflo(uu.z); b[1] *= bfhi(uu.z); b[2] *= bflo(uu.w); b[3] *= bfhi(uu.w);
                    if (u.aux != 0) { const v4u yy = *(const v4u*)(Y + row * 1024 + col);
                        a[0] += bflo(yy.x); a[1] += bfhi(yy.x); a[2] += bflo(yy.y); a[3] += bfhi(yy.y);
                        b[0] += bflo(yy.z); b[1] += bfhi(yy.z); b[2] += bflo(yy.w); b[3] += bfhi(yy.w); }
                    *(v4u*)(Y + row * 1024 + col) = pack8(a, b); }
                asm volatile("" ::: "memory"); }
    }
};
struct EpiResid {
    float* H;
    __device__ __forceinline__ void operator()(AccRef acc, const Unit& u, int wr, int wc, int fr, int fq) const {
        const int row0 = u.pm * 256 + wr * 64 + fr, col0 = u.pn * 256 + wc * 32 + 8 * fq;
#pragma unroll
        for (int ai = 0; ai < 2; ++ai)
#pragma unroll
            for (int m = 0; m < 4; ++m) { float* rowp = H + (size_t)(row0 + ai * 128 + m * 16) * D + col0;
#pragma unroll
                for (int bj = 0; bj < 2; ++bj) { f32x4* p = (f32x4*)(rowp + bj * 128); const f32x4 h0 = p[0], h1 = p[1];
                    p[0] = h0 * ALPHA + acc[ai][bj][m][0]; p[1] = h1 * ALPHA + acc[ai][bj][m][1]; }
                asm volatile("" ::: "memory"); }
    }
};
struct EpiSwiglu {
    bf16* Hd;
    __device__ __forceinline__ void operator()(AccRef acc, const Unit& u, int wr, int wc, int fr, int fq) const {
        const int row0 = u.pm * 256 + wr * 64 + fr, col0 = u.pn * 128 + wc * 32 + 8 * fq;
#pragma unroll
        for (int ai = 0; ai < 2; ++ai)
#pragma unroll
            for (int m = 0; m < 4; ++m) { f32x4 a = acc[ai][0][m][0], b = acc[ai][0][m][1]; const f32x4 ua = acc[ai][1][m][0], ub = acc[ai][1][m][1];
#pragma unroll
                for (int j = 0; j < 4; ++j) { a[j] = a[j] * sigmoidf_(a[j]) * ua[j]; b[j] = b[j] * sigmoidf_(b[j]) * ub[j]; }
                *(v4u*)(Hd + (size_t)(row0 + ai * 128 + m * 16) * DE + col0) = pack8(a, b); }
    }
};
namespace attn_body {
using bf16=__hip_bfloat16;
typedef unsigned long long u64x8 __attribute__((ext_vector_type(8)));
using bf16x8=__attribute__((ext_vector_type(8)))short;
using s16x4=__attribute__((ext_vector_type(4)))short;
using f32x16=__attribute__((ext_vector_type(16)))float;
using u32x4=__attribute__((ext_vector_type(4)))unsigned;
constexpr int SEQ=4096,D=64,DM=512;
constexpr int NW=8,QBLK=32,QB=QBLK*NW,KVBLK=64,NQB=SEQ/QB;
constexpr int ATTN_PITCH=DM, ATTN_UNIT_ROWS=QB;
__device__ __forceinline__ int crow(int r,int hi){return (r&3)+8*(r>>2)+4*hi;}
#define SBAR() __builtin_amdgcn_sched_barrier(0)
__device__ __forceinline__ void cmask(f32x16&p0,f32x16&p1,int jb,int qrel,int hi){
  const float NEG=-INFINITY; int kb=64*jb+4*hi;
  #pragma unroll
  for(int r=0;r<16;++r){int kv=kb+(r&3)+8*(r>>2); if(kv>qrel)p0[r]=NEG; if(kv+32>qrel)p1[r]=NEG;}
}

__device__ __forceinline__ void chunkmask(f32x16&p0,f32x16&p1,int jb,int wid){
  if(jb>(wid>>1)){ const float NEG=-INFINITY;
    #pragma unroll
    for(int r=0;r<16;++r){p0[r]=NEG;p1[r]=NEG;} }
}
constexpr int NSLOT=3, SLOTB=8192;
constexpr int LDS_K=0, LDS_V=NSLOT*SLOTB, LDS_WS=2*NSLOT*SLOTB, LDS_OST=LDS_WS+NW*64*4, LDS_CBT=LDS_OST+NW*4096, LDS_BYTES=LDS_CBT+16384;
constexpr float C2=0.125f*1.4426950408889634f;
__device__ __forceinline__ void glds16(const void*gsrc,unsigned lds_dst){unsigned keep;
  asm volatile("s_mov_b32 %0, m0\n\ts_mov_b32 m0, %2\n\ts_nop 0\n\tglobal_load_lds_dwordx4 %1, off\n\ts_mov_b32 m0, %0":"=&s"(keep):"v"(gsrc),"s"(lds_dst):"memory");}
__device__ __forceinline__ float max3f(float a,float b,float c){float r;asm("v_max3_f32 %0, %1, %2, %3":"=v"(r):"v"(a),"v"(b),"v"(c));return r;}
__device__ __forceinline__ float max2f(float a,float b){float r;asm("v_max_f32_e32 %0, %1, %2":"=v"(r):"v"(a),"v"(b));return r;}
__device__ __forceinline__ float fadd_s(float a,float b){float r;asm("v_add_f32_e32 %0, %1, %2":"=v"(r):"v"(a),"v"(b));return r;}
__device__ __forceinline__ float fsub_s(float a,float b){float r;asm("v_sub_f32_e32 %0, %1, %2":"=v"(r):"v"(a),"v"(b));return r;}
typedef float f32x2_t __attribute__((ext_vector_type(2))); typedef float f32x4_t __attribute__((ext_vector_type(4))); typedef __bf16 bf16x2_t __attribute__((ext_vector_type(2)));
__device__ __forceinline__ unsigned cvtpk_s(float lo,float hi){f32x2_t v={lo,hi};bf16x2_t b=__builtin_convertvector(v,bf16x2_t);return __builtin_bit_cast(unsigned,b);}
#define WAIT_BAR(N) asm volatile("s_waitcnt vmcnt(" #N ") lgkmcnt(0)\n\ts_barrier":::"memory")

__device__ __forceinline__ void qkt(f32x16&p0,f32x16&p1,const char*Kslot,const bf16x8*qr,int r32,int hi){ const f32x16 negm=f32x16{};
  const char*kb=Kslot+hi*1024+r32*16;
  #pragma unroll
  for(int d0=0;d0<4;++d0){
    const bf16x8 b0=*reinterpret_cast<const bf16x8*>(kb+d0*2048);
    const bf16x8 b1=*reinterpret_cast<const bf16x8*>(kb+d0*2048+512);
    if(d0==0){p0=__builtin_amdgcn_mfma_f32_32x32x16_bf16(b0,qr[0],negm,0,0,0);p1=__builtin_amdgcn_mfma_f32_32x32x16_bf16(b1,qr[0],negm,0,0,0);}
    else{p0=__builtin_amdgcn_mfma_f32_32x32x16_bf16(b0,qr[d0],p0,0,0,0);p1=__builtin_amdgcn_mfma_f32_32x32x16_bf16(b1,qr[d0],p1,0,0,0);}}
}
typedef __attribute__((address_space(3))) const char* lds_cptr;
typedef short v4i16_t __attribute__((ext_vector_type(4)));
__device__ __forceinline__ void kload8(bf16x8*kf,lds_cptr kp){
  kf[0]=*(const __attribute__((address_space(3))) bf16x8*)(kp);      kf[1]=*(const __attribute__((address_space(3))) bf16x8*)(kp+512);
  kf[2]=*(const __attribute__((address_space(3))) bf16x8*)(kp+2048); kf[3]=*(const __attribute__((address_space(3))) bf16x8*)(kp+2560);
  kf[4]=*(const __attribute__((address_space(3))) bf16x8*)(kp+4096); kf[5]=*(const __attribute__((address_space(3))) bf16x8*)(kp+4608);
  kf[6]=*(const __attribute__((address_space(3))) bf16x8*)(kp+6144); kf[7]=*(const __attribute__((address_space(3))) bf16x8*)(kp+6656);
}
__device__ __forceinline__ void kload2(bf16x8*kf,lds_cptr kp,int j){ kf[2*j]=*(const __attribute__((address_space(3))) bf16x8*)(kp+j*2048); kf[2*j+1]=*(const __attribute__((address_space(3))) bf16x8*)(kp+j*2048+512); }
__device__ __forceinline__ s16x4 vtr(lds_cptr p){ return __builtin_bit_cast(s16x4,__builtin_amdgcn_ds_read_tr16_b64_v4i16((__attribute__((address_space(3))) v4i16_t*)p)); }
__device__ __forceinline__ float rowmax(const f32x16&p0,const f32x16&p1){
  float a=max3f(p0[0],p0[1],p1[0]),b=max3f(p0[2],p0[3],p1[1]);a=max3f(a,p1[2],p1[3]);
  #pragma unroll
  for(int r=4;r<16;r+=4){a=max3f(a,p0[r],p0[r+1]);b=max3f(b,p0[r+2],p0[r+3]);a=max3f(a,p1[r],p1[r+1]);b=max3f(b,p1[r+2],p1[r+3]);}
  const float m=max2f(a,b);
  auto rr=__builtin_amdgcn_permlane32_swap(__float_as_uint(m),__float_as_uint(m),false,false);
  return max2f(__uint_as_float(rr[0]),__uint_as_float(rr[1]));
}
__device__ __forceinline__ void pv(f32x16*o,int vb,bf16x8 pa0,bf16x8 pa1,bf16x8 pa2,bf16x8 pa3){
  #pragma unroll
  for(int d0=0;d0<2;++d0){s16x4 lo[4],hi[4];
    #pragma unroll
    for(int ks=0;ks<4;++ks){
      asm volatile("ds_read_b64_tr_b16 %0,%1 offset:%c2":"=&v"(lo[ks]):"v"(vb),"i"(d0*4096+ks*1024):"memory");
      asm volatile("ds_read_b64_tr_b16 %0,%1 offset:%c2":"=&v"(hi[ks]):"v"(vb),"i"(d0*4096+ks*1024+512):"memory");}
    asm volatile("s_waitcnt lgkmcnt(0)":::"memory");SBAR();
    #define PK(k) (bf16x8){lo[k][0],lo[k][1],lo[k][2],lo[k][3],hi[k][0],hi[k][1],hi[k][2],hi[k][3]}
    o[d0]=__builtin_amdgcn_mfma_f32_32x32x16_bf16(pa0,PK(0),o[d0],0,0,0);
    o[d0]=__builtin_amdgcn_mfma_f32_32x32x16_bf16(pa1,PK(1),o[d0],0,0,0);
    o[d0]=__builtin_amdgcn_mfma_f32_32x32x16_bf16(pa2,PK(2),o[d0],0,0,0);
    o[d0]=__builtin_amdgcn_mfma_f32_32x32x16_bf16(pa3,PK(3),o[d0],0,0,0);
    #undef PK
  }
}

#ifndef ATTN_STORE16
#define ATTN_STORE16(p,v) (*(u32x4*)(p)=(v))
#endif
template<int THRL,int MODE,int PO> __device__ __forceinline__ void attn_unit(int b,int qb,const bf16*Q,const bf16*K,const bf16*V,bf16*O,char*shm,const unsigned long long*masks,int tid){
  asm volatile("":"+v"(tid));
  const int lane=tid&63,r32=lane&31,hi=lane>>5; const int wid=__builtin_amdgcn_readfirstlane(tid>>6);
  const long rowbase=(long)b*SEQ; const int q0=qb*QB;
  const bf16*Qw=Q+(rowbase+q0+wid*QBLK)*DM;
  const bf16*Kh=K+rowbase*DM,*Vh=V+rowbase*DM;
  const unsigned lds0=(unsigned)(uintptr_t)shm;
  float*wsf=(float*)(shm+LDS_WS)+wid*64;
  const bf16*ksrc=Kh+(long)lane*DM+wid*8;
  const bf16*vsrc=Vh+(long)(16*(wid&3)+(lane>>2))*DM+(wid>>2)*32+(lane&3)*8;
  const unsigned kdst=lds0+LDS_K+wid*1024, vdst=lds0+LDS_V+wid*1024;
  #define DMA_K(t,slot) glds16(ksrc+(long)(t)*KVBLK*DM,(unsigned)__builtin_amdgcn_readfirstlane(kdst+(slot)))
  #define DMA_V(t,slot) glds16(vsrc+(long)(t)*KVBLK*DM,(unsigned)__builtin_amdgcn_readfirstlane(vdst+(slot)))
  const int vb0=(int)(lds0+LDS_V)+((lane>>4)&1)*32+(lane&3)*8+(4*hi+((lane&15)>>2))*64;
  const char*Kbase=shm+LDS_K; bf16x8 kf[8];
  const lds_cptr shm3=(lds_cptr)shm; const lds_cptr shm3c=shm3; const lds_cptr kp0=shm3+LDS_K+hi*1024+r32*16; const lds_cptr vp0=shm3+LDS_V+((lane>>4)&1)*32+(lane&3)*8+(4*hi+((lane&15)>>2))*64;
  const int NT=(q0+QB)/KVBLK;
  DMA_K(0,0);DMA_V(0,0);DMA_K(1,SLOTB);
  bf16x8 qr[4];
  #pragma unroll
  for(int d0=0;d0<4;++d0)qr[d0]=*reinterpret_cast<const bf16x8*>(&Qw[(long)r32*DM+d0*16+hi*8]);
  float mhat=0.f,l_reg=0.f;f32x16 o[2];o[0]=f32x16{};o[1]=f32x16{};const f32x16 ZERO16=f32x16{};
  const int qrel=wid*QBLK+r32;
  #define CMASK(P0,P1,t) do{ if(MODE!=2){ int jb_=(t)-(NT-4); if(jb_>=0){ if(MODE==0)chunkmask(P0,P1,jb_,wid); else cmask(P0,P1,jb_,qrel,hi);} } }while(0)
  const __attribute__((address_space(3))) float*ctab=(const __attribute__((address_space(3))) float*)(shm3c+LDS_CBT)+4*hi;
  const unsigned long long*mwave=masks+((size_t)(b*(SEQ/32)+(q0>>5)+wid)*(SEQ/64))*32;
  const float NEGINF=-INFINITY;
  #define CND(x,m) asm volatile("v_cndmask_b32_e64 %0, %2, %0, %1":"+v"(x):"s"(m),"v"(NEGINF))
  #define HOOK(P0,P1,t) do{ \
    if(MODE==1){ _Pragma("unroll") for(int g_=0;g_<4;++g_){ const f32x4_t b0_=*(const __attribute__((address_space(3))) f32x4_t*)(ctab+64*(t)+8*g_), b1_=*(const __attribute__((address_space(3))) f32x4_t*)(ctab+64*(t)+8*g_+32); \
        _Pragma("unroll") for(int i_=0;i_<4;++i_){ P0[4*g_+i_]-=b0_[i_]; P1[4*g_+i_]-=b1_[i_]; } asm volatile("":::"memory"); } } \
    if(MODE==2){ const unsigned long long*mp_=mwave+(size_t)(t)*32; \
      const unsigned lo_=__builtin_amdgcn_readfirstlane((unsigned)(uintptr_t)mp_), hi_=__builtin_amdgcn_readfirstlane((unsigned)((uintptr_t)mp_>>32)); \
      const unsigned long long ma_=((unsigned long long)hi_<<32)|lo_; u64x8 ka_,kb_; \
      asm volatile("s_load_dwordx16 %0, %2, 0x0\n\ts_load_dwordx16 %1, %2, 0x40\n\ts_waitcnt lgkmcnt(0)":"=&s"(ka_),"=&s"(kb_):"s"(ma_):"memory"); \
      _Pragma("unroll") for(int r_=0;r_<8;++r_){ CND(P0[r_],ka_[r_]); CND(P0[8+r_],kb_[r_]); } \
      asm volatile("s_load_dwordx16 %0, %2, 0x80\n\ts_load_dwordx16 %1, %2, 0xc0\n\ts_waitcnt lgkmcnt(0)":"=&s"(ka_),"=&s"(kb_):"s"(ma_):"memory"); \
      _Pragma("unroll") for(int r_=0;r_<8;++r_){ CND(P1[r_],ka_[r_]); CND(P1[8+r_],kb_[r_]); } } }while(0)
  bool resc=false;
  #define START(P0,P1) do{ const float rm=rowmax(P0,P1); resc=false; \
    { const float dl=__builtin_fmaxf(rm,-256.f); mhat=fadd_s(mhat,dl); \
      _Pragma("unroll") for(int r=0;r<16;++r){P0[r]=fsub_s(P0[r],dl);P1[r]=fsub_s(P1[r],dl);} \
      } \
    _Pragma("unroll") for(int r=0;r<16;++r)P0[r]=__builtin_amdgcn_exp2f(P0[r]); }while(0)
  #define RESC() do{ if(resc){ asm volatile("s_waitcnt lgkmcnt(0)":::"memory"); \
      _Pragma("unroll") for(int d_=0;d_<2;++d_) _Pragma("unroll") for(int r=0;r<16;++r)o[d_][r]*=wsf[crow(r,hi)]; } }while(0)
  f32x16 pA0,pA1,pB0,pB1;
  int sl_prev=0,sl_cur=0,sl_next=SLOTB;
  #define ROT() do{sl_prev=sl_cur;sl_cur=sl_next;sl_next=(sl_next==(NSLOT-1)*SLOTB)?0:sl_next+SLOTB;}while(0)
  DMA_K(2,2*SLOTB);
  WAIT_BAR(3);
  qkt(pA0,pA1,Kbase,qr,r32,hi);asm volatile("s_nop 15\n\ts_nop 7":"+v"(pA0),"+v"(pA1));HOOK(pA0,pA1,0);CMASK(pA0,pA1,0);
  START(pA0,pA1);
  _Pragma("unroll") for(int r=0;r<16;++r)pA1[r]=__builtin_amdgcn_exp2f(pA1[r]);
  WAIT_BAR(0);
  DMA_K(3,0);DMA_V(1,SLOTB);
  ROT();
  kload8(kf,kp0+sl_cur);
  WAIT_BAR(2);
  s16x4 vlo[8],vhi[8]; u32x4 pw0,pw1,pw2,pw3;
  #define PKW(P,B) cvtpk_s(P[B],P[B+1])
  #define PAF(k) __builtin_bit_cast(bf16x8,pw##k)
  #define VFR(i) (bf16x8){vlo[i][0],vlo[i][1],vlo[i][2],vlo[i][3],vhi[i][0],vhi[i][1],vhi[i][2],vhi[i][3]}
  #define PIN(x) asm volatile("":"+v"(x))
  #define MX3(a,b,c) __builtin_fmaxf(__builtin_fmaxf((a),(b)),(c))
  #define GAPA(MF,A0,A1,A2,A3,W0,W1,PW) do{ MF; sacc+=A0; sacc+=A1; sacc+=A2; sacc+=A3; PIN(sacc); W0; W1; PIN(PW); SBAR(); }while(0)
  #define EX(v) __builtin_amdgcn_exp2f(v)
  #define GAPB(MF,X,B) do{ MF; X[B]=EX(X[B]); X[B+1]=EX(X[B+1]); X[B+2]=EX(X[B+2]); X[B+3]=EX(X[B+3]); PIN(X); SBAR(); }while(0)
  #define VRD(i) do{ vlo[i]=vtr(vp_+(((i)>>2)*4096+((i)&3)*1024)); vhi[i]=vtr(vp_+(((i)>>2)*4096+((i)&3)*1024+512)); }while(0)
  #define KRD(G,j) do{ if(G){ kload2(kf,kp0+sl_next,j); SBAR(); } }while(0)
  #define STEP(C0,C1,P0,P1,t,GK,GV,GL) do{ SBAR(); \
    const lds_cptr vp_=vp0+sl_prev; \
    VRD(0); SBAR(); float sacc=(P0[0]+P0[1]); \
    GAPA(C0=__builtin_amdgcn_mfma_f32_32x32x16_bf16(kf[0],qr[0],ZERO16,0,0,0), P0[2],P0[3],P0[4],P0[5],     pw0[0]=PKW(P0,0), pw0[1]=PKW(P0,2), pw0); \
    VRD(4); SBAR(); GAPA(C1=__builtin_amdgcn_mfma_f32_32x32x16_bf16(kf[1],qr[0],ZERO16,0,0,0), P0[6],P0[7],P0[8],P0[9],     pw0[2]=PKW(P0,4), pw0[3]=PKW(P0,6), pw0); \
    VRD(1); SBAR(); GAPA(C0=__builtin_amdgcn_mfma_f32_32x32x16_bf16(kf[2],qr[1],C0,0,0,0),   P0[10],P0[11],P0[12],P0[13], pw1[0]=PKW(P0,8), pw1[1]=PKW(P0,10), pw1); \
    VRD(5); SBAR(); GAPA(C1=__builtin_amdgcn_mfma_f32_32x32x16_bf16(kf[3],qr[1],C1,0,0,0),   P0[14],P0[15],P1[0],P1[1],   pw1[2]=PKW(P0,12),pw1[3]=PKW(P0,14), pw1); \
    VRD(2); SBAR(); GAPA(C0=__builtin_amdgcn_mfma_f32_32x32x16_bf16(kf[4],qr[2],C0,0,0,0),   P1[2],P1[3],P1[4],P1[5],     pw2[0]=PKW(P1,0), pw2[1]=PKW(P1,2), pw2); \
    VRD(6); SBAR(); GAPA(C1=__builtin_amdgcn_mfma_f32_32x32x16_bf16(kf[5],qr[2],C1,0,0,0),   P1[6],P1[7],P1[8],P1[9],     pw2[2]=PKW(P1,4), pw2[3]=PKW(P1,6), pw2); \
    VRD(3); SBAR(); GAPA(C0=__builtin_amdgcn_mfma_f32_32x32x16_bf16(kf[6],qr[3],C0,0,0,0),   P1[10],P1[11],P1[12],P1[13], pw3[0]=PKW(P1,8), pw3[1]=PKW(P1,10), pw3); \
    VRD(7); SBAR(); GAPA(C1=__builtin_amdgcn_mfma_f32_32x32x16_bf16(kf[7],qr[3],C1,0,0,0),   P1[14],P1[15],0.f,0.f,       pw3[2]=PKW(P1,12),pw3[3]=PKW(P1,14), pw3); \
    l_reg+=sacc; \
    if(GK){DMA_K((t)+3,sl_cur);} if(GV){DMA_V((t)+1,sl_next);} \
    { _Pragma("unroll") for(int r=0;r<16;++r){C0[r]-=mhat;C1[r]-=mhat;} } HOOK(C0,C1,t); CMASK(C0,C1,t); \
    { float a=MX3(C0[0],C0[1],C1[0]),b=MX3(C0[2],C0[3],C1[1]); a=MX3(a,C1[2],C1[3]); \
      _Pragma("unroll") for(int r=4;r<16;r+=4){a=MX3(a,C0[r],C0[r+1]);b=MX3(b,C0[r+2],C0[r+3]);a=MX3(a,C1[r],C1[r+1]);b=MX3(b,C1[r+2],C1[r+3]);} \
      float rm=__builtin_fmaxf(a,b); { auto rr=__builtin_amdgcn_permlane32_swap(__float_as_uint(rm),__float_as_uint(rm),false,false); rm=__builtin_fmaxf(__uint_as_float(rr[0]),__uint_as_float(rr[1])); } \
      resc=false; \
      if(__builtin_expect(__any(rm>(float)THRL),0)){ const float dl=__builtin_fmaxf(rm,0.f); mhat+=dl; \
        _Pragma("unroll") for(int r=0;r<16;++r){C0[r]-=dl;C1[r]-=dl;} \
        const float f=__builtin_amdgcn_exp2f(-dl); l_reg*=f; if(hi==0)wsf[r32]=f; resc=true; } } \
    SBAR(); \
    GAPB(o[0]=__builtin_amdgcn_mfma_f32_32x32x16_bf16(PAF(0),VFR(0),o[0],0,0,0), C0,0); \
    GAPB(o[1]=__builtin_amdgcn_mfma_f32_32x32x16_bf16(PAF(0),VFR(4),o[1],0,0,0), C0,4); \
    KRD(GL,0); GAPB(o[0]=__builtin_amdgcn_mfma_f32_32x32x16_bf16(PAF(1),VFR(1),o[0],0,0,0), C0,8); \
    KRD(GL,1); GAPB(o[1]=__builtin_amdgcn_mfma_f32_32x32x16_bf16(PAF(1),VFR(5),o[1],0,0,0), C0,12); \
    KRD(GL,2); GAPB(o[0]=__builtin_amdgcn_mfma_f32_32x32x16_bf16(PAF(2),VFR(2),o[0],0,0,0), C1,0); \
    KRD(GL,3); GAPB(o[1]=__builtin_amdgcn_mfma_f32_32x32x16_bf16(PAF(2),VFR(6),o[1],0,0,0), C1,4); \
    GAPB(o[0]=__builtin_amdgcn_mfma_f32_32x32x16_bf16(PAF(3),VFR(3),o[0],0,0,0), C1,8); \
    GAPB(o[1]=__builtin_amdgcn_mfma_f32_32x32x16_bf16(PAF(3),VFR(7),o[1],0,0,0), C1,12); \
    }while(0)
  int t=1;
  #undef CMASK
  #define CMASK(P0,P1,t) do{}while(0)
  for(;t+5<NT;t+=2){
    STEP(pB0,pB1,pA0,pA1,t,true,true,true);     WAIT_BAR(2); RESC(); ROT();
    STEP(pA0,pA1,pB0,pB1,t+1,true,true,true);   WAIT_BAR(2); RESC(); ROT();
  }
  #undef CMASK
  #define CMASK(P0,P1,t) do{ if(MODE!=2){ int jb_=(t)-(NT-4); if(jb_>=0){ if(MODE==0)chunkmask(P0,P1,jb_,wid); else cmask(P0,P1,jb_,qrel,hi);} } }while(0)
  #define ENDW(tt) do{ if((tt)+3<NT){WAIT_BAR(2);} else if((tt)+2<NT){WAIT_BAR(1);} else {WAIT_BAR(0);} }while(0)
  for(;t+1<NT;t+=2){
    STEP(pB0,pB1,pA0,pA1,t,(t+3<NT),(t+1<NT),(t+1<NT));       ENDW(t);   RESC(); ROT();
    STEP(pA0,pA1,pB0,pB1,t+1,(t+4<NT),(t+2<NT),(t+2<NT));     ENDW(t+1); RESC(); ROT();
  }
  STEP(pB0,pB1,pA0,pA1,NT-1,false,false,false); RESC();
  { float sacc=pB0[0]+pB0[1]; _Pragma("unroll") for(int r=2;r<16;++r)sacc+=pB0[r]; _Pragma("unroll") for(int r=0;r<16;++r)sacc+=pB1[r]; l_reg+=sacc;
    pw0=(u32x4){PKW(pB0,0),PKW(pB0,2),PKW(pB0,4),PKW(pB0,6)};pw1=(u32x4){PKW(pB0,8),PKW(pB0,10),PKW(pB0,12),PKW(pB0,14)};pw2=(u32x4){PKW(pB1,0),PKW(pB1,2),PKW(pB1,4),PKW(pB1,6)};pw3=(u32x4){PKW(pB1,8),PKW(pB1,10),PKW(pB1,12),PKW(pB1,14)};
    SBAR(); pv(o,vb0+sl_cur,PAF(0),PAF(1),PAF(2),PAF(3)); }
  #undef PKW
  #undef PAF
  #undef VFR
  #undef PIN
  #undef MX3
  #undef GAPA
  #undef GAPB
  #undef EX
  #undef VRD
  #undef KRD
  #undef STEP
  #undef ENDW
  {auto rr=__builtin_amdgcn_permlane32_swap(__float_as_uint(l_reg),__float_as_uint(l_reg),false,false);l_reg=__uint_as_float(rr[0])+__uint_as_float(rr[1]);}
  if(hi==0)wsf[32+r32]=l_reg;asm volatile("s_waitcnt lgkmcnt(0)":::"memory");
  float rli[16];
  #pragma unroll
  for(int r=0;r<16;++r)rli[r]=__builtin_amdgcn_rcpf(wsf[32+crow(r,hi)]);
  bf16*Ow=O+(rowbase+q0+wid*QBLK)*PO;
  { bf16*stg=(bf16*)(shm+LDS_OST)+wid*2048;
    #pragma unroll
    for(int r=0;r<16;++r){const int orow=crow(r,hi);
      #pragma unroll
      for(int d0=0;d0<2;++d0)stg[orow*64+d0*32+r32]=__float2bfloat16(o[d0][r]*rli[r]);}
    asm volatile("s_waitcnt lgkmcnt(0)":::"memory");
    #pragma unroll
    for(int i=0;i<4;++i){const int row=i*8+(lane>>3),ch=lane&7; const u32x4 v=*(const u32x4*)(stg+row*64+ch*8); ATTN_STORE16(Ow+(long)row*PO+ch*8,v);} }
  asm volatile("s_waitcnt lgkmcnt(0)\n\ts_barrier":::"memory");
  #undef DMA_K
  #undef DMA_V
  #undef CMASK
  #undef HOOK
  #undef CND
  #undef START
  #undef RESC
  #undef ROT
}
constexpr int ATTN_LDS_BYTES=LDS_BYTES;
#undef SBAR
#undef WAIT_BAR
}

__device__ __forceinline__ void attention_phase(Frame& F, char* lds_g, int amask, int l) {
    using namespace attn_body;
    typedef attn_body::bf16 abf;
    const int v = F.vcu, b = v >> 5, he = v & 31;
    unsigned char* ws = F.ws;
#ifndef AMODES
#define AMODES 7
#endif
    if (he < 16) {
        if (!(AMODES & 1) || !(amask & 1)) return;
        const int hm = he >> 1, vh = he & 1;
        const abf* Q = (const abf*)(ws + WS_Z) + hm * 64; const abf* K = (const abf*)(ws + WS_Z + ZG) + hm * 64; const abf* V = (const abf*)(ws + WS_Z + 2 * ZG) + (hm >> 1) * 128 + vh * 64;
        abf* O = (abf*)(ws + WS_OD) + hm * 128 + vh * 64;
        for (int qb = 15; qb >= 0; --qb) attn_unit<8, 0, 1024>(b, qb, Q, K, V, O, lds_g, nullptr, F.tid);
    } else if (he < 24) {
        if (!(AMODES & 2) || !(amask & 2)) return;
        const int h = he - 16;
        const abf* Q = (const abf*)(ws + WS_Z + 3 * ZG) + h * 64; const abf* K = (const abf*)(ws + WS_Z + 4 * ZG) + h * 64; const abf* V = (const abf*)(ws + WS_Z + 5 * ZG) + h * 64;
        abf* O = (abf*)(ws + WS_OS) + h * 64;
        for (int qb = 15; qb >= 0; --qb) attn_unit<8, 2, 512>(b, qb, Q, K, V, O, lds_g, (const unsigned long long*)(ws + (l == 0 ? WS_MASK : WS_MASK1)), F.tid);
    } else {
        if (!(AMODES & 4) || !(amask & 4)) return;
        const int h = he - 24;
        { LAS float* ct = (LAS float*)(F.lds + RING_OFF + LDS_CBT); const float* cb = (const float*)(ws + WS_CB) + (size_t)(b * 8 + h) * S;
          for (int i = F.tid; i < S; i += NWAVES * 64) ct[i] = cb[i];
          __syncthreads(); }
        const abf* Q = (const abf*)(ws + WS_Z + 6 * ZG) + h * 64; const abf* K = (const abf*)(ws + WS_Z + 7 * ZG) + h * 64; const abf* V = (const abf*)(ws + WS_Z + 8 * ZG) + h * 64;
        abf* O = (abf*)(ws + WS_OF) + h * 64;
        for (int qb = 15; qb >= 0; --qb) attn_unit<8, 1, 512>(b, qb, Q, K, V, O, lds_g, nullptr, F.tid);
    }
}
namespace dsa_sel {
typedef float f32x16 __attribute__((ext_vector_type(16)));
constexpr int HP = 257;
constexpr int L_HIST = 0, L_PREFIX = 64 * HP * 4, L_KK = L_PREFIX + 256, L_TAU = L_KK + 256, L_NEED = L_TAU + 256, L_TSEL = L_NEED + 256, L_IDXT = L_TSEL + 256, L_FLAG = L_IDXT + 256;
__device__ __forceinline__ unsigned f2key(float f) { unsigned u = __float_as_uint(f); if (u == 0x80000000u) u = 0u; return (u & 0x80000000u) ? ~u : (u | 0x80000000u); }
__device__ __forceinline__ int crow(int r, int hi) { return (r & 3) + 8 * (r >> 2) + 4 * hi; }

template <int PM>
__device__ __forceinline__ void sweep(const unsigned short* ikb  , const bf16x8 (&qf)[4][4], const f32x4& iw, int ntile, int kq, int lane, int ql  ,
                                      LAS unsigned* lds32, int shift, unsigned long long* mout  ) {
    const int i32 = lane & 31, hi = lane >> 5;
    LAS unsigned* hist = lds32 + (L_HIST / 4) + ql * HP;
    unsigned prefix = 0, tau = 0, need = 0, tsel = 0, idxt = 0;
    if (PM == 0) prefix = lds32[L_PREFIX / 4 + ql];
    if (PM >= 1) tau = lds32[L_TAU / 4 + ql];
    if (PM == 2) tsel = lds32[L_TSEL / 4 + ql];
    if (PM == 3) idxt = lds32[L_IDXT / 4 + ql];
    (void)need;
    for (int t = kq; t < ntile; t += 4) {
        unsigned long long mine = 0ull;
#pragma unroll
        for (int kh = 0; kh < 2; ++kh) {
            bf16x8 kf[4];
#pragma unroll
            for (int ds = 0; ds < 4; ++ds) kf[ds] = *(const bf16x8*)(ikb + (size_t)(64 * t + 32 * kh + i32) * 64 + 16 * ds + 8 * hi);
            f32x16 sc;
#pragma unroll
            for (int h = 0; h < 4; ++h) {
                f32x16 a = {};
#pragma unroll
                for (int ds = 0; ds < 4; ++ds) a = __builtin_amdgcn_mfma_f32_32x32x16_bf16(kf[ds], qf[h][ds], a, 0, 0, 0);
                const float w = iw[h];
                if (h == 0) {
#pragma unroll
                    for (int r = 0; r < 16; ++r) sc[r] = w * fmaxf(a[r], 0.f);
                } else {
#pragma unroll
                    for (int r = 0; r < 16; ++r) sc[r] = fmaf(w, fmaxf(a[r], 0.f), sc[r]);
                }
            }
#pragma unroll
            for (int r = 0; r < 16; ++r) {
                const unsigned key = f2key(sc[r]);
                if (PM == 0) {
                    const bool match = (shift == 24) || ((key >> (shift + 8)) == prefix);
                    if (match) __hip_atomic_fetch_add(hist + ((key >> shift) & 255u), 1u, __ATOMIC_RELAXED, __HIP_MEMORY_SCOPE_WORKGROUP);
                } else if (PM == 1) {
                    if (key == tau) __hip_atomic_fetch_add(hist + t, 1u, __ATOMIC_RELAXED, __HIP_MEMORY_SCOPE_WORKGROUP);
                } else if (PM == 2) {
                    if (key == tau && (unsigned)t == tsel) __hip_atomic_fetch_add(hist + (32 * kh + crow(r, hi)), 1u, __ATOMIC_RELAXED, __HIP_MEMORY_SCOPE_WORKGROUP);
                } else {
                    const unsigned idx = (unsigned)(64 * t + 32 * kh + crow(r, hi));
                    const bool sel = key > tau || (key == tau && idx <= idxt);
                    const unsigned long long bal = __ballot(sel);
                    if (lane == kh * 16 + r) mine = bal;
                }
            }
            asm volatile("" ::: "memory");
        }
        if (PM == 3) { if (lane < 32) mout[(size_t)t * 32 + lane] = mine; }
    }
}

__device__ __forceinline__ void select_phase(Frame& F, int l) {
    const int tid = F.tid, lane = F.lane, wid = F.wave;
    const int v = F.vcu, b = v >> 5, s = v & 31;
    const int qg = wid & 1, kq = wid >> 1;
    LAS unsigned* lds32 = (LAS unsigned*)(F.lds + RING_OFF);
    unsigned char* ws = F.ws;
    const unsigned short* ikb = (const unsigned short*)(ws + WS_IK) + (size_t)b * S * 64;
    unsigned long long* masks = (unsigned long long*)(ws + (l == 0 ? WS_MASK : WS_MASK1));
    for (int uu = 0; uu < 2; ++uu) {
        const int c = uu == 0 ? 63 - s : s;
        const int ntile = c + 1, q0 = c * 64;
        const int ql = 32 * qg + (lane & 31);
        const size_t qrow = (size_t)b * S + q0 + ql;
        unsigned long long* mout = masks + ((size_t)(b * 128 + (q0 >> 5) + qg) * 64) * 32;
        const int tend = 4 * (c >> 2) + 4;
        for (int t = ntile + kq; t < tend; t += 4) { if (lane < 32) mout[(size_t)t * 32 + lane] = 0ull; }
        if (ntile <= 4) {
            for (int t = kq; t < ntile; t += 4) { if (lane < 32) mout[(size_t)t * 32 + lane] = ~0ull; }
            continue;
        }
        bf16x8 qf[4][4]; f32x4 iw;
        {
            const unsigned short* iq = (const unsigned short*)(ws + WS_IQ) + qrow * 256;
#pragma unroll
            for (int h = 0; h < 4; ++h)
#pragma unroll
                for (int ds = 0; ds < 4; ++ds) qf[h][ds] = *(const bf16x8*)(iq + h * 64 + 16 * ds + 8 * (lane >> 5));
            iw = *(const f32x4*)((const float*)(ws + WS_IW) + qrow * 4);
        }
        if (tid < 64) { lds32[L_PREFIX / 4 + tid] = 0u; lds32[L_KK / 4 + tid] = 256u; }
        if (tid == 0) lds32[L_FLAG / 4] = 0u;
        for (int pass = 0; pass < 4; ++pass) {
            for (int i = tid; i < 64 * HP; i += NWAVES * 64) lds32[L_HIST / 4 + i] = 0u;
            __syncthreads();
            sweep<0>(ikb, qf, iw, ntile, kq, lane, ql, lds32, 24 - 8 * pass, nullptr);
            __syncthreads();
            if (tid < 64) {
                LAS unsigned* hq = lds32 + (L_HIST / 4) + tid * HP;
                const unsigned kk = lds32[L_KK / 4 + tid]; unsigned cum = 0; int d = 255;
                for (; d > 0; --d) { const unsigned hv = hq[d]; if (cum + hv >= kk) break; cum += hv; }
                const unsigned np = (lds32[L_PREFIX / 4 + tid] << 8) | (unsigned)d, nk = kk - cum;
                lds32[L_PREFIX / 4 + tid] = np; lds32[L_KK / 4 + tid] = nk;
                if (pass == 3) { lds32[L_TAU / 4 + tid] = np; lds32[L_NEED / 4 + tid] = nk; lds32[L_IDXT / 4 + tid] = 0xffffu;
                    if (hq[d] != nk) __hip_atomic_fetch_or(lds32 + L_FLAG / 4, 1u, __ATOMIC_RELAXED, __HIP_MEMORY_SCOPE_WORKGROUP); }
            }
            __syncthreads();
        }
        if (lds32[L_FLAG / 4] != 0u) {
            for (int i = tid; i < 64 * HP; i += NWAVES * 64) lds32[L_HIST / 4 + i] = 0u;
            __syncthreads();
            sweep<1>(ikb, qf, iw, ntile, kq, lane, ql, lds32, 0, nullptr);
            __syncthreads();
            if (tid < 64) {
                LAS unsigned* hq = lds32 + (L_HIST / 4) + tid * HP;
                const unsigned need = lds32[L_NEED / 4 + tid]; unsigned cum = 0; int d = 0;
                for (; d < 63; ++d) { const unsigned hv = hq[d]; if (cum + hv >= need) break; cum += hv; }
                lds32[L_TSEL / 4 + tid] = (unsigned)d; lds32[L_NEED / 4 + tid] = need - cum;
            }
            __syncthreads();
            for (int i = tid; i < 64 * HP; i += NWAVES * 64) lds32[L_HIST / 4 + i] = 0u;
            __syncthreads();
            sweep<2>(ikb, qf, iw, ntile, kq, lane, ql, lds32, 0, nullptr);
            __syncthreads();
            if (tid < 64) {
                LAS unsigned* hq = lds32 + (L_HIST / 4) + tid * HP;
                const unsigned need = lds32[L_NEED / 4 + tid]; unsigned cum = 0; int d = 0;
                for (; d < 63; ++d) { const unsigned hv = hq[d]; if (cum + hv >= need) break; cum += hv; }
                lds32[L_IDXT / 4 + tid] = lds32[L_TSEL / 4 + tid] * 64u + (unsigned)d;
            }
            __syncthreads();
        }
        sweep<3>(ikb, qf, iw, ntile, kq, lane, ql, lds32, 0, mout);
        __syncthreads();
    }
}
}
constexpr int N_PHASES = 1 + 12 * DEPTH;
struct Args { const float* in[19]; float* out; unsigned char* ws; int ph_lo, ph_hi, li, amask; };
__global__ void __launch_bounds__(NWAVES * 64, 2) mk_fwd(Args args) {
    extern __shared__ __attribute__((aligned(16))) unsigned char lds[];
    Frame F;
    F.lds = (LAS unsigned char*)lds;
    F.MISC = (volatile LAS unsigned*)(F.lds + MISC_OFF);
    F.tid = threadIdx.x; F.lane = F.tid & 63; F.wave = __builtin_amdgcn_readfirstlane(F.tid >> 6);
    F.G = gridDim.x; { const int bx = blockIdx.x; F.vcu = (F.G % 8 == 0) ? (bx % 8) * (F.G / 8) + bx / 8 : bx; }
    F.ws = args.ws; F.out = args.out; F.in = args.in;
    F.ctl = (gu32*)(F.ws + WS_CTL);
    for (int u = F.tid; u < (LDS_BYTES - LDSCTL_OFF) / 4; u += NWAVES * 64) ((LAS unsigned*)(F.lds + LDSCTL_OFF))[u] = 0u;
    __syncthreads();
    const int wave0 = F.wave;
    (void)xcd_barrier_post((unsigned*)(F.ctl + CW_BAR) + args.li * XCD_BAR_WORDS, F.MISC + 8);
    const int lo = args.ph_lo, hi = args.ph_hi;
#ifndef PHMASK
#define PHMASK 0xFFFF
#endif
#define IN(k) (lo <= (k) && (k) < hi)
#define INL(j) (((PHMASK >> ((j) + 1)) & 1) && IN(pb + (j)))
#define SEAM(k) do { if (IN(k) && IN((k) + 1)) { XcdBarrier b_; b_.bar = (unsigned*)((gu32*)(args.ws + WS_CTL) + CW_BAR) + args.li * XCD_BAR_WORDS; b_.x = xb_xcc_id(); b_.tid = (unsigned)F.tid; \
        b_.st = (volatile LAS unsigned*)((LAS unsigned char*)lds + MISC_OFF) + 8; xcd_barrier(b_); } } while (0)
#define FRESH() do { int l_ = (int)__builtin_amdgcn_mbcnt_hi(~0u, __builtin_amdgcn_mbcnt_lo(~0u, 0u)); asm volatile("" : "+v"(l_)); F.lane = l_; F.wave = wave0; F.tid = wave0 * 64 + l_; \
        { unsigned char* w_ = args.ws; asm volatile("" : "+s"(w_)); F.ws = w_; float* o_ = args.out; asm volatile("" : "+s"(o_)); F.out = o_; } \
        int b_ = blockIdx.x; asm volatile("" : "+s"(b_)); F.G = gridDim.x; F.vcu = (F.G % 8 == 0) ? (b_ % 8) * (F.G / 8) + b_ / 8 : b_; } while (0)
    const int bx = (int)blockIdx.x;

    if ((PHMASK & 1) && IN(0)) { FRESH(); p0_prologue(F); SEAM(0); }

#pragma unroll 1
    for (int l = 0; l < DEPTH; ++l) {
        const int pb = 1 + 12 * l;

        if (INL(0)) { FRESH(); unsigned char* ws = F.ws;
            GPlain g{(const char*)(ws + WS_XN), (const char*)(ws + WS_WIN), D, D};
            SchedGrid Sc{T / 256, NPROJ / 256, F.G, bx};
            EpiProj E{ws, F.in[I_BF] + l * 8};
            pg8::gemm_phase<GPlain, EpiProj, SchedGrid, true>(F.lds + RING_OFF, g, Sc, E, F.tid);
            SEAM(pb + 0);
        }
        if (INL(1)) { FRESH(); fox_scan(F); dsa_sel::select_phase(F, l); SEAM(pb + 1); }
        if (INL(2)) { FRESH(); attention_phase(F, (char*)lds + RING_OFF, args.amask, l); SEAM(pb + 2); }
        if (INL(3)) { FRESH(); diff_combine(F, l); SEAM(pb + 3); }
        if (INL(4)) { FRESH(); unsigned char* ws = F.ws;
            GBranch g{(const char*)ws, (const char*)(ws + WS_WBR), 512, 512};
            SchedU Sc{F.G, bx};
            EpiPlain E{(bf16*)(ws + WS_U), 3072, 1024};
            pg8::gemm_phase<GBranch, EpiPlain, SchedU, true>(F.lds + RING_OFF, g, Sc, E, F.tid);
            SEAM(pb + 4);
        }
        if (INL(5)) { FRESH(); unsigned char* ws = F.ws;
            GGate g{(const char*)(ws + WS_XN), (const char*)(ws + WS_WIN), D, D};
            SchedY Sc{F.G, bx};
            EpiGate E{(const bf16*)(ws + WS_U), (bf16*)(ws + WS_Y)};
            pg8::gemm_phase<GGate, EpiGate, SchedY, true>(F.lds + RING_OFF, g, Sc, E, F.tid);
            SEAM(pb + 5);
        }
        if (INL(6)) { FRESH(); unsigned char* ws = F.ws;
            GPlain g{(const char*)(ws + WS_Y), (const char*)(ws + WS_WO), D, D};
            SchedGrid Sc{T / 256, D / 256, F.G, bx};
            EpiResid E{F.out};
            pg8::gemm_phase<GPlain, EpiResid, SchedGrid, true>(F.lds + RING_OFF, g, Sc, E, F.tid);
            SEAM(pb + 6);
        }
        if (INL(7)) { FRESH(); p8_ln1_router(F, l); SEAM(pb + 7); }
        if (INL(8)) { FRESH(); p9_placement(F); SEAM(pb + 8); }
        if (INL(9)) { FRESH(); unsigned char* ws = F.ws;
            const int* tile_e = (const int*)(ws + WS_TILEE);
            const int ntiles = __builtin_amdgcn_readfirstlane(__hip_atomic_load(tile_e + NRT_MAX, RLX_AGENT));
            SchedMoe Sc{tile_e, ntiles, F.G, bx};
            LAS int* tab = (LAS int*)(F.lds + TAB_OFF);
            { Unit u; const int* row_tok = (const int*)(ws + WS_ROWTOK);
              for (int i = 0; i < 8 && Sc.next(i, u); ++i) if (F.tid < 256) tab[i * 256 + F.tid] = row_tok[u.pm * 256 + F.tid]; }
            __syncthreads();
            GMoe1 g{(const char*)(ws + WS_XN), (const char*)(ws + WS_EW), D, tab};
            EpiSwiglu E{(bf16*)(ws + WS_HID)};
            pg8::gemm_phase<GMoe1, EpiSwiglu, SchedMoe, true>(F.lds + RING_OFF, g, Sc, E, F.tid);
            SEAM(pb + 9);
        }
        if (INL(10)) { FRESH(); unsigned char* ws = F.ws;
            const int* tile_e = (const int*)(ws + WS_TILEE);
            const int ntiles = __builtin_amdgcn_readfirstlane(__hip_atomic_load(tile_e + NRT_MAX, RLX_AGENT));
            SchedMoe Sc{tile_e, ntiles, F.G, bx};
            GMoe2 g{(const char*)(ws + WS_HID), (const char*)(ws + WS_EWD), DE, DE};
            EpiPlain E{(bf16*)(ws + WS_YR), D, 0};
            pg8::gemm_phase<GMoe2, EpiPlain, SchedMoe, true>(F.lds + RING_OFF, g, Sc, E, F.tid);
            SEAM(pb + 10);
        }
        if (INL(11)) { FRESH(); p12_combine_ln2(F, l); SEAM(pb + 11); }
    }
#undef IN
#undef INL
#undef SEAM
#undef FRESH
}

template <int MODE>
__global__ __launch_bounds__(64) void attn_naive_bf(unsigned char* ws) {
    const int chunk = blockIdx.x, he = blockIdx.y, b = blockIdx.z, lane = threadIdx.x;
    const int t = chunk * 64 + lane; const size_t rowb = (size_t)b * S;
    const bf16 *Q, *K, *V; bf16* O;
    if (MODE == 0) { const int hm = he >> 1, vh = he & 1; Q = (const bf16*)(ws + WS_Z) + hm * 64; K = (const bf16*)(ws + WS_Z + ZG) + hm * 64; V = (const bf16*)(ws + WS_Z + 2 * ZG) + (hm >> 1) * 128 + vh * 64; O = (bf16*)(ws + WS_OD) + hm * 128 + vh * 64; }
    else if (MODE == 2) { Q = (const bf16*)(ws + WS_Z + 3 * ZG) + he * 64; K = (const bf16*)(ws + WS_Z + 4 * ZG) + he * 64; V = (const bf16*)(ws + WS_Z + 5 * ZG) + he * 64; O = (bf16*)(ws + WS_OS) + he * 64; }
    else { Q = (const bf16*)(ws + WS_Z + 6 * ZG) + he * 64; K = (const bf16*)(ws + WS_Z + 7 * ZG) + he * 64; V = (const bf16*)(ws + WS_Z + 8 * ZG) + he * 64; O = (bf16*)(ws + WS_OF) + he * 64; }
    float q[64];
    { const v4u* qp = (const v4u*)(Q + (rowb + t) * 512);
#pragma unroll
      for (int i = 0; i < 8; ++i) { const v4u w = qp[i]; q[8 * i] = bflo(w.x); q[8 * i + 1] = bfhi(w.x); q[8 * i + 2] = bflo(w.y); q[8 * i + 3] = bfhi(w.y); q[8 * i + 4] = bflo(w.z); q[8 * i + 5] = bfhi(w.z); q[8 * i + 6] = bflo(w.w); q[8 * i + 7] = bfhi(w.w); } }
    float acc[64];
#pragma unroll
    for (int i = 0; i < 64; ++i) acc[i] = 0.f;
    float m = -INFINITY, lsum = 0.f;
    const int kend = chunk * 64 + 64;
    const float* cb = (const float*)(ws + WS_CB) + (size_t)(b * 8 + he) * S;
    float cq = 0.f; if (MODE == 1) cq = cb[t];
    const unsigned* mask = (const unsigned*)(ws + WS_MASK) + (rowb + t) * 128;
    for (int j0 = 0; j0 < kend; j0 += 8) {
        float s[8]; unsigned mw = 0;
        if (MODE == 2) mw = mask[j0 >> 5] >> (j0 & 31);
#pragma unroll
        for (int jj = 0; jj < 8; ++jj) {
            const int j = j0 + jj; const v4u* kr = (const v4u*)(K + (rowb + j) * 512);
            float d = 0.f;
#pragma unroll
            for (int i = 0; i < 8; ++i) { const v4u w = kr[i];
                d = fmaf(q[8 * i], bflo(w.x), d); d = fmaf(q[8 * i + 1], bfhi(w.x), d); d = fmaf(q[8 * i + 2], bflo(w.y), d); d = fmaf(q[8 * i + 3], bfhi(w.y), d);
                d = fmaf(q[8 * i + 4], bflo(w.z), d); d = fmaf(q[8 * i + 5], bfhi(w.z), d); d = fmaf(q[8 * i + 6], bflo(w.w), d); d = fmaf(q[8 * i + 7], bfhi(w.w), d); }
            if (MODE == 1) { d += cq - cb[j]; if (j > t) d = -INFINITY; }
            if (MODE == 2) { if (!((mw >> jj) & 1u)) d = -INFINITY; }
            s[jj] = d;
        }
        float tm = s[0];
#pragma unroll
        for (int jj = 1; jj < 8; ++jj) tm = fmaxf(tm, s[jj]);
        const float mnew = fmaxf(m, tm);
        if (mnew > -INFINITY) {
            const float corr = exp2f(m - mnew);
            lsum *= corr;
#pragma unroll
            for (int i = 0; i < 64; ++i) acc[i] *= corr;
#pragma unroll
            for (int jj = 0; jj < 8; ++jj) {
                const float p = exp2f(s[jj] - mnew); lsum += p;
                const v4u* vr = (const v4u*)(V + (rowb + j0 + jj) * 512);
#pragma unroll
                for (int i = 0; i < 8; ++i) { const v4u w = vr[i];
                    acc[8 * i] = fmaf(p, bflo(w.x), acc[8 * i]); acc[8 * i + 1] = fmaf(p, bfhi(w.x), acc[8 * i + 1]); acc[8 * i + 2] = fmaf(p, bflo(w.y), acc[8 * i + 2]); acc[8 * i + 3] = fmaf(p, bfhi(w.y), acc[8 * i + 3]);
                    acc[8 * i + 4] = fmaf(p, bflo(w.z), acc[8 * i + 4]); acc[8 * i + 5] = fmaf(p, bfhi(w.z), acc[8 * i + 5]); acc[8 * i + 6] = fmaf(p, bflo(w.w), acc[8 * i + 6]); acc[8 * i + 7] = fmaf(p, bfhi(w.w), acc[8 * i + 7]); }
            }
            m = mnew;
        }
    }
    const float rl = 1.f / lsum;
    v4u* op = (v4u*)(O + (rowb + t) * (MODE == 0 ? 1024 : 512));
#pragma unroll
    for (int i = 0; i < 8; ++i) { v4u w; w.x = pk2(acc[8 * i] * rl, acc[8 * i + 1] * rl); w.y = pk2(acc[8 * i + 2] * rl, acc[8 * i + 3] * rl); w.z = pk2(acc[8 * i + 4] * rl, acc[8 * i + 5] * rl); w.w = pk2(acc[8 * i + 6] * rl, acc[8 * i + 7] * rl); op[i] = w; }
}
__device__ __forceinline__ unsigned f2key(float f) {
    unsigned u = __float_as_uint(f);
    if (u == 0x80000000u) u = 0u;
    return (u & 0x80000000u) ? ~u : (u | 0x80000000u);
}
__global__ __launch_bounds__(256) void dsa_naive_select(unsigned char* ws) {
    __shared__ unsigned keys[S];
    __shared__ float qv[256];
    __shared__ unsigned hist[256];
    __shared__ unsigned sh_prefix, sh_kk;
    __shared__ unsigned seg[256];
    const int qg = blockIdx.x, tid = threadIdx.x, b = qg / S, t = qg % S;
    const int nvis = (t / 64 + 1) * 64;
    qv[tid] = bf2f(((const bf16*)(ws + WS_IQ))[(size_t)qg * 256 + tid]);
    const f32x4 iw = *(const f32x4*)((const float*)(ws + WS_IW) + (size_t)qg * 4);
    __syncthreads();
    for (int j = tid; j < S; j += 256) {
        unsigned key = 0u;
        if (j < nvis) {
            const v4u* kr = (const v4u*)((const bf16*)(ws + WS_IK) + ((size_t)b * S + j) * 64);
            float kv[64];
#pragma unroll
            for (int i = 0; i < 8; ++i) { const v4u w = kr[i]; kv[8 * i] = bflo(w.x); kv[8 * i + 1] = bfhi(w.x); kv[8 * i + 2] = bflo(w.y); kv[8 * i + 3] = bfhi(w.y); kv[8 * i + 4] = bflo(w.z); kv[8 * i + 5] = bfhi(w.z); kv[8 * i + 6] = bflo(w.w); kv[8 * i + 7] = bfhi(w.w); }
            float sc = 0.f;
#pragma unroll
            for (int hh = 0; hh < 4; ++hh) { float d = 0.f;
#pragma unroll
                for (int dd = 0; dd < 64; ++dd) d = fmaf(qv[hh * 64 + dd], kv[dd], d);
                sc = fmaf(iw[hh], fmaxf(d, 0.f), sc); }
            key = f2key(sc);
        }
        keys[j] = key;
    }
    __syncthreads();
    unsigned tau = 0, need = 0; const bool all_vis = nvis <= 256;
    if (!all_vis) {
        unsigned prefix = 0, kk = 256;
        for (int pass = 0; pass < 4; ++pass) {
            const int shift = 24 - 8 * pass;
            hist[tid] = 0;
            __syncthreads();
            for (int i = tid; i < nvis; i += 256) { const unsigned k = keys[i]; if (pass == 0 || (k >> (shift + 8)) == prefix) atomicAdd(&hist[(k >> shift) & 255u], 1u); }
            __syncthreads();
            if (tid == 0) { unsigned cum = 0; int d = 255; for (; d > 0; --d) { if (cum + hist[d] >= kk) break; cum += hist[d]; } sh_prefix = (prefix << 8) | (unsigned)d; sh_kk = kk - cum; }
            __syncthreads();
            prefix = sh_prefix; kk = sh_kk;
            __syncthreads();
        }
        tau = prefix; need = kk;
    }
    unsigned eqc = 0;
    if (!all_vis) {
#pragma unroll
        for (int i = 0; i < 16; ++i) { const int idx = tid * 16 + i; if (idx < nvis && keys[idx] == tau) ++eqc; }
    }
    seg[tid] = eqc;
    __syncthreads();
    if (tid == 0) { unsigned run = 0; for (int i = 0; i < 256; ++i) { const unsigned c = seg[i]; seg[i] = run; run += c; } }
    __syncthreads();
    unsigned rank = seg[tid], bits = 0;
#pragma unroll
    for (int i = 0; i < 16; ++i) {
        const int idx = tid * 16 + i; bool sel = false;
        if (idx < nvis) { if (all_vis) sel = true; else { const unsigned k = keys[idx]; if (k > tau) sel = true; else if (k == tau) { sel = rank < need; ++rank; } } }
        bits |= (sel ? 1u : 0u) << i;
    }
    const unsigned other = __shfl_down(bits, 1);
    if ((tid & 1) == 0) ((unsigned*)(ws + WS_MASK))[(size_t)qg * 128 + (tid >> 1)] = bits | (other << 16);
}

extern "C" void kernel_launch(void* const* d_in, const int* in_sizes, int n_in, void* d_out, int out_size, void* d_ws, size_t ws_size, hipStream_t stream) {
    static int grid = 0;
    if (grid == 0) {
        if (n_in != 19 || out_size != T * D || ws_size < WS_END) { fprintf(stderr, "kernel_launch: unexpected shapes (n_in %d out %d ws %zu, need %zu); nothing launched\n", n_in, out_size, ws_size, (size_t)WS_END); grid = -1; return; }
        int dev = 0, cus = 0, per_cu = 0;
        if (hipGetDevice(&dev) != hipSuccess || hipDeviceGetAttribute(&cus, hipDeviceAttributeMultiprocessorCount, dev) != hipSuccess) { grid = -1; return; }
        if (hipFuncSetAttribute((const void*)mk_fwd, hipFuncAttributeMaxDynamicSharedMemorySize, LDS_BYTES) != hipSuccess) { fprintf(stderr, "kernel_launch: hipFuncSetAttribute failed\n"); grid = -1; return; }
        if (hipOccupancyMaxActiveBlocksPerMultiprocessor(&per_cu, (const void*)mk_fwd, NWAVES * 64, LDS_BYTES) != hipSuccess || per_cu < 1) { fprintf(stderr, "kernel_launch: occupancy query says %d\n", per_cu); }
        (void)hipGetLastError();
        if (cus < 256) { fprintf(stderr, "kernel_launch: needs 256 CUs, device has %d\n", cus); grid = -1; return; }
        grid = 256;
    }
    if (grid < 0) return;
    if (hipMemsetAsync((char*)d_ws + WS_CTL, 0, CTL_ZERO_BYTES, stream) != hipSuccess) return;
    Args a{};
    for (int i = 0; i < 19; ++i) a.in[i] = (const float*)d_in[i];
    a.out = (float*)d_out; a.ws = (unsigned char*)d_ws;
    unsigned char* ws = (unsigned char*)d_ws;
    a.amask = 7;
    auto run = [&](int lo, int hi, int li) { a.ph_lo = lo; a.ph_hi = hi; a.li = li; hipLaunchKernelGGL(mk_fwd, dim3(grid), dim3(NWAVES * 64), LDS_BYTES, stream, a); };
    auto naive = [&]() {
        hipLaunchKernelGGL(dsa_naive_select, dim3(T), dim3(256), 0, stream, ws);
        hipLaunchKernelGGL(attn_naive_bf<2>, dim3(64, 8, NB), dim3(64), 0, stream, ws);
    };
    (void)naive; run(0, N_PHASES, 0);
}
```

```cpp
#include <hip/hip_runtime.h>
#include <hip/hip_bf16.h>
#include <cstdio>
#include <cstdint>
#include <cmath>

namespace cfg {
constexpr int D = 1024, NB = 8, S = 4096, T = NB * S, DEPTH = 2, INW = 8012;
constexpr int O_DQ = 0, O_DK = 512, O_DV = 1024, O_SQ = 1536, O_SK = 2048, O_SV = 2560, O_IQ = 3072, O_IK = 3328,
              O_IW = 3392, O_FQ = 3396, O_FK = 3908, O_FV = 4420, O_FF = 4932, O_G = 4940;
constexpr float LN_EPS = 1e-5f;
constexpr float ALPHA = 1.41421356237309515f;
constexpr float LOG2E = 1.4426950408889634f;
constexpr float C2 = 0.125f * LOG2E;
constexpr int NE = 32, DE = 512;
constexpr int NPROJ = 5120;
constexpr int RMAX = 2 * T + NE * 256 - NE;
constexpr int NRT_MAX = 288;
constexpr int RPAD = NRT_MAX * 256;
constexpr size_t MiB = 1u << 20;
constexpr size_t WS_CTL = 0, CTL_ZERO_BYTES = 1 * MiB;
constexpr size_t WS_CS = 1 * MiB;
constexpr size_t WS_SN = 5 * MiB;
constexpr size_t WS_LF = 9 * MiB;
constexpr size_t WS_CB = 10 * MiB;
constexpr size_t WS_IW = 11 * MiB;
constexpr size_t WS_EIDX = 11 * MiB + 512 * 1024;
constexpr size_t WS_WTS = 11 * MiB + 768 * 1024;
constexpr size_t WS_POS = 12 * MiB;
constexpr size_t WS_ROWTOK = 12 * MiB + 256 * 1024;
constexpr size_t WS_HIST = 12 * MiB + 640 * 1024;
constexpr size_t WS_TILEE = 12 * MiB + 704 * 1024;
constexpr size_t WS_W = 16 * MiB;
constexpr size_t WS_WIN = WS_W, WS_WBR = WS_W + 16 * MiB, WS_WO = WS_W + 19 * MiB;
constexpr size_t WS_XN = 38 * MiB;
constexpr size_t WS_MASK = 102 * MiB;
constexpr size_t WS_O = 118 * MiB;
constexpr size_t WS_OS = WS_O, WS_OF = WS_O + 32 * MiB;
constexpr size_t WS_OD = 182 * MiB;
constexpr size_t WS_Z = 246 * MiB;
constexpr size_t ZG = 32 * MiB;
constexpr size_t WS_IQ = WS_Z + 9 * ZG, WS_IK = WS_IQ + 16 * MiB, WS_ZEND = WS_IK + 4 * MiB;
constexpr size_t WS_U = WS_Z;
constexpr size_t WS_Y = WS_Z + 192 * MiB;
constexpr size_t WS_ODC = WS_Z + 256 * MiB;
constexpr size_t WS_EW = WS_O;
constexpr size_t WS_EWD = WS_EW + 64 * MiB;
constexpr size_t WS_S1 = WS_Z;
constexpr size_t WS_HID = WS_Z;
constexpr size_t WS_YR = WS_Z + 72 * MiB;
constexpr size_t WS_MASK1 = WS_ZEND;
constexpr size_t WS_END = WS_ZEND + 16 * MiB;
static_assert(WS_ODC + 32 * MiB <= WS_ZEND && WS_YR + 144 * MiB <= WS_ZEND && WS_EWD + 32 * MiB <= WS_Z, "ws map");
constexpr int CW_BAR = 4096;
}
using namespace cfg;

#define GAS __attribute__((address_space(1)))
#define LAS __attribute__((address_space(3)))
typedef unsigned short bf16;
typedef unsigned v4u __attribute__((ext_vector_type(4)));
typedef unsigned v2u __attribute__((ext_vector_type(2)));
typedef float f32x4 __attribute__((ext_vector_type(4)));
typedef float f32x2 __attribute__((ext_vector_type(2)));
typedef short bf16x8 __attribute__((ext_vector_type(8)));
typedef GAS unsigned gu32;
#define RLX_AGENT __ATOMIC_RELAXED, __HIP_MEMORY_SCOPE_AGENT
#define LDS_WAIT() asm volatile("s_waitcnt lgkmcnt(0)" ::: "memory")
#define VM_WAIT() asm volatile("s_waitcnt vmcnt(0)" ::: "memory")
__device__ __forceinline__ unsigned f2bf(float f) { unsigned u = __builtin_bit_cast(unsigned, f); return (u + 0x7fffu + ((u >> 16) & 1u)) >> 16; }
__device__ __forceinline__ unsigned pk2(float lo, float hi) { return f2bf(lo) | (f2bf(hi) << 16); }
__device__ __forceinline__ float bf2f(unsigned short h) { return __builtin_bit_cast(float, (unsigned)h << 16); }
__device__ __forceinline__ float bflo(unsigned w) { return __builtin_bit_cast(float, w << 16); }
__device__ __forceinline__ float bfhi(unsigned w) { return __builtin_bit_cast(float, w & 0xffff0000u); }
__device__ __forceinline__ unsigned cvt_pk_bf16(float lo, float hi) { unsigned r; asm volatile("v_cvt_pk_bf16_f32 %0, %1, %2" : "=v"(r) : "v"(lo), "v"(hi)); return r; }
__device__ __forceinline__ float wave_sum(float v) {
#pragma unroll
    for (int o = 1; o < 64; o <<= 1) v += __shfl_xor(v, o);
    return v;
}
__device__ __forceinline__ float sigmoidf_(float x) { return __builtin_amdgcn_rcpf(1.f + __builtin_amdgcn_exp2f(-LOG2E * x)); }
namespace pg8 {
#define PG8_LAS __attribute__((address_space(3)))
constexpr int BM = 256, BK = 64, HALF = 128, HTB = HALF * BK * 2  , STAGE_BYTES = 8 * HTB, NXCD = 8, WGM = 8;
__host__ __device__ __forceinline__ int lds_byte(int r, int c) { const int st = (r >> 4) * 2 + (c >> 5), rr = r & 15, cc = c & 31, ob = rr * 64 + cc * 2; return st * 1024 + (ob ^ (((ob >> 9) & 1) << 5)); }
__host__ __device__ __forceinline__ void stage_rc(int b, int& R, int& C) { const int st = b / 1024, sb = b % 1024, swz = sb ^ (((sb >> 9) & 1) << 5); R = (st >> 1) * 16 + swz / 64; C = (st & 1) * 32 + (swz % 64) / 2; }
__host__ __device__ __forceinline__ int perm32(int rho) { const int n = rho >> 4, i = rho & 15; return 8 * (i >> 2) + 4 * n + (i & 3); }

struct Unit { int pm, pn, aux; };

__device__ __forceinline__ void map_unit(int L, int nM, int nN, int& pm, int& pn) {
    const int nwg = nM * nN; int wgid = L;
    { const int q = nwg / NXCD, r = nwg % NXCD, xcd = wgid % NXCD, off = wgid / NXCD; wgid = (xcd < r ? xcd * (q + 1) : r * (q + 1) + (xcd - r) * q) + off; }
    const int nig = WGM * nN, gid = wgid / nig, fm = gid * WGM, gsz = (nM - fm) < WGM ? (nM - fm) : WGM;
    pm = fm + ((wgid % nig) % gsz); pn = (wgid % nig) / gsz;
}

template <class G, class Epi, class Sched, bool ALIGN_EPI>
__device__ __forceinline__ void gemm_phase(PG8_LAS unsigned char* lds, const G& g, const Sched& S, const Epi& E, int tid_in) {
    int tid_ = tid_in; asm volatile("" : "+v"(tid_));
    const int tid = tid_, wid = __builtin_amdgcn_readfirstlane(tid >> 6), lane = tid & 63, wr = wid >> 2, wc = wid & 3, fr = lane & 15, fq = lane >> 4;
    const int K = g.K, nt = K / BK;
    constexpr bool GA = G::GATHER;
    unsigned voffB[2], voffA[2];
#pragma unroll
    for (int i = 0; i < 2; ++i) { int R, C; stage_rc(tid * 16 + i * 8192, R, C); const int Rb = (R & ~31) + perm32(R & 31); voffB[i] = (unsigned)(Rb * K + C) * 2u;
        if constexpr (!GA) voffA[i] = (unsigned)(R * g.lda + C) * 2u; else voffA[i] = 0u; }
    const size_t kstep = (size_t)(BK * 2);
    const size_t hstep = (size_t)HALF * K * 2;
    size_t hstepA = 0; if constexpr (!GA) hstepA = (size_t)HALF * g.lda * 2;
    const unsigned ldsw = (unsigned)wid * 1024u;
    const int aoff = lds_byte(wr * 64 + fr, fq * 8), boff = lds_byte(wc * 32 + fr, fq * 8);
#define PG8_SA(b, h) (((b) * 2 + (h)) * HTB)
#define PG8_SB(b, h) ((4 + (b) * 2 + (h)) * HTB)
#define PG8_STAGE(bufoff, gbase, voff) do { _Pragma("unroll") for (int _i = 0; _i < 2; ++_i) \
        __builtin_amdgcn_global_load_lds((const unsigned*)((const char*)(gbase) + (voff)[_i]), (PG8_LAS unsigned*)(lds + (bufoff) + ldsw + _i * 8192), 16, 0, 0); } while (0)
#define PG8_LDA(dst, b, h) do { _Pragma("unroll") for (int m = 0; m < 4; ++m) _Pragma("unroll") for (int k = 0; k < 2; ++k) dst[m][k] = *(const PG8_LAS bf16x8*)(lds + PG8_SA(b, h) + aoff + m * 2048 + k * 1024); } while (0)
#define PG8_LDB(dst, b, h) do { _Pragma("unroll") for (int n = 0; n < 2; ++n) _Pragma("unroll") for (int k = 0; k < 2; ++k) dst[n][k] = *(const PG8_LAS bf16x8*)(lds + PG8_SB(b, h) + boff + n * 2048 + k * 1024); } while (0)
#define PG8_MMA(ai, bj, At, Bt) do { __builtin_amdgcn_s_setprio(1); _Pragma("unroll") for (int m = 0; m < 4; ++m) _Pragma("unroll") for (int n = 0; n < 2; ++n) _Pragma("unroll") for (int k = 0; k < 2; ++k) \
        acc[ai][bj][m][n] = __builtin_amdgcn_mfma_f32_16x16x32_bf16(Bt[n][k], At[m][k], acc[ai][bj][m][n], 0, 0, 0); __builtin_amdgcn_s_setprio(0); } while (0)
#define PG8_WAIT_V(n) asm volatile("s_waitcnt vmcnt(" #n ")" ::: "memory")
#define PG8_WAIT_L(n) asm volatile("s_waitcnt lgkmcnt(" #n ")" ::: "memory")
#define PG8_BAR __builtin_amdgcn_s_barrier()
#define PG8_SCHED __builtin_amdgcn_sched_barrier(0)
    Unit cur, nxt; int ui = 0;
    if (!S.next(0, cur)) return;
    f32x4 acc[2][2][4][2];
#pragma unroll
    for (int a = 0; a < 2; ++a)
#pragma unroll
        for (int b = 0; b < 2; ++b)
#pragma unroll
            for (int m = 0; m < 4; ++m)
#pragma unroll
                for (int n = 0; n < 2; ++n) acc[a][b][m][n] = (f32x4){0.f, 0.f, 0.f, 0.f};
    bf16x8 At[4][2], B0[2][2], B1[2][2];
    unsigned vC0[2], vC1[2], vN0[2], vN1[2];
    const char* cA0; const char* cA1;
    if constexpr (GA) {
#pragma unroll
        for (int i = 0; i < 2; ++i) { int R, C; stage_rc(tid * 16 + i * 8192, R, C); vC0[i] = g.a_off(cur, 0, 0, R, C); vC1[i] = g.a_off(cur, 0, 1, R, C); }
        cA0 = g.a_base; cA1 = g.a_base;
    } else {
#pragma unroll
        for (int i = 0; i < 2; ++i) { vC0[i] = voffA[i]; vC1[i] = voffA[i]; vN0[i] = voffA[i]; vN1[i] = voffA[i]; }
        cA0 = g.a_ptr(cur); cA1 = cA0 + hstepA;
    }
    const char* cB = g.b_ptr(cur);
    PG8_STAGE(PG8_SB(0, 0), cB, voffB); PG8_STAGE(PG8_SB(0, 1), cB + hstep, voffB); PG8_STAGE(PG8_SA(0, 0), cA0, vC0); PG8_STAGE(PG8_SA(0, 1), cA1, vC1);
    if (wr == 1) PG8_BAR;
    PG8_WAIT_V(2); PG8_BAR;
    PG8_STAGE(PG8_SB(1, 0), cB + kstep, voffB); PG8_STAGE(PG8_SA(1, 0), cA0 + kstep, vC0); PG8_STAGE(PG8_SB(1, 1), cB + hstep + kstep, voffB);
    PG8_WAIT_V(6); PG8_BAR;
    for (;;) {
        const bool has_next = S.next(ui + 1, nxt);
        const char* nB = cB; const char* nA0 = cA0; const char* nA1 = cA1;
        if (has_next) {
            if constexpr (GA) {
#pragma unroll
                for (int i = 0; i < 2; ++i) { int R, C; stage_rc(tid * 16 + i * 8192, R, C); vN0[i] = g.a_off(nxt, ui + 1, 0, R, C); vN1[i] = g.a_off(nxt, ui + 1, 1, R, C); }
            } else { nA0 = g.a_ptr(nxt); nA1 = nA0 + hstepA; }
            nB = g.b_ptr(nxt);
        } else {
            if constexpr (GA) {
#pragma unroll
                for (int i = 0; i < 2; ++i) { vN0[i] = vC0[i]; vN1[i] = vC1[i]; }
            }
        }
        for (int t = 0; t < nt; t += 2) {
            const bool last = (t == nt - 2);
            const char* a1 = cA1 + (size_t)(t + 1) * kstep;
            const char* a20 = last ? nA0 : cA0 + (size_t)(t + 2) * kstep; const char* a21 = last ? nA1 : cA1 + (size_t)(t + 2) * kstep;
            const char* b2 = last ? nB : cB + (size_t)(t + 2) * kstep;
            const char* a30 = a20 + kstep; const char* b3 = b2 + kstep;
            unsigned w0[2], w1[2];
#pragma unroll
            for (int i = 0; i < 2; ++i) { if constexpr (GA) { w0[i] = last ? vN0[i] : vC0[i]; w1[i] = last ? vN1[i] : vC1[i]; } else { w0[i] = voffA[i]; w1[i] = voffA[i]; } }
            PG8_LDB(B0, 0, 0); PG8_LDB(B1, 0, 1); PG8_SCHED; PG8_LDA(At, 0, 0); PG8_STAGE(PG8_SA(1, 1), a1, vC1);
            PG8_WAIT_V(8); PG8_WAIT_L(0); PG8_BAR; PG8_MMA(0, 0, At, B0); PG8_MMA(0, 1, At, B1); PG8_BAR; PG8_SCHED;
            PG8_LDA(At, 0, 1); PG8_STAGE(PG8_SB(0, 0), b2, voffB); PG8_STAGE(PG8_SB(0, 1), b2 + hstep, voffB); PG8_STAGE(PG8_SA(0, 0), a20, w0);
            PG8_WAIT_V(8); PG8_WAIT_L(0); PG8_BAR; PG8_MMA(1, 0, At, B0); PG8_MMA(1, 1, At, B1); PG8_BAR; PG8_SCHED;
            PG8_LDB(B0, 1, 0); PG8_LDB(B1, 1, 1); PG8_SCHED; PG8_LDA(At, 1, 0); PG8_STAGE(PG8_SA(0, 1), a21, w1);
            PG8_WAIT_V(8); PG8_WAIT_L(0); PG8_BAR; PG8_MMA(0, 0, At, B0); PG8_MMA(0, 1, At, B1); PG8_BAR; PG8_SCHED;
            PG8_LDA(At, 1, 1); PG8_STAGE(PG8_SB(1, 0), b3, voffB); PG8_STAGE(PG8_SB(1, 1), b3 + hstep, voffB); PG8_STAGE(PG8_SA(1, 0), a30, w0);
            PG8_WAIT_V(8); PG8_WAIT_L(0); PG8_BAR; PG8_MMA(1, 0, At, B0); PG8_MMA(1, 1, At, B1); PG8_BAR; PG8_SCHED;
        }
        if constexpr (ALIGN_EPI) { if (wr == 0) PG8_BAR; }
        E(acc, cur, wr, wc, fr, fq);
        if (!has_next) break;
#pragma unroll
        for (int a = 0; a < 2; ++a)
#pragma unroll
            for (int b = 0; b < 2; ++b)
#pragma unroll
                for (int m = 0; m < 4; ++m)
#pragma unroll
                    for (int n = 0; n < 2; ++n) acc[a][b][m][n] = (f32x4){0.f, 0.f, 0.f, 0.f};
        cur = nxt; cB = nB; cA0 = nA0; cA1 = nA1; ++ui;
        if constexpr (GA) {
#pragma unroll
            for (int i = 0; i < 2; ++i) { vC0[i] = vN0[i]; vC1[i] = vN1[i]; }
        }
        if constexpr (ALIGN_EPI) { if (wr == 1) PG8_BAR; }
    }
    PG8_WAIT_V(0);
    if constexpr (!ALIGN_EPI) { if (wr == 0) PG8_BAR; }
    PG8_BAR;
#undef PG8_SA
#undef PG8_SB
#undef PG8_STAGE
#undef PG8_LDA
#undef PG8_LDB
#undef PG8_MMA
#undef PG8_WAIT_V
#undef PG8_WAIT_L
#undef PG8_BAR
#undef PG8_SCHED
}
}
#define XB_TMO      128
#define XB_XCNT(j)  (256  + 64 * (j))
#define XB_XSUB(j)  (1280 + 64 * (j))
#define XB_XGEN(j)  (2304 + 64 * (j))
#define XB_TOP      3328
#define XB_TOPGEN   3392
#define XCD_BAR_WORDS 3456
#define XB_SPIN_CAP (1u << 18)

__device__ __forceinline__ unsigned xb_ld(unsigned* p)              { return __hip_atomic_load(p, __ATOMIC_RELAXED, __HIP_MEMORY_SCOPE_AGENT); }
__device__ __forceinline__ unsigned xb_add(unsigned* p, unsigned v) { return __hip_atomic_fetch_add(p, v, __ATOMIC_RELAXED, __HIP_MEMORY_SCOPE_AGENT); }
__device__ __forceinline__ unsigned xb_xcc_id() { return (unsigned)__builtin_amdgcn_s_getreg((3 << 11) | 20) & 0xFu; }
#define XB_SPIN(cond, bar) do { unsigned _sp = 0; while (cond) { __builtin_amdgcn_s_sleep(1); \
    if ((++_sp & 255u) == 0u) { if (xb_ld(&(bar)[XB_TMO])) break; if (_sp > XB_SPIN_CAP) { atomicAdd(&(bar)[XB_TMO], 1u); break; } } } } while (0)

struct XcdBarrier {
    unsigned* bar; unsigned x; unsigned tid;
    volatile LAS unsigned* st;
};

__device__ __forceinline__ XcdBarrier xcd_barrier_post(unsigned* bar, volatile LAS unsigned* st) {
    XcdBarrier b; b.bar = bar; b.x = xb_xcc_id(); b.st = st;
    if (threadIdx.x == 0) (void)xb_add(&bar[XB_XCNT(b.x)], 1u);
    return b;
}
__device__ __forceinline__ void xcd_barrier_complete(unsigned* bar, unsigned x, unsigned& nloc, unsigned& nx) {
    const unsigned G = gridDim.x * gridDim.y * gridDim.z;
    unsigned sum, cnt, mine, sp = 0u;
    for (;;) {
        sum = 0u; cnt = 0u; mine = 0u;
#pragma unroll
        for (unsigned j = 0; j < 16; ++j) { const unsigned c = xb_ld(&bar[XB_XCNT(j)]); sum += c; cnt += (c > 0u) ? 1u : 0u; mine = (j == x) ? c : mine; }
        if (sum == G) break;
        __builtin_amdgcn_s_sleep(1);
        if ((++sp & 255u) == 0u) { if (xb_ld(&bar[XB_TMO])) break; if (sp > XB_SPIN_CAP) { atomicAdd(&bar[XB_TMO], 1u); break; } }
    }
    nloc = mine > 0u ? mine : 1u; nx = cnt > 0u ? cnt : 1u;
}

__device__ __forceinline__ void xcd_barrier(const XcdBarrier& b) {
    asm volatile("s_waitcnt vmcnt(0)" ::: "memory");
    __syncthreads();
    if (b.tid == 0u) {
        unsigned* bar = b.bar;
        __builtin_amdgcn_s_waitcnt(0);
        unsigned nloc = b.st[0], nx = b.st[1];
        if (nloc == 0u) { xcd_barrier_complete(bar, b.x, nloc, nx); b.st[0] = nloc; b.st[1] = nx; }
        const unsigned old = xb_add(&bar[XB_XSUB(b.x)], 1u);
        const unsigned gen = old / nloc;
        if (old + 1u == (gen + 1u) * nloc) {
            __builtin_amdgcn_fence(__ATOMIC_RELEASE, "agent");
            asm volatile("s_waitcnt vmcnt(0)" ::: "memory");
            const unsigned og = xb_add(&bar[XB_TOP], 1u);
            const unsigned tg = og / nx;
            if (og + 1u == (tg + 1u) * nx) xb_add(&bar[XB_TOPGEN], 1u);
            else XB_SPIN(xb_ld(&bar[XB_TOPGEN]) == tg, bar);
            __builtin_amdgcn_fence(__ATOMIC_ACQUIRE, "agent");
            xb_add(&bar[XB_XGEN(b.x)], 1u);
            asm volatile("s_waitcnt vmcnt(0)" ::: "memory");
        } else {
            XB_SPIN(xb_ld(&bar[XB_XGEN(b.x)]) == gen, bar);
            __builtin_amdgcn_fence(__ATOMIC_ACQUIRE, "agent");
            asm volatile("s_waitcnt vmcnt(0)" ::: "memory");
        }
    }
    __syncthreads();
}
constexpr int NWAVES = 8;
constexpr int RING_OFF = 0, RING_BYTES = 131072;
constexpr int LDSCTL_OFF = RING_BYTES, MISC_OFF = LDSCTL_OFF + 320;
constexpr int TAB_OFF = LDSCTL_OFF + 1024;
constexpr int LDS_BYTES = 147456;
static_assert(TAB_OFF + 8 * 1024 <= LDS_BYTES, "LDS map");

struct Frame {
    LAS unsigned char* lds;
    volatile LAS unsigned* MISC;
    gu32* ctl;
    int tid, lane, wave, vcu, G;
    unsigned char* ws; float* out;
    const float* const* in;
};
enum { I_X = 0, I_POS, I_LNG, I_LNB, I_WIN, I_BF, I_LAM, I_DNG, I_WBR, I_WO, I_LN1G, I_LN1B, I_WR, I_BR, I_WG, I_WU, I_WD, I_LN2G, I_LN2B };

__device__ __forceinline__ int win_src(int n) {
    if (n < 4608) {
        const int g = n >> 9, c = n & 511;
        const int base = g == 0 ? O_DQ : g == 1 ? O_DK : g == 2 ? O_DV : g == 3 ? O_SQ : g == 4 ? O_SK : g == 5 ? O_SV : g == 6 ? O_FQ : g == 7 ? O_FK : O_FV;
        const bool rope = (g == 0) | (g == 1) | (g == 3) | (g == 4);
        if (rope) { const int j = c & 63; return base + (c & ~63) + (j >> 1) + 32 * (j & 1); }
        return base + c;
    }
    if (n < 4864) { const int c = n - 4608, j = c & 63; return O_IQ + (c & ~63) + (j >> 1) + 32 * (j & 1); }
    if (n < 4928) { const int j = n - 4864; return O_IK + (j >> 1) + 32 * (j & 1); }
    if (n < 4932) return O_IW + (n - 4928);
    if (n < 4940) return O_FF + (n - 4932);
    if (n < NPROJ) return -1;
    return O_G + (n - NPROJ);
}
template <bool MAPPED>
__device__ __forceinline__ void transpose_item(const float* W, int ldw, int k0, int n0, bf16* WT, int ldt, int drow0, LAS float* scr, int lane) {
    int sc = n0 + (lane & 31);
    if (MAPPED) sc = win_src(sc);
    float wv[32];
#pragma unroll
    for (int i = 0; i < 32; ++i) { const int kk = 2 * i + (lane >> 5); wv[i] = (sc >= 0) ? W[(size_t)(k0 + kk) * ldw + sc] : 0.f; }
#pragma unroll
    for (int i = 0; i < 32; ++i) { const int kk = 2 * i + (lane >> 5); scr[kk * 33 + (lane & 31)] = wv[i]; }
    LDS_WAIT(); asm volatile("" ::: "memory");
    const int c = lane & 7;
#pragma unroll
    for (int j = 0; j < 4; ++j) { const int n = (lane >> 3) + 8 * j; const LAS float* s = scr + (8 * c) * 33 + n;
        v4u o; o.x = pk2(s[0 * 33], s[1 * 33]); o.y = pk2(s[2 * 33], s[3 * 33]); o.z = pk2(s[4 * 33], s[5 * 33]); o.w = pk2(s[6 * 33], s[7 * 33]);
        *(GAS v4u*)(WT + (size_t)(drow0 + n) * ldt + k0 + 8 * c) = o; }
    LDS_WAIT(); asm volatile("" ::: "memory");
}
__device__ __forceinline__ void convert_layer_weights(Frame& F, int l, int gw, int NGW) {
    LAS float* scr = (LAS float*)(F.lds + RING_OFF + F.wave * 16384);
    constexpr int I_IN = 16 * 256, I_BRN = 3 * 8 * 32, I_ON = 16 * 32;
    for (int it = gw; it < I_IN + I_BRN + I_ON; it += NGW) {
        int r = it;
        if (r < I_IN) { const int kb = r >> 8, nb = r & 255; transpose_item<true>(F.in[I_WIN] + (size_t)l * D * INW, INW, 64 * kb, 32 * nb, (bf16*)(F.ws + WS_WIN), D, 32 * nb, scr, F.lane); continue; } r -= I_IN;
        if (r < I_BRN) { const int br = r >> 8, q = r & 255, kb = q >> 5, nb = q & 31;
            transpose_item<false>(F.in[I_WBR] + ((size_t)l * 3 + br) * 512 * D, D, 64 * kb, 32 * nb, (bf16*)(F.ws + WS_WBR) + (size_t)br * D * 512, 512, 32 * nb, scr, F.lane); continue; } r -= I_BRN;
        { const int kb = r >> 5, nb = r & 31; transpose_item<false>(F.in[I_WO] + (size_t)l * D * D, D, 64 * kb, 32 * nb, (bf16*)(F.ws + WS_WO), D, 32 * nb, scr, F.lane); }
    }
}
__device__ __forceinline__ void convert_expert_weights(Frame& F, int l, int gw, int NGW) {
    LAS float* scr = (LAS float*)(F.lds + RING_OFF + F.wave * 16384);
    constexpr int PER = 256;
    for (int it = gw; it < 3 * NE * PER; it += NGW) {
        const int which = it / (NE * PER), r = it % (NE * PER), e = r / PER, q = r % PER;
        if (which < 2) { const int kb = q >> 4, nb = q & 15, n0 = 32 * nb;
            const float* W = F.in[which == 0 ? I_WG : I_WU] + ((size_t)l * NE + e) * D * DE;
            transpose_item<false>(W, DE, 64 * kb, n0, (bf16*)(F.ws + WS_EW) + (size_t)e * 1024 * D, D, (n0 >> 7) * 256 + (n0 & 127) + which * 128, scr, F.lane);
        } else { const int kb = q >> 5, nb = q & 31;
            const float* W = F.in[I_WD] + ((size_t)l * NE + e) * DE * D;
            transpose_item<false>(W, D, 64 * kb, 32 * nb, (bf16*)(F.ws + WS_EWD) + (size_t)e * D * DE, DE, 32 * nb, scr, F.lane);
        }
    }
}

struct LnGB { f32x4 g[4], b[4]; };
__device__ __forceinline__ void ln_load_gb(LnGB& p, const float* g, const float* b, int lane) {
#pragma unroll
    for (int j = 0; j < 4; ++j) { p.g[j] = *(const GAS f32x4*)(g + 256 * j + 4 * lane); p.b[j] = *(const GAS f32x4*)(b + 256 * j + 4 * lane); }
}
__device__ __forceinline__ void ln_row(f32x4 (&v)[4], const LnGB& p) {
    float s = 0.f;
#pragma unroll
    for (int j = 0; j < 4; ++j) s += (v[j].x + v[j].y) + (v[j].z + v[j].w);
    const float mean = wave_sum(s) * (1.f / D); float s2 = 0.f;
#pragma unroll
    for (int j = 0; j < 4; ++j) { v[j] = v[j] - mean; s2 += (v[j].x * v[j].x + v[j].y * v[j].y) + (v[j].z * v[j].z + v[j].w * v[j].w); }
    const float rstd = 1.f / sqrtf(wave_sum(s2) * (1.f / D) + LN_EPS);
#pragma unroll
    for (int j = 0; j < 4; ++j) v[j] = v[j] * rstd * p.g[j] + p.b[j];
}
__device__ __forceinline__ void store_row(const f32x4 (&v)[4], float* of32, bf16* obf, int lane) {
    if (of32) {
#pragma unroll
        for (int j = 0; j < 4; ++j) *((GAS f32x4*)of32 + 64 * j + lane) = v[j];
    }
    if (obf) {
        GAS unsigned long long* o8 = (GAS unsigned long long*)obf + lane;
#pragma unroll
        for (int j = 0; j < 4; ++j) o8[64 * j] = (unsigned long long)pk2(v[j].x, v[j].y) | ((unsigned long long)pk2(v[j].z, v[j].w) << 32);
    }
}

__device__ __forceinline__ void sincos_tab(double a, float& c, float& s) {
    const double q = rint(a * 0.63661977236758134308);
    double r = fma(-q, 1.57079632679489655800e+00, a); r = fma(-q, 6.12323399573676603587e-17, r);
    const double r2 = r * r;
    double sp = -1.0 / 1307674368000.0; sp = fma(sp, r2, 1.0 / 6227020800.0); sp = fma(sp, r2, -1.0 / 39916800.0); sp = fma(sp, r2, 1.0 / 362880.0); sp = fma(sp, r2, -1.0 / 5040.0); sp = fma(sp, r2, 1.0 / 120.0); sp = fma(sp, r2, -1.0 / 6.0); sp = fma(sp * r2, r, r);
    double cp = 1.0 / 20922789888000.0; cp = fma(cp, r2, -1.0 / 87178291200.0); cp = fma(cp, r2, 1.0 / 479001600.0); cp = fma(cp, r2, -1.0 / 3628800.0); cp = fma(cp, r2, 1.0 / 40320.0); cp = fma(cp, r2, -1.0 / 720.0); cp = fma(cp, r2, 1.0 / 24.0); cp = fma(cp, r2, -0.5); cp = fma(cp, r2, 1.0);
    const int n = (int)q & 3;
    const double sn_ = (n & 1) ? cp : sp, cn_ = (n & 1) ? sp : cp;
    s = (float)((n & 2) ? -sn_ : sn_); c = (float)(((n + 1) & 2) ? -cn_ : cn_);
}
__device__ __forceinline__ void p0_prologue(Frame& F) {
    const int gw = F.vcu * NWAVES + F.wave, NGW = F.G * NWAVES;
    convert_layer_weights(F, 0, gw, NGW);
    {
        LnGB P; ln_load_gb(P, F.in[I_LNG], F.in[I_LNB], F.lane);
        f32x4 vA[4], vB[4];
#define P0_LOAD(V_, m_) do { const int mm_ = (m_) < T ? (m_) : T - 1; _Pragma("unroll") for (int j = 0; j < 4; ++j) V_[j] = *((const GAS f32x4*)(F.in[I_X] + (size_t)mm_ * D) + 64 * j + F.lane); __builtin_amdgcn_sched_barrier(0); } while (0)
#define P0_PROC(V_, m_) do { if ((m_) < T) { ln_row(V_, P); store_row(V_, (float*)nullptr, (bf16*)(F.ws + WS_XN) + (size_t)(m_) * D, F.lane); } __builtin_amdgcn_sched_barrier(0); } while (0)
        P0_LOAD(vA, gw);
        for (int m = gw; m < T; m += 2 * NGW) { P0_LOAD(vB, m + NGW); P0_PROC(vA, m); P0_LOAD(vA, m + 2 * NGW); P0_PROC(vB, m + NGW); }
#undef P0_LOAD
#undef P0_PROC
    }
    const int* positions = (const int*)F.in[I_POS];
    float* cs = (float*)(F.ws + WS_CS); float* sn = (float*)(F.ws + WS_SN);
    for (int i = (F.vcu * NWAVES * 64) + F.tid; i < T * 32; i += F.G * NWAVES * 64) {
        const int t = i >> 5, k = i & 31;
        const float inv = powf(10000.0f, -(float)(2 * k) / 64.0f);
        const float ang = (float)positions[t] * inv;
        sincos_tab((double)ang, cs[i], sn[i]);
    }
}

__device__ __forceinline__ void fox_scan(Frame& F) {
    const int gw = F.vcu * NWAVES + F.wave;
    if (gw >= NB * 8) return;
    const int b = gw >> 3, h = gw & 7;
    const float* lf = (const float*)(F.ws + WS_LF) + (size_t)b * S * 8 + h;
    float* cb = (float*)(F.ws + WS_CB) + (size_t)gw * S;
    const int t0 = F.lane * 64;
    float x[64];
#pragma unroll
    for (int i = 0; i < 64; ++i) x[i] = ((const GAS float*)lf)[(size_t)(t0 + i) * 8];
    double tot = 0.0;
#pragma unroll
    for (int i = 0; i < 64; ++i) tot += (double)x[i];
    double inc = tot;
#pragma unroll
    for (int o = 1; o < 64; o <<= 1) { const double n = __shfl_up(inc, o); if (F.lane >= o) inc += n; }
    double run = inc - tot;
#pragma unroll
    for (int i = 0; i < 64; i += 4) { f32x4 o4;
#pragma unroll
        for (int k = 0; k < 4; ++k) { run += (double)x[i + k]; o4[k] = (float)run; }
        *(GAS f32x4*)(cb + t0 + i) = o4; }
}

__device__ __forceinline__ void diff_combine(Frame& F, int l) {
    const int gw = F.vcu * NWAVES + F.wave, NGW = F.G * NWAVES, lane = F.lane;
    const float* lamp = F.in[I_LAM] + l * 256; const float* g = F.in[I_DNG] + l * 128;
    const float lam_init = 0.8f - 0.6f * expf(-0.3f * (float)l);
    const float s1 = wave_sum(lamp[lane] * lamp[64 + lane]), s2 = wave_sum(lamp[128 + lane] * lamp[192 + lane]);
    const float lam = expf(s1) - expf(s2) + lam_init;
    const float g0 = g[2 * lane], g1 = g[2 * lane + 1];
    const GAS unsigned* od = (const GAS unsigned*)(F.ws + WS_OD); GAS unsigned* oc = (GAS unsigned*)(F.ws + WS_ODC);
    unsigned an[4], bn[4];
#pragma unroll
    for (int h = 0; h < 4; ++h) { an[h] = 0u; bn[h] = 0u; }
    if (gw < T) {
#pragma unroll
        for (int h = 0; h < 4; ++h) { an[h] = od[(size_t)gw * 512 + h * 128 + lane]; bn[h] = od[(size_t)gw * 512 + h * 128 + 64 + lane]; }
    }
    for (int t = gw; t < T; t += NGW) {
        unsigned a[4], b[4];
#pragma unroll
        for (int h = 0; h < 4; ++h) { a[h] = an[h]; b[h] = bn[h]; }
        { const int tn = t + NGW; if (tn < T) {
#pragma unroll
            for (int h = 0; h < 4; ++h) { an[h] = od[(size_t)tn * 512 + h * 128 + lane]; bn[h] = od[(size_t)tn * 512 + h * 128 + 64 + lane]; } } }
        float v0[4], v1[4], ss[4];
#pragma unroll
        for (int h = 0; h < 4; ++h) { v0[h] = bflo(a[h]) - lam * bflo(b[h]); v1[h] = bfhi(a[h]) - lam * bfhi(b[h]); ss[h] = v0[h] * v0[h] + v1[h] * v1[h]; }
#pragma unroll
        for (int o = 1; o < 64; o <<= 1) {
#pragma unroll
            for (int h = 0; h < 4; ++h) ss[h] += __shfl_xor(ss[h], o); }
#pragma unroll
        for (int h = 0; h < 4; ++h) { const float r = (1.f / sqrtf(ss[h] * (1.f / 128.f) + LN_EPS)) * (1.f - lam_init);
            oc[(size_t)t * 256 + h * 64 + lane] = pk2(v0[h] * r * g0, v1[h] * r * g1); }
    }
}

typedef float f32x16r __attribute__((ext_vector_type(16)));
__device__ __forceinline__ void p8_ln1_router(Frame& F, int l) {
    const int lane = F.lane, wid = F.wave, tid = F.tid;
    const int m0 = (int)blockIdx.x * 128;
    LAS float* part = (LAS float*)(F.lds + RING_OFF);
    LAS float* affl = (LAS float*)(F.lds + RING_OFF + 16384);
    LAS int* cnt = (LAS int*)(F.lds + TAB_OFF);
    if (tid < NE) cnt[tid] = 0;
    const float* g1 = F.in[I_LN1G] + l * D; const float* b1 = F.in[I_LN1B] + l * D;
    {
        LnGB P; ln_load_gb(P, g1, b1, lane);
        v2u bA[4], bB[4];
        const int r0 = m0 + wid * 16;
        const bf16* S1 = (const bf16*)(F.ws + WS_S1);
#define P8_LOAD(B_, m_) do { _Pragma("unroll") for (int j = 0; j < 4; ++j) B_[j] = *((const GAS v2u*)(S1 + (size_t)(m_) * D) + 64 * j + lane); __builtin_amdgcn_sched_barrier(0); } while (0)
#define P8_PROC(B_, m_) do { f32x4 v[4]; _Pragma("unroll") for (int j = 0; j < 4; ++j) v[j] = (f32x4){bflo(B_[j].x), bfhi(B_[j].x), bflo(B_[j].y), bfhi(B_[j].y)}; \
            ln_row(v, P); store_row(v, (float*)nullptr, (bf16*)(F.ws + WS_XN) + (size_t)(m_) * D, lane); __builtin_amdgcn_sched_barrier(0); } while (0)
        P8_LOAD(bA, r0);
#pragma unroll 1
        for (int rr = 0; rr < 16; rr += 2) { P8_LOAD(bB, r0 + rr + 1); P8_PROC(bA, r0 + rr); P8_LOAD(bA, r0 + (rr + 2 < 16 ? rr + 2 : 15)); P8_PROC(bB, r0 + rr + 1); }
#undef P8_LOAD
#undef P8_PROC
    }
    VM_WAIT(); __syncthreads();
    {
        const int t = wid & 3, kh = wid >> 2, i32 = lane & 31, kk = lane >> 5;
        const bf16* xrow = (const bf16*)(F.ws + WS_XN) + (size_t)(m0 + 32 * t + i32) * D + 512 * kh + 4 * kk;
        const float* wr = F.in[I_WR] + (size_t)(512 * kh + 4 * kk) * NE + i32;
        f32x16r acc = {};
        const GAS float* wrg = (const GAS float*)wr;
        v2u xA[4], xB[4]; float wA[16], wB[16];
#define RT_LOAD(X_, W_, grp_) do { const int c0_ = 4 * (grp_); _Pragma("unroll") for (int q = 0; q < 4; ++q) { X_[q] = *(const GAS v2u*)(xrow + 8 * (c0_ + q)); \
            _Pragma("unroll") for (int e = 0; e < 4; ++e) W_[4 * q + e] = wrg[(8 * (c0_ + q) + e) * NE]; } __builtin_amdgcn_sched_barrier(0); } while (0)
#define RT_MMA(X_, W_) do { _Pragma("unroll") for (int q = 0; q < 4; ++q) { const f32x4 a4 = {bflo(X_[q].x), bfhi(X_[q].x), bflo(X_[q].y), bfhi(X_[q].y)}; \
            _Pragma("unroll") for (int e = 0; e < 4; ++e) acc = __builtin_amdgcn_mfma_f32_32x32x2f32(a4[e], W_[4 * q + e], acc, 0, 0, 0); } __builtin_amdgcn_sched_barrier(0); } while (0)
        RT_LOAD(xA, wA, 0);
#pragma unroll 1
        for (int it = 0; it < 8; ++it) {
            RT_LOAD(xB, wB, 2 * it + 1); RT_MMA(xA, wA);
            RT_LOAD(xA, wA, (it < 7 ? 2 * it + 2 : 15)); RT_MMA(xB, wB);
        }
#undef RT_LOAD
#undef RT_MMA
        if (kh == 1) {
#pragma unroll
            for (int r = 0; r < 16; ++r) part[(t * 16 + r) * 64 + lane] = acc[r];
        }
        __syncthreads();
        if (kh == 0) {
#pragma unroll
            for (int r = 0; r < 16; ++r) { const float a = acc[r] + part[(t * 16 + r) * 64 + lane]; const int row = 32 * t + (r & 3) + 8 * (r >> 2) + 4 * kk;
                affl[row * 33 + i32] = 1.f / (1.f + expf(-a)); }
        }
        __syncthreads();
    }
    if (tid < 128) {
        const float* br = F.in[I_BR];
        const LAS float* af = affl + tid * 33;
        int gbest = 0; float gs = -INFINITY;
#pragma unroll
        for (int g = 0; g < 4; ++g) {
            float m1 = -INFINITY, m2 = -INFINITY;
#pragma unroll
            for (int i = 0; i < 8; ++i) { const float x = af[g * 8 + i] + br[g * 8 + i]; if (x > m1) { m2 = m1; m1 = x; } else if (x > m2) m2 = x; }
            const float sc = m1 + m2;
            if (sc > gs) { gs = sc; gbest = g; }
        }
        int i1 = 0, i2 = 0; float m1 = -INFINITY, m2 = -INFINITY, a1 = 0.f, a2 = 0.f;
        const f32x4 bsel0 = *(const GAS f32x4*)(br + gbest * 8), bsel1 = *(const GAS f32x4*)(br + gbest * 8 + 4);
#pragma unroll
        for (int i = 0; i < 8; ++i) { const float afv = af[gbest * 8 + i], x = afv + (i < 4 ? bsel0[i & 3] : bsel1[i & 3]);
            if (x > m1) { m2 = m1; i2 = i1; a2 = a1; m1 = x; i1 = i; a1 = afv; } else if (x > m2) { m2 = x; i2 = i; a2 = afv; } }
        const int e1 = gbest * 8 + i1, e2 = gbest * 8 + i2; const float sum = a1 + a2; const int m = m0 + tid;
        int* eidx = (int*)(F.ws + WS_EIDX); float* wts = (float*)(F.ws + WS_WTS);
        eidx[m * 2] = e1; eidx[m * 2 + 1] = e2; wts[m * 2] = a1 / sum; wts[m * 2 + 1] = a2 / sum;
        __hip_atomic_fetch_add(&cnt[e1], 1, __ATOMIC_RELAXED, __HIP_MEMORY_SCOPE_WORKGROUP); __hip_atomic_fetch_add(&cnt[e2], 1, __ATOMIC_RELAXED, __HIP_MEMORY_SCOPE_WORKGROUP);
    }
    __syncthreads();
    if (tid < NE) ((int*)(F.ws + WS_HIST))[blockIdx.x * NE + tid] = cnt[tid];
    int* row_tok = (int*)(F.ws + WS_ROWTOK);
    for (int i = tid; i < RPAD / 256; i += NWAVES * 64) row_tok[blockIdx.x * (RPAD / 256) + i] = 0;
    __syncthreads();
    const int gw = F.vcu * NWAVES + F.wave, NGW = F.G * NWAVES;
    convert_expert_weights(F, l, gw, NGW);
#ifdef PROBE_CONV2
    convert_expert_weights(F, l, gw, NGW);
#endif
    if (l + 1 < DEPTH) convert_layer_weights(F, l + 1, gw, NGW);
}

__device__ __forceinline__ void p9_placement(Frame& F) {
    LAS int* tot = (LAS int*)(F.lds + RING_OFF); LAS int* before = tot + 32; LAS int* start = tot + 64; LAS int* earr = tot + 128;
    const int* hist = (const int*)(F.ws + WS_HIST);
    const int blk = blockIdx.x;
    {
        LAS int* ptot = tot + 512; LAS int* pbef = tot + 1024;
        const int e = F.tid & 31, part = F.tid >> 5; int t = 0, bfr = 0;
#pragma unroll
        for (int i = 0; i < 16; ++i) { const int b = part * 16 + i; const int c = __hip_atomic_load(hist + b * NE + e, RLX_AGENT); t += c; bfr += (b < blk) ? c : 0; }
        ptot[part * 32 + e] = t; pbef[part * 32 + e] = bfr;
        __syncthreads();
        if (F.tid < NE) { int ts = 0, bs = 0;
#pragma unroll
            for (int p = 0; p < 16; ++p) { ts += ptot[p * 32 + F.tid]; bs += pbef[p * 32 + F.tid]; }
            tot[F.tid] = ts; before[F.tid] = bs; }
    }
    __syncthreads();
    if (F.tid == 0) { int run = 0; for (int e = 0; e < NE; ++e) { start[e] = run; run += (tot[e] + 255) & ~255; } start[NE] = run; }
    __syncthreads();
    const int* eidx = (const int*)(F.ws + WS_EIDX);
    int e = 0;
    if (F.tid < 256) { e = eidx[blk * 256 + F.tid]; earr[F.tid] = e; }
    __syncthreads();
    if (F.tid < 256) {
        int rank = 0;
        for (int a = 0; a < 256; ++a) rank += (a < F.tid && earr[a] == e) ? 1 : 0;
        const int p = start[e] + before[e] + rank;
        ((int*)(F.ws + WS_ROWTOK))[p] = blk * 128 + (F.tid >> 1);
        ((int*)(F.ws + WS_POS))[blk * 256 + F.tid] = p;
    }
    if (blk == 0) {
        int* tile_e = (int*)(F.ws + WS_TILEE);
        if (F.tid < NE) { const int t0 = start[F.tid] >> 8, t1 = start[F.tid + 1] >> 8; for (int t = t0; t < t1; ++t) tile_e[t] = F.tid; }
        if (F.tid == 0) tile_e[NRT_MAX] = start[NE] >> 8;
    }
    __syncthreads();
}

__device__ __forceinline__ void p12_combine_ln2(Frame& F, int l, bool dry = false) {
    const int gw = F.vcu * NWAVES + F.wave, NGW = F.G * NWAVES, lane = F.lane;
    const float* g2 = F.in[I_LN2G] + l * D; const float* b2 = F.in[I_LN2B] + l * D;
    const int* pos = (const int*)(F.ws + WS_POS); const float* wts = (const float*)(F.ws + WS_WTS);
    const bf16* yr = (const bf16*)(F.ws + WS_YR);
    LnGB P; ln_load_gb(P, g2, b2, lane);
    const GAS int* posg = (const GAS int*)pos; const GAS float* wtsg = (const GAS float*)wts; const bf16* xn = (const bf16*)(F.ws + WS_XN);
    v2u hA[4], aA[4], bA[4], hB[4], aB[4], bB[4]; float wA0, wA1, wB0, wB1, wN0, wN1; int pN0, pN1;
#define P12_POS(m_) do { const int mm_ = (m_) < T ? (m_) : T - 1; pN0 = posg[mm_ * 2]; pN1 = posg[mm_ * 2 + 1]; wN0 = wtsg[mm_ * 2]; wN1 = wtsg[mm_ * 2 + 1]; } while (0)
#define P12_LOAD(H_, A_, B_, W0_, W1_, m_) do { const int mm_ = (m_) < T ? (m_) : T - 1; W0_ = wN0; W1_ = wN1; _Pragma("unroll") for (int j = 0; j < 4; ++j) { H_[j] = *((const GAS v2u*)(xn + (size_t)mm_ * D) + 64 * j + lane); \
        A_[j] = *((const GAS v2u*)(yr + (size_t)pN0 * D) + 64 * j + lane); B_[j] = *((const GAS v2u*)(yr + (size_t)pN1 * D) + 64 * j + lane); } } while (0)
#define P12_PROC(H_, A_, B_, W0_, W1_, m_) do { if ((m_) < T) { f32x4 v[4]; _Pragma("unroll") for (int j = 0; j < 4; ++j) { \
            v[j].x = ALPHA * bflo(H_[j].x) + (W0_ * bflo(A_[j].x) + W1_ * bflo(B_[j].x)); v[j].y = ALPHA * bfhi(H_[j].x) + (W0_ * bfhi(A_[j].x) + W1_ * bfhi(B_[j].x)); \
            v[j].z = ALPHA * bflo(H_[j].y) + (W0_ * bflo(A_[j].y) + W1_ * bflo(B_[j].y)); v[j].w = ALPHA * bfhi(H_[j].y) + (W0_ * bfhi(A_[j].y) + W1_ * bfhi(B_[j].y)); } \
        ln_row(v, P); \
        store_row(v, (dry || l + 1 < DEPTH) ? (float*)nullptr : F.out + (size_t)(m_) * D, (l + 1 < DEPTH && !dry) ? (bf16*)(F.ws + WS_XN) + (size_t)(m_) * D : (bf16*)nullptr, lane); } __builtin_amdgcn_sched_barrier(0); } while (0)
    P12_POS(gw); P12_LOAD(hA, aA, bA, wA0, wA1, gw); P12_POS(gw + NGW); __builtin_amdgcn_sched_barrier(0);
    for (int m = gw; m < T; m += 2 * NGW) {
        P12_LOAD(hB, aB, bB, wB0, wB1, m + NGW); P12_POS(m + 2 * NGW); __builtin_amdgcn_sched_barrier(0);
        P12_PROC(hA, aA, bA, wA0, wA1, m);
        P12_LOAD(hA, aA, bA, wA0, wA1, m + 2 * NGW); P12_POS(m + 3 * NGW); __builtin_amdgcn_sched_barrier(0);
        P12_PROC(hB, aB, bB, wB0, wB1, m + NGW);
    }
#undef P12_POS
#undef P12_LOAD
#undef P12_PROC
}
using pg8::Unit;
struct SchedGrid {
    int nM, nN, G, c;
    __device__ __forceinline__ bool next(int i, Unit& u) const { const int L = i * G + c; if (L >= nM * nN) return false; pg8::map_unit(L, nM, nN, u.pm, u.pn); u.aux = 0; return true; }
};
struct SchedU {
    int G, c;
    __device__ __forceinline__ bool next(int i, Unit& u) const { const int L = i * G + c; if (L >= 3 * 512) return false; u.aux = L >> 9; pg8::map_unit(L & 511, 128, 4, u.pm, u.pn); return true; }
};
struct SchedY {
    int G, c;
    __device__ __forceinline__ bool next(int i, Unit& u) const { const int slot = i / 3, br = i - 3 * slot; const int L = slot * G + c; if (L >= 512) return false; pg8::map_unit(L, 128, 4, u.pm, u.pn); u.aux = br; return true; }
};
struct SchedMoe {
    const LAS int* tabe; int ntiles, G, c;
    __device__ __forceinline__ void a_ready(const Unit&, int, int) const {}
    __device__ __forceinline__ bool unit(int i, Unit& u) const { const int L = i * G + c; if (L >= ntiles * 4) return false; pg8::map_unit(L, ntiles, 4, u.pm, u.pn); return true; }
    __device__ __forceinline__ bool next(int i, Unit& u) const { if (!unit(i, u)) return false; u.aux = __builtin_amdgcn_readfirstlane(tabe[i]); return true; }
};

struct GPlain {
    static constexpr bool GATHER = false;
    const char* a_base; const char* b_base; int K, lda;
    __device__ __forceinline__ const char* a_ptr(const Unit& u) const { return a_base + (size_t)u.pm * 256 * lda * 2; }
    __device__ __forceinline__ const char* b_ptr(const Unit& u) const { return b_base + (size_t)u.pn * 256 * K * 2; }
};
struct GBranch {
    static constexpr bool GATHER = false;
    const char* a_base; const char* b_base; int K, lda;
    __device__ __forceinline__ const char* a_ptr(const Unit& u) const {
        const size_t base = u.aux == 0 ? WS_ODC : u.aux == 1 ? WS_OS : WS_OF;
        return a_base + base + (size_t)u.pm * 256 * 512 * 2;
    }
    __device__ __forceinline__ const char* b_ptr(const Unit& u) const { return b_base + ((size_t)u.aux * 1024 + (size_t)u.pn * 256) * 512 * 2; }
};
struct GGate {
    static constexpr bool GATHER = false;
    const char* a_base; const char* b_base; int K, lda;
    __device__ __forceinline__ const char* a_ptr(const Unit& u) const { return a_base + (size_t)u.pm * 256 * 1024 * 2; }
    __device__ __forceinline__ const char* b_ptr(const Unit& u) const { return b_base + ((size_t)NPROJ + (size_t)u.aux * 1024 + (size_t)u.pn * 256) * 1024 * 2; }
};
struct GMoe1 {
    static constexpr bool GATHER = true;
    const char* a_base; const char* b_base; int K; const LAS int* tab;
    __device__ __forceinline__ unsigned a_off(const Unit&, int ui, int half, int R, int C) const { return (unsigned)tab[ui * 256 + half * 128 + R] * 2048u + (unsigned)C * 2u; }
    __device__ __forceinline__ const char* b_ptr(const Unit& u) const { return b_base + ((size_t)u.aux * 1024 + (size_t)u.pn * 256) * 1024 * 2; }
};
struct GMoe2 {
    static constexpr bool GATHER = false;
    const char* a_base; const char* b_base; int K, lda;
    __device__ __forceinline__ const char* a_ptr(const Unit& u) const { return a_base + (size_t)u.pm * 256 * 512 * 2; }
    __device__ __forceinline__ const char* b_ptr(const Unit& u) const { return b_base + ((size_t)u.aux * 1024 + (size_t)u.pn * 256) * 512 * 2; }
};

typedef const f32x4 (&AccRef)[2][2][4][2];
__device__ __forceinline__ v4u pack8(f32x4 a, f32x4 b) { v4u w; w.x = cvt_pk_bf16(a[0], a[1]); w.y = cvt_pk_bf16(a[2], a[3]); w.z = cvt_pk_bf16(b[0], b[1]); w.w = cvt_pk_bf16(b[2], b[3]); return w; }
__device__ __forceinline__ void rope8(f32x4& a, f32x4& b, const float* cs, const float* sn) {
    const f32x4 c = *(const GAS f32x4*)cs, s = *(const GAS f32x4*)sn;
    const f32x4 a2 = {a[0] * c[0] - a[1] * s[0], a[1] * c[0] + a[0] * s[0], a[2] * c[1] - a[3] * s[1], a[3] * c[1] + a[2] * s[1]};
    const f32x4 b2 = {b[0] * c[2] - b[1] * s[2], b[1] * c[2] + b[0] * s[2], b[2] * c[3] - b[3] * s[3], b[3] * c[3] + b[2] * s[3]};
    a = a2; b = b2;
}
#ifndef PROBE_EPIVAR
#define PROBE_EPIVAR 0
#endif
template <int VAR>
struct EpiProjT {
    unsigned char* ws; const float* bforget;
    __device__ __forceinline__ void operator()(AccRef acc, const Unit& u, int wr, int wc, int fr, int fq) const { asm volatile("" : "+v"(fr), "+v"(fq));
        const float* cs = (const float*)(ws + WS_CS); const float* sn = (const float*)(ws + WS_SN);
        const int pn = u.pn, row0 = u.pm * 256 + wr * 64 + fr, cw = wc * 32 + 8 * fq;
        if (pn < 19) {
            const int grp = pn >> 1;
            const bool rope = (VAR & 1) ? false : ((grp == 0) | (grp == 1) | (grp == 3) | (grp == 4) | (pn == 18));
            const float sc = ((grp == 0) | (grp == 3) | (grp == 6)) ? C2 : 1.f;
            bf16* base = pn < 18 ? (bf16*)(ws + WS_Z + (size_t)grp * ZG) + (pn & 1) * 256 : (bf16*)(ws + WS_IQ);
            const int pitch = pn < 18 ? 512 : 256;
            if (rope) { const int i0 = (cw & 63) >> 1;
                f32x4 cB[8], sB[8];
#pragma unroll
                for (int g = 0; g < 8; ++g) { const size_t ro_ = (size_t)(row0 + (g >> 2) * 128 + (g & 3) * 16) * 32 + i0; if (VAR & 4) { const float f_ = (float)(ro_ & 1023) * 0.001f; cB[g] = (f32x4){f_, f_ + 1.f, f_ + 2.f, f_ + 3.f}; sB[g] = (f32x4){f_ + 4.f, f_ + 5.f, f_ + 6.f, f_ + 7.f}; } else { cB[g] = *(const GAS f32x4*)(cs + ro_); sB[g] = *(const GAS f32x4*)(sn + ro_); } }
#pragma unroll
                for (int g = 0; g < 8; ++g) { const int ai = g >> 2, m = g & 3; const int row = row0 + ai * 128 + m * 16; const f32x4 c = cB[g] * sc, s = sB[g] * sc;
#pragma unroll
                    for (int bj = 0; bj < 2; ++bj) { const int col = bj * 128 + cw; const f32x4 v0 = acc[ai][bj][m][0], v1 = acc[ai][bj][m][1];
                        const f32x4 a2 = {v0[0] * c[0] - v0[1] * s[0], v0[1] * c[0] + v0[0] * s[0], v0[2] * c[1] - v0[3] * s[1], v0[3] * c[1] + v0[2] * s[1]};
                        const f32x4 b2 = {v1[0] * c[2] - v1[1] * s[2], v1[1] * c[2] + v1[0] * s[2], v1[2] * c[3] - v1[3] * s[3], v1[3] * c[3] + v1[2] * s[3]};
                        *(GAS v4u*)(base + (size_t)row * pitch + col) = pack8(a2, b2); } }
            } else {
#pragma unroll
                for (int g = 0; g < 8; ++g) { const int ai = g >> 2, m = g & 3; const int row = row0 + ai * 128 + m * 16;
#pragma unroll
                    for (int bj = 0; bj < 2; ++bj) { const int col = bj * 128 + cw;
                        *(GAS v4u*)(base + (size_t)row * pitch + col) = pack8(acc[ai][bj][m][0] * sc, acc[ai][bj][m][1] * sc); } }
            }
        } else if (!(VAR & 2)) {
            bf16* ik = (bf16*)(ws + WS_IK); float* iw = (float*)(ws + WS_IW); float* lf = (float*)(ws + WS_LF);
            if (cw < 64) { const int i0 = cw >> 1, g_ = cw >> 3; f32x4 cB[8], sB[8];
#pragma unroll
                for (int g = 0; g < 8; ++g) { const size_t ro_ = (size_t)(row0 + (g >> 2) * 128 + (g & 3) * 16) * 32 + i0; cB[g] = *(const GAS f32x4*)(cs + ro_); sB[g] = *(const GAS f32x4*)(sn + ro_); }
#pragma unroll
                for (int g = 0; g < 8; ++g) { const int ai = g >> 2, m = g & 3; const int row = row0 + ai * 128 + m * 16, kk_ = row & 63; const f32x4 c = cB[g], s = sB[g];
                    const f32x4 v0 = acc[ai][0][m][0], v1 = acc[ai][0][m][1];
                    const f32x4 a2 = {v0[0] * c[0] - v0[1] * s[0], v0[1] * c[0] + v0[0] * s[0], v0[2] * c[1] - v0[3] * s[1], v0[3] * c[1] + v0[2] * s[1]};
                    const f32x4 b2 = {v1[0] * c[2] - v1[1] * s[2], v1[1] * c[2] + v1[0] * s[2], v1[2] * c[3] - v1[3] * s[3], v1[3] * c[3] + v1[2] * s[3]};
                    *(GAS v4u*)(ik + (size_t)(row >> 6) * 4096 + (size_t)((((kk_ >> 5) * 4 + (g_ >> 1)) * 64 + (g_ & 1) * 32 + (kk_ & 31)) * 8)) = pack8(a2, b2); }
            } else {
#pragma unroll
            for (int ai = 0; ai < 2; ++ai)
#pragma unroll
                for (int m = 0; m < 4; ++m) { const int row = row0 + ai * 128 + m * 16;
                    const f32x4 v0 = acc[ai][0][m][0], v1 = acc[ai][0][m][1];
                    if (cw == 64) { *(GAS f32x4*)(iw + (size_t)row * 4) = v0 * 0.0625f;
                        f32x4 o;
#pragma unroll
                        for (int j = 0; j < 4; ++j) { const float x = v1[j] + bforget[j]; o[j] = LOG2E * (fminf(x, 0.f) - log1pf(expf(-fabsf(x)))); }
                        *(GAS f32x4*)(lf + (size_t)row * 8) = o; }
                    else if (cw == 72) { f32x4 o;
#pragma unroll
                        for (int j = 0; j < 4; ++j) { const float x = v0[j] + bforget[4 + j]; o[j] = LOG2E * (fminf(x, 0.f) - log1pf(expf(-fabsf(x)))); }
                        *(GAS f32x4*)(lf + (size_t)row * 8 + 4) = o; } }
            }
        }
    }
};
typedef EpiProjT<0> EpiProj;
struct EpiPlain {
    bf16* O; int ldc, aux_cols;
    __device__ __forceinline__ void operator()(AccRef acc, const Unit& u, int wr, int wc, int fr, int fq) const { asm volatile("" : "+v"(fr), "+v"(fq));
        const int row0 = u.pm * 256 + wr * 64 + fr, col0 = u.aux * aux_cols + u.pn * 256 + wc * 32 + 8 * fq;
#pragma unroll
        for (int ai = 0; ai < 2; ++ai)
#pragma unroll
            for (int m = 0; m < 4; ++m) { bf16* rowp = O + (size_t)(row0 + ai * 128 + m * 16) * ldc + col0;
#pragma unroll
                for (int bj = 0; bj < 2; ++bj) *(GAS v4u*)(rowp + bj * 128) = pack8(acc[ai][bj][m][0], acc[ai][bj][m][1]); }
    }
};
struct EpiGate {
    const bf16* U; bf16* Y;
    __device__ __forceinline__ void operator()(AccRef acc, const Unit& u, int wr, int wc, int fr, int fq) const { asm volatile("" : "+v"(fr), "+v"(fq));
        const int row0 = u.pm * 256 + wr * 64 + fr, col0 = u.pn * 256 + wc * 32 + 8 * fq;
        const bool acc_y = u.aux != 0;
        v4u uB[3][2], yB[3][2];
#define EG_LOAD(g_, s_) do { const size_t rw_ = (size_t)(row0 + ((g_) >> 2) * 128 + ((g_) & 3) * 16); _Pragma("unroll") for (int bj = 0; bj < 2; ++bj) { const int col = col0 + bj * 128; \
            uB[s_][bj] = *(const GAS v4u*)(U + rw_ * 3072 + u.aux * 1024 + col); yB[s_][bj] = acc_y ? *(const GAS v4u*)(Y + rw_ * 1024 + col) : (v4u){0u, 0u, 0u, 0u}; } } while (0)
        EG_LOAD(0, 0); EG_LOAD(1, 1);
#pragma unroll
        for (int g = 0; g < 8; ++g) { const int ai = g >> 2, m = g & 3; const size_t row = (size_t)(row0 + ai * 128 + m * 16);
            if (g + 2 < 8) EG_LOAD(g + 2, (g + 2) % 3);
#pragma unroll
            for (int bj = 0; bj < 2; ++bj) { const int col = col0 + bj * 128;
                const v4u uu = uB[g % 3][bj], yy = yB[g % 3][bj];
                f32x4 a = acc[ai][bj][m][0], b = acc[ai][bj][m][1];
#pragma unroll
                for (int j = 0; j < 4; ++j) { a[j] = sigmoidf_(a[j]); b[j] = sigmoidf_(b[j]); }
                a[0] *= bflo(uu.x); a[1] *= bfhi(uu.x); a[2] *= bflo(uu.y); a[3] *= bfhi(uu.y);
                b[0] *= bflo(uu.z); b[1] *= bfhi(uu.z); b[2] *= bflo(uu.w); b[3] *= bfhi(uu.w);
                a[0] += bflo(yy.x); a[1] += bfhi(yy.x); a[2] += bflo(yy.y); a[3] += bfhi(yy.y);
                b[0] += bflo(yy.z); b[1] += bfhi(yy.z); b[2] += bflo(yy.w); b[3] += bfhi(yy.w);
                *(GAS v4u*)(Y + row * 1024 + col) = pack8(a, b); }
            asm volatile("" ::: "memory"); }
#undef EG_LOAD
    }
};
struct EpiResid {
    bf16* R; const bf16* XNp;
    __device__ __forceinline__ void operator()(AccRef acc, const Unit& u, int wr, int wc, int fr, int fq) const { asm volatile("" : "+v"(fr), "+v"(fq));
        const int row0 = u.pm * 256 + wr * 64 + fr, col0 = u.pn * 256 + wc * 32 + 8 * fq;
        v4u xB[3][2];
#define ER_LOAD(g_, s_) do { const size_t ro_ = (size_t)(row0 + ((g_) >> 2) * 128 + ((g_) & 3) * 16) * D + col0; _Pragma("unroll") for (int bj = 0; bj < 2; ++bj) xB[s_][bj] = *(const GAS v4u*)(XNp + ro_ + bj * 128); } while (0)
        ER_LOAD(0, 0); ER_LOAD(1, 1);
#pragma unroll
        for (int g = 0; g < 8; ++g) { const int ai = g >> 2, m = g & 3; const size_t ro = (size_t)(row0 + ai * 128 + m * 16) * D + col0;
            if (g + 2 < 8) ER_LOAD(g + 2, (g + 2) % 3);
#pragma unroll
            for (int bj = 0; bj < 2; ++bj) { const v4u x = xB[g % 3][bj];
                const f32x4 h0 = {bflo(x.x), bfhi(x.x), bflo(x.y), bfhi(x.y)}, h1 = {bflo(x.z), bfhi(x.z), bflo(x.w), bfhi(x.w)};
                *(GAS v4u*)(R + ro + bj * 128) = pack8(h0 * ALPHA + acc[ai][bj][m][0], h1 * ALPHA + acc[ai][bj][m][1]); }
            asm volatile("" ::: "memory"); }
#undef ER_LOAD
    }
};
struct EpiSwiglu {
    bf16* Hd;
    __device__ __forceinline__ void operator()(AccRef acc, const Unit& u, int wr, int wc, int fr, int fq) const { asm volatile("" : "+v"(fr), "+v"(fq));
        const int row0 = u.pm * 256 + wr * 64 + fr, col0 = u.pn * 128 + wc * 32 + 8 * fq;
#pragma unroll
        for (int ai = 0; ai < 2; ++ai)
#pragma unroll
            for (int m = 0; m < 4; ++m) { f32x4 a = acc[ai][0][m][0], b = acc[ai][0][m][1]; const f32x4 ua = acc[ai][1][m][0], ub = acc[ai][1][m][1];
#pragma unroll
                for (int j = 0; j < 4; ++j) { a[j] = a[j] * sigmoidf_(a[j]) * ua[j]; b[j] = b[j] * sigmoidf_(b[j]) * ub[j]; }
                *(GAS v4u*)(Hd + (size_t)(row0 + ai * 128 + m * 16) * DE + col0) = pack8(a, b); }
    }
};
namespace attn_body {
using bf16=__hip_bfloat16;
typedef unsigned long long u64x8 __attribute__((ext_vector_type(8)));
using bf16x8=__attribute__((ext_vector_type(8)))short;
using s16x4=__attribute__((ext_vector_type(4)))short;
using f32x16=__attribute__((ext_vector_type(16)))float;
using u32x4=__attribute__((ext_vector_type(4)))unsigned;
constexpr int SEQ=4096,D=64,DM=512;
constexpr int NW=8,QBLK=32,QB=QBLK*NW,KVBLK=64,NQB=SEQ/QB;
constexpr int ATTN_PITCH=DM, ATTN_UNIT_ROWS=QB;
__device__ __forceinline__ int crow(int r,int hi){return (r&3)+8*(r>>2)+4*hi;}
#define SBAR() __builtin_amdgcn_sched_barrier(0)
__device__ __forceinline__ void cmask(f32x16&p0,f32x16&p1,int jb,int qrel,int hi){
  const float NEG=-INFINITY; int kb=64*jb+4*hi;
  #pragma unroll
  for(int r=0;r<16;++r){int kv=kb+(r&3)+8*(r>>2); if(kv>qrel)p0[r]=NEG; if(kv+32>qrel)p1[r]=NEG;}
}

__device__ __forceinline__ void chunkmask(f32x16&p0,f32x16&p1,int jb,int wid){
  if(jb>(wid>>1)){ const float NEG=-INFINITY;
    #pragma unroll
    for(int r=0;r<16;++r){p0[r]=NEG;p1[r]=NEG;} }
}
constexpr int NSLOT=3, SLOTB=8192;
constexpr int LDS_K=0, LDS_V=NSLOT*SLOTB, LDS_WS=3*NSLOT*SLOTB, LDS_OST=LDS_WS+NW*64*4, LDS_CBT=LDS_OST+NW*4096, LDS_BYTES=LDS_CBT+16384;
constexpr float C2=0.125f*1.4426950408889634f;
__device__ __forceinline__ void glds16(const void*gsrc,unsigned lds_dst){unsigned keep;
  asm volatile("s_mov_b32 %0, m0\n\ts_mov_b32 m0, %2\n\ts_nop 0\n\tglobal_load_lds_dwordx4 %1, off\n\ts_mov_b32 m0, %0":"=&s"(keep):"v"(gsrc),"s"(lds_dst):"memory");}
__device__ __forceinline__ float max3f(float a,float b,float c){float r;asm("v_max3_f32 %0, %1, %2, %3":"=v"(r):"v"(a),"v"(b),"v"(c));return r;}
__device__ __forceinline__ float max2f(float a,float b){float r;asm("v_max_f32_e32 %0, %1, %2":"=v"(r):"v"(a),"v"(b));return r;}
__device__ __forceinline__ float fadd_s(float a,float b){float r;asm("v_add_f32_e32 %0, %1, %2":"=v"(r):"v"(a),"v"(b));return r;}
__device__ __forceinline__ float fsub_s(float a,float b){float r;asm("v_sub_f32_e32 %0, %1, %2":"=v"(r):"v"(a),"v"(b));return r;}
typedef float f32x2_t __attribute__((ext_vector_type(2))); typedef float f32x4_t __attribute__((ext_vector_type(4))); typedef __bf16 bf16x2_t __attribute__((ext_vector_type(2)));
__device__ __forceinline__ unsigned cvtpk_s(float lo,float hi){f32x2_t v={lo,hi};bf16x2_t b=__builtin_convertvector(v,bf16x2_t);return __builtin_bit_cast(unsigned,b);}
#define WAIT_BAR(N) asm volatile("s_waitcnt vmcnt(" #N ") lgkmcnt(0)\n\ts_barrier":::"memory")
#define WAIT_BAR2(N,N2) do{ if(DV2){WAIT_BAR(N2);}else{WAIT_BAR(N);} }while(0)

__device__ __forceinline__ void qkt(f32x16&p0,f32x16&p1,const char*Kslot,const bf16x8*qr,int r32,int hi){ const f32x16 negm=f32x16{};
  const char*kb=Kslot+hi*1024+r32*16;
  #pragma unroll
  for(int d0=0;d0<4;++d0){
    const bf16x8 b0=*reinterpret_cast<const bf16x8*>(kb+d0*2048);
    const bf16x8 b1=*reinterpret_cast<const bf16x8*>(kb+d0*2048+512);
    if(d0==0){p0=__builtin_amdgcn_mfma_f32_32x32x16_bf16(b0,qr[0],negm,0,0,0);p1=__builtin_amdgcn_mfma_f32_32x32x16_bf16(b1,qr[0],negm,0,0,0);}
    else{p0=__builtin_amdgcn_mfma_f32_32x32x16_bf16(b0,qr[d0],p0,0,0,0);p1=__builtin_amdgcn_mfma_f32_32x32x16_bf16(b1,qr[d0],p1,0,0,0);}}
}
typedef __attribute__((address_space(3))) const char* lds_cptr;
typedef short v4i16_t __attribute__((ext_vector_type(4)));
__device__ __forceinline__ void kload8(bf16x8*kf,lds_cptr kp){
  kf[0]=*(const __attribute__((address_space(3))) bf16x8*)(kp);      kf[1]=*(const __attribute__((address_space(3))) bf16x8*)(kp+512);
  kf[2]=*(const __attribute__((address_space(3))) bf16x8*)(kp+2048); kf[3]=*(const __attribute__((address_space(3))) bf16x8*)(kp+2560);
  kf[4]=*(const __attribute__((address_space(3))) bf16x8*)(kp+4096); kf[5]=*(const __attribute__((address_space(3))) bf16x8*)(kp+4608);
  kf[6]=*(const __attribute__((address_space(3))) bf16x8*)(kp+6144); kf[7]=*(const __attribute__((address_space(3))) bf16x8*)(kp+6656);
}
__device__ __forceinline__ void kload2(bf16x8*kf,lds_cptr kp,int j){ kf[2*j]=*(const __attribute__((address_space(3))) bf16x8*)(kp+j*2048); kf[2*j+1]=*(const __attribute__((address_space(3))) bf16x8*)(kp+j*2048+512); }
__device__ __forceinline__ s16x4 vtr(lds_cptr p){ return __builtin_bit_cast(s16x4,__builtin_amdgcn_ds_read_tr16_b64_v4i16((__attribute__((address_space(3))) v4i16_t*)p)); }
__device__ __forceinline__ float rowmax(const f32x16&p0,const f32x16&p1){
  float a=max3f(p0[0],p0[1],p1[0]),b=max3f(p0[2],p0[3],p1[1]);a=max3f(a,p1[2],p1[3]);
  #pragma unroll
  for(int r=4;r<16;r+=4){a=max3f(a,p0[r],p0[r+1]);b=max3f(b,p0[r+2],p0[r+3]);a=max3f(a,p1[r],p1[r+1]);b=max3f(b,p1[r+2],p1[r+3]);}
  const float m=max2f(a,b);
  auto rr=__builtin_amdgcn_permlane32_swap(__float_as_uint(m),__float_as_uint(m),false,false);
  return max2f(__uint_as_float(rr[0]),__uint_as_float(rr[1]));
}
__device__ __forceinline__ void pv(f32x16*o,int vb,bf16x8 pa0,bf16x8 pa1,bf16x8 pa2,bf16x8 pa3){
  #pragma unroll
  for(int d0=0;d0<2;++d0){s16x4 lo[4],hi[4];
    #pragma unroll
    for(int ks=0;ks<4;++ks){
      asm volatile("ds_read_b64_tr_b16 %0,%1 offset:%c2":"=&v"(lo[ks]):"v"(vb),"i"(d0*4096+ks*1024):"memory");
      asm volatile("ds_read_b64_tr_b16 %0,%1 offset:%c2":"=&v"(hi[ks]):"v"(vb),"i"(d0*4096+ks*1024+512):"memory");}
    asm volatile("s_waitcnt lgkmcnt(0)":::"memory");SBAR();
    #define PK(k) (bf16x8){lo[k][0],lo[k][1],lo[k][2],lo[k][3],hi[k][0],hi[k][1],hi[k][2],hi[k][3]}
    o[d0]=__builtin_amdgcn_mfma_f32_32x32x16_bf16(pa0,PK(0),o[d0],0,0,0);
    o[d0]=__builtin_amdgcn_mfma_f32_32x32x16_bf16(pa1,PK(1),o[d0],0,0,0);
    o[d0]=__builtin_amdgcn_mfma_f32_32x32x16_bf16(pa2,PK(2),o[d0],0,0,0);
    o[d0]=__builtin_amdgcn_mfma_f32_32x32x16_bf16(pa3,PK(3),o[d0],0,0,0);
    #undef PK
  }
}

#ifndef ATTN_STORE16
#define ATTN_STORE16(p,v) (*(GAS u32x4*)(p)=(v))
#endif
template<int THRL,int MODE,int PO> __device__ __forceinline__ void attn_unit(int b,int qb,const bf16*Q,const bf16*K,const bf16*V,bf16*O,char*shm,const unsigned long long*masks,int tid){
  constexpr bool DV2=(MODE==0);
  asm volatile("":"+v"(tid));
  const int lane=tid&63,r32=lane&31,hi=lane>>5; const int wid=__builtin_amdgcn_readfirstlane(tid>>6);
  const long rowbase=(long)b*SEQ; const int q0=qb*QB;
  const bf16*Qw=Q+(rowbase+q0+wid*QBLK)*DM;
  const bf16*Kh=K+rowbase*DM,*Vh=V+rowbase*DM;
  const unsigned lds0=(unsigned)(uintptr_t)shm;
  float*wsf=(float*)(shm+LDS_WS)+wid*64;
  const bf16*ksrc=Kh+(long)lane*DM+wid*8;
  const bf16*vsrc=Vh+(long)(16*(wid&3)+(lane>>2))*DM+(wid>>2)*32+(lane&3)*8;
  const unsigned kdst=lds0+LDS_K+wid*1024, vdst=lds0+LDS_V+wid*1024;
  #define DMA_K(t,slot) glds16(ksrc+(long)(t)*KVBLK*DM,(unsigned)__builtin_amdgcn_readfirstlane(kdst+(slot)))
  #define DMA_V(t,slot) do{ glds16(vsrc+(long)(t)*KVBLK*DM,(unsigned)__builtin_amdgcn_readfirstlane(vdst+2*(slot))); \
    if(DV2) glds16(vsrc+64+(long)(t)*KVBLK*DM,(unsigned)__builtin_amdgcn_readfirstlane(vdst+2*(slot)+8192)); }while(0)
  const int vb0=(int)(lds0+LDS_V)+((lane>>4)&1)*32+(lane&3)*8+(4*hi+((lane&15)>>2))*64;
  const char*Kbase=shm+LDS_K; bf16x8 kf[8];
  const lds_cptr shm3=(lds_cptr)shm; const lds_cptr shm3c=shm3; const lds_cptr kp0=shm3+LDS_K+hi*1024+r32*16; const lds_cptr vp0=shm3+LDS_V+((lane>>4)&1)*32+(lane&3)*8+(4*hi+((lane&15)>>2))*64;
  const int NT=(q0+QB)/KVBLK;
  DMA_K(0,0);DMA_V(0,0);DMA_K(1,SLOTB);
  bf16x8 qr[4];
  #pragma unroll
  for(int d0=0;d0<4;++d0)qr[d0]=*(const GAS bf16x8*)(&Qw[(long)r32*DM+d0*16+hi*8]);
  constexpr bool NEGM=(MODE==2);
  float mhat=0.f,l_reg=0.f;f32x16 o[2];o[0]=f32x16{};o[1]=f32x16{};f32x16 o2[2];o2[0]=f32x16{};o2[1]=f32x16{};f32x16 ZERO16=f32x16{}; if(NEGM){asm volatile("":"+v"(ZERO16));}
  const int qrel=wid*QBLK+r32;
  #define CMASK(P0,P1,t) do{ if(MODE!=2){ int jb_=(t)-(NT-4); if(jb_>=0){ if(MODE==0)chunkmask(P0,P1,jb_,wid); else cmask(P0,P1,jb_,qrel,hi);} } }while(0)
  const __attribute__((address_space(3))) float*ctab=(const __attribute__((address_space(3))) float*)(shm3c+LDS_CBT)+4*hi;
  const unsigned long long*mwave=masks+((size_t)(b*(SEQ/32)+(q0>>5)+wid)*(SEQ/64))*32;
  const float NEGINF=-INFINITY;
  #define CND(x,m) asm volatile("v_cndmask_b32_e64 %0, %2, %0, %1":"+v"(x):"s"(m),"v"(NEGINF))
  #define HOOK(P0,P1,t) do{ \
    if(MODE==1){ _Pragma("unroll") for(int g_=0;g_<4;++g_){ const f32x4_t b0_=*(const __attribute__((address_space(3))) f32x4_t*)(ctab+64*(t)+8*g_), b1_=*(const __attribute__((address_space(3))) f32x4_t*)(ctab+64*(t)+8*g_+32); \
        _Pragma("unroll") for(int i_=0;i_<4;i_+=2){ f32x2_t a_={P0[4*g_+i_],P0[4*g_+i_+1]}, c_={P1[4*g_+i_],P1[4*g_+i_+1]}; const f32x2_t x_={b0_[i_],b0_[i_+1]}, y_={b1_[i_],b1_[i_+1]}; a_=a_-x_; c_=c_-y_; \
          P0[4*g_+i_]=a_[0];P0[4*g_+i_+1]=a_[1];P1[4*g_+i_]=c_[0];P1[4*g_+i_+1]=c_[1]; } asm volatile("":::"memory"); } } \
    if(MODE==2){ asm volatile("s_waitcnt lgkmcnt(0)":::"memory"); \
      _Pragma("unroll") for(int r_=0;r_<8;++r_){ CND(P0[r_],mk0_[r_]); CND(P0[8+r_],mk1_[r_]); CND(P1[r_],mk2_[r_]); CND(P1[8+r_],mk3_[r_]); } } }while(0)
  u64x8 mk0_,mk1_,mk2_,mk3_;
  #define HOOK_ISSUE(t) do{ if(MODE==2){ const unsigned long long*mp_=mwave+(size_t)(t)*32; \
      const unsigned lo_=__builtin_amdgcn_readfirstlane((unsigned)(uintptr_t)mp_), hi_=__builtin_amdgcn_readfirstlane((unsigned)((uintptr_t)mp_>>32)); \
      const unsigned long long ma_=((unsigned long long)hi_<<32)|lo_; \
      asm volatile("s_load_dwordx16 %0, %4, 0x0\n\ts_load_dwordx16 %1, %4, 0x40\n\ts_load_dwordx16 %2, %4, 0x80\n\ts_load_dwordx16 %3, %4, 0xc0":"=&s"(mk0_),"=&s"(mk1_),"=&s"(mk2_),"=&s"(mk3_):"s"(ma_):"memory"); } }while(0)
  bool resc=false;
  #define START(P0,P1) do{ const float rm=rowmax(P0,P1); resc=false; \
    { const float dl=__builtin_fmaxf(rm,-256.f); mhat=fadd_s(mhat,dl); \
      _Pragma("unroll") for(int r=0;r<16;++r){P0[r]=fsub_s(P0[r],dl);P1[r]=fsub_s(P1[r],dl);} \
      if(NEGM){ _Pragma("unroll") for(int r=0;r<16;++r)ZERO16[r]=-mhat; asm volatile("":"+v"(ZERO16)); } } \
    _Pragma("unroll") for(int r=0;r<16;++r)P0[r]=__builtin_amdgcn_exp2f(P0[r]); }while(0)
  #define RESC() do{ if(resc){ asm volatile("s_waitcnt lgkmcnt(0)":::"memory"); \
      _Pragma("unroll") for(int d_=0;d_<2;++d_) _Pragma("unroll") for(int r=0;r<16;++r){ const float f_=wsf[crow(r,hi)]; o[d_][r]*=f_; if(DV2)o2[d_][r]*=f_; } } }while(0)
  f32x16 pA0,pA1,pB0,pB1;
  int sl_prev=0,sl_cur=0,sl_next=SLOTB;
  #define ROT() do{sl_prev=sl_cur;sl_cur=sl_next;sl_next=(sl_next==(NSLOT-1)*SLOTB)?0:sl_next+SLOTB;}while(0)
  DMA_K(2,2*SLOTB);
  WAIT_BAR2(3,4);
  HOOK_ISSUE(0); qkt(pA0,pA1,Kbase,qr,r32,hi);asm volatile("s_nop 15\n\ts_nop 7":"+v"(pA0),"+v"(pA1));HOOK(pA0,pA1,0);CMASK(pA0,pA1,0);
  START(pA0,pA1);
  _Pragma("unroll") for(int r=0;r<16;++r)pA1[r]=__builtin_amdgcn_exp2f(pA1[r]);
  WAIT_BAR(0);
  DMA_K(3,0);DMA_V(1,SLOTB);
  ROT();
  kload8(kf,kp0+sl_cur);
  WAIT_BAR2(2,3);
  s16x4 vlo[8],vhi[8]; u32x4 pw0,pw1,pw2,pw3;
  #define PKW(P,B) cvtpk_s(P[B],P[B+1])
  #define PAF(k) __builtin_bit_cast(bf16x8,pw##k)
  #define VFR(i) (bf16x8){vlo[i][0],vlo[i][1],vlo[i][2],vlo[i][3],vhi[i][0],vhi[i][1],vhi[i][2],vhi[i][3]}
  #define PIN(x) asm volatile("":"+v"(x))
  #define MX3(a,b,c) __builtin_fmaxf(__builtin_fmaxf((a),(b)),(c))
  #define GAPA(MF,A0,A1,A2,A3,W0,W1,PW) do{ MF; sacc+=A0; sacc+=A1; sacc+=A2; sacc+=A3; PIN(sacc); W0; W1; PIN(PW); SBAR(); }while(0)
  #define EX(v) __builtin_amdgcn_exp2f(v)
  #define GAPB(MF,X,B) do{ MF; X[B]=EX(X[B]); X[B+1]=EX(X[B+1]); X[B+2]=EX(X[B+2]); X[B+3]=EX(X[B+3]); PIN(X); SBAR(); }while(0)
  #define VRD(i) do{ vlo[i]=vtr(vp_+(((i)>>2)*4096+((i)&3)*1024)); vhi[i]=vtr(vp_+(((i)>>2)*4096+((i)&3)*1024+512)); }while(0)
  #define VRD2(i) do{ vlo[i]=vtr(vp_+8192+(((i)>>2)*4096+((i)&3)*1024)); vhi[i]=vtr(vp_+8192+(((i)>>2)*4096+((i)&3)*1024+512)); }while(0)
  #define KRD(G,j) do{ if(G){ kload2(kf,kp0+sl_next,j); SBAR(); } }while(0)
  #define STEP(C0,C1,P0,P1,t,GK,GV,GL) do{ SBAR(); HOOK_ISSUE(t); \
    const lds_cptr vp_=vp0+2*sl_prev; \
    VRD(0); SBAR(); float sacc=(P0[0]+P0[1]); \
    GAPA(C0=__builtin_amdgcn_mfma_f32_32x32x16_bf16(kf[0],qr[0],ZERO16,0,0,0), P0[2],P0[3],P0[4],P0[5],     pw0[0]=PKW(P0,0), pw0[1]=PKW(P0,2), pw0); \
    VRD(4); SBAR(); GAPA(C1=__builtin_amdgcn_mfma_f32_32x32x16_bf16(kf[1],qr[0],ZERO16,0,0,0), P0[6],P0[7],P0[8],P0[9],     pw0[2]=PKW(P0,4), pw0[3]=PKW(P0,6), pw0); \
    VRD(1); SBAR(); GAPA(C0=__builtin_amdgcn_mfma_f32_32x32x16_bf16(kf[2],qr[1],C0,0,0,0),   P0[10],P0[11],P0[12],P0[13], pw1[0]=PKW(P0,8), pw1[1]=PKW(P0,10), pw1); \
    VRD(5); SBAR(); GAPA(C1=__builtin_amdgcn_mfma_f32_32x32x16_bf16(kf[3],qr[1],C1,0,0,0),   P0[14],P0[15],P1[0],P1[1],   pw1[2]=PKW(P0,12),pw1[3]=PKW(P0,14), pw1); \
    VRD(2); SBAR(); GAPA(C0=__builtin_amdgcn_mfma_f32_32x32x16_bf16(kf[4],qr[2],C0,0,0,0),   P1[2],P1[3],P1[4],P1[5],     pw2[0]=PKW(P1,0), pw2[1]=PKW(P1,2), pw2); \
    VRD(6); SBAR(); GAPA(C1=__builtin_amdgcn_mfma_f32_32x32x16_bf16(kf[5],qr[2],C1,0,0,0),   P1[6],P1[7],P1[8],P1[9],     pw2[2]=PKW(P1,4), pw2[3]=PKW(P1,6), pw2); \
    VRD(3); SBAR(); GAPA(C0=__builtin_amdgcn_mfma_f32_32x32x16_bf16(kf[6],qr[3],C0,0,0,0),   P1[10],P1[11],P1[12],P1[13], pw3[0]=PKW(P1,8), pw3[1]=PKW(P1,10), pw3); \
    VRD(7); SBAR(); GAPA(C1=__builtin_amdgcn_mfma_f32_32x32x16_bf16(kf[7],qr[3],C1,0,0,0),   P1[14],P1[15],0.f,0.f,       pw3[2]=PKW(P1,12),pw3[3]=PKW(P1,14), pw3); \
    l_reg+=sacc; \
    if(GK){DMA_K((t)+3,sl_cur);} if(GV){DMA_V((t)+1,sl_next);} \
    if(!NEGM){ const f32x2_t mh2_={mhat,mhat}; _Pragma("unroll") for(int r=0;r<16;r+=2){ f32x2_t a_={C0[r],C0[r+1]}, b_={C1[r],C1[r+1]}; a_=a_-mh2_; b_=b_-mh2_; C0[r]=a_[0];C0[r+1]=a_[1];C1[r]=b_[0];C1[r+1]=b_[1]; } } \
    if(NEGM&&MODE==2){ asm volatile("s_nop 15\n\ts_nop 7":"+v"(C0),"+v"(C1)); }     \
    HOOK(C0,C1,t); CMASK(C0,C1,t); \
    { float a=MX3(C0[0],C0[1],C1[0]),b=MX3(C0[2],C0[3],C1[1]); a=MX3(a,C1[2],C1[3]); \
      _Pragma("unroll") for(int r=4;r<16;r+=4){a=MX3(a,C0[r],C0[r+1]);b=MX3(b,C0[r+2],C0[r+3]);a=MX3(a,C1[r],C1[r+1]);b=MX3(b,C1[r+2],C1[r+3]);} \
      float rm=__builtin_fmaxf(a,b); { auto rr=__builtin_amdgcn_permlane32_swap(__float_as_uint(rm),__float_as_uint(rm),false,false); rm=__builtin_fmaxf(__uint_as_float(rr[0]),__uint_as_float(rr[1])); } \
      resc=false; \
      if(__builtin_expect(__any(rm>(float)THRL),0)){ const float dl=__builtin_fmaxf(rm,0.f); mhat+=dl; \
        _Pragma("unroll") for(int r=0;r<16;++r){C0[r]-=dl;C1[r]-=dl;} \
        if(NEGM){ _Pragma("unroll") for(int r=0;r<16;++r)ZERO16[r]=-mhat; asm volatile("":"+v"(ZERO16)); } \
        const float f=__builtin_amdgcn_exp2f(-dl); l_reg*=f; if(hi==0)wsf[r32]=f; resc=true; } } \
    SBAR(); \
    GAPB(o[0]=__builtin_amdgcn_mfma_f32_32x32x16_bf16(PAF(0),VFR(0),o[0],0,0,0), C0,0); \
    GAPB(o[1]=__builtin_amdgcn_mfma_f32_32x32x16_bf16(PAF(0),VFR(4),o[1],0,0,0), C0,4); \
    KRD(GL,0); GAPB(o[0]=__builtin_amdgcn_mfma_f32_32x32x16_bf16(PAF(1),VFR(1),o[0],0,0,0), C0,8); \
    KRD(GL,1); GAPB(o[1]=__builtin_amdgcn_mfma_f32_32x32x16_bf16(PAF(1),VFR(5),o[1],0,0,0), C0,12); \
    KRD(GL,2); GAPB(o[0]=__builtin_amdgcn_mfma_f32_32x32x16_bf16(PAF(2),VFR(2),o[0],0,0,0), C1,0); \
    KRD(GL,3); GAPB(o[1]=__builtin_amdgcn_mfma_f32_32x32x16_bf16(PAF(2),VFR(6),o[1],0,0,0), C1,4); \
    GAPB(o[0]=__builtin_amdgcn_mfma_f32_32x32x16_bf16(PAF(3),VFR(3),o[0],0,0,0), C1,8); \
    GAPB(o[1]=__builtin_amdgcn_mfma_f32_32x32x16_bf16(PAF(3),VFR(7),o[1],0,0,0), C1,12); \
    if(DV2){   \
      VRD2(0);VRD2(4);VRD2(1);VRD2(5);VRD2(2);VRD2(6);VRD2(3);VRD2(7); SBAR(); \
      o2[0]=__builtin_amdgcn_mfma_f32_32x32x16_bf16(PAF(0),VFR(0),o2[0],0,0,0); o2[1]=__builtin_amdgcn_mfma_f32_32x32x16_bf16(PAF(0),VFR(4),o2[1],0,0,0); \
      o2[0]=__builtin_amdgcn_mfma_f32_32x32x16_bf16(PAF(1),VFR(1),o2[0],0,0,0); o2[1]=__builtin_amdgcn_mfma_f32_32x32x16_bf16(PAF(1),VFR(5),o2[1],0,0,0); \
      o2[0]=__builtin_amdgcn_mfma_f32_32x32x16_bf16(PAF(2),VFR(2),o2[0],0,0,0); o2[1]=__builtin_amdgcn_mfma_f32_32x32x16_bf16(PAF(2),VFR(6),o2[1],0,0,0); \
      o2[0]=__builtin_amdgcn_mfma_f32_32x32x16_bf16(PAF(3),VFR(3),o2[0],0,0,0); o2[1]=__builtin_amdgcn_mfma_f32_32x32x16_bf16(PAF(3),VFR(7),o2[1],0,0,0); SBAR(); } \
    }while(0)
  int t=1;
  #undef CMASK
  #define CMASK(P0,P1,t) do{}while(0)
  for(;t+5<NT;t+=2){
    STEP(pB0,pB1,pA0,pA1,t,true,true,true);     WAIT_BAR2(2,3); RESC(); ROT();
    STEP(pA0,pA1,pB0,pB1,t+1,true,true,true);   WAIT_BAR2(2,3); RESC(); ROT();
  }
  #undef CMASK
  #define CMASK(P0,P1,t) do{ if(MODE!=2){ int jb_=(t)-(NT-4); if(jb_>=0){ if(MODE==0)chunkmask(P0,P1,jb_,wid); else cmask(P0,P1,jb_,qrel,hi);} } }while(0)
  #define ENDW(tt) do{ if((tt)+3<NT){WAIT_BAR2(2,3);} else if((tt)+2<NT){WAIT_BAR2(1,2);} else {WAIT_BAR(0);} }while(0)
  for(;t+1<NT;t+=2){
    STEP(pB0,pB1,pA0,pA1,t,(t+3<NT),(t+1<NT),(t+1<NT));       ENDW(t);   RESC(); ROT();
    STEP(pA0,pA1,pB0,pB1,t+1,(t+4<NT),(t+2<NT),(t+2<NT));     ENDW(t+1); RESC(); ROT();
  }
  STEP(pB0,pB1,pA0,pA1,NT-1,false,false,false); RESC();
  { float sacc=pB0[0]+pB0[1]; _Pragma("unroll") for(int r=2;r<16;++r)sacc+=pB0[r]; _Pragma("unroll") for(int r=0;r<16;++r)sacc+=pB1[r]; l_reg+=sacc;
    pw0=(u32x4){PKW(pB0,0),PKW(pB0,2),PKW(pB0,4),PKW(pB0,6)};pw1=(u32x4){PKW(pB0,8),PKW(pB0,10),PKW(pB0,12),PKW(pB0,14)};pw2=(u32x4){PKW(pB1,0),PKW(pB1,2),PKW(pB1,4),PKW(pB1,6)};pw3=(u32x4){PKW(pB1,8),PKW(pB1,10),PKW(pB1,12),PKW(pB1,14)};
    SBAR(); pv(o,vb0+2*sl_cur,PAF(0),PAF(1),PAF(2),PAF(3)); if(DV2){ SBAR(); pv(o2,vb0+2*sl_cur+8192,PAF(0),PAF(1),PAF(2),PAF(3)); } }
  #undef PKW
  #undef PAF
  #undef VFR
  #undef PIN
  #undef MX3
  #undef GAPA
  #undef GAPB
  #undef EX
  #undef VRD
  #undef VRD2
  #undef KRD
  #undef STEP
  #undef ENDW
  {auto rr=__builtin_amdgcn_permlane32_swap(__float_as_uint(l_reg),__float_as_uint(l_reg),false,false);l_reg=__uint_as_float(rr[0])+__uint_as_float(rr[1]);}
  if(hi==0)wsf[32+r32]=l_reg;asm volatile("s_waitcnt lgkmcnt(0)":::"memory");
  float rli[16];
  #pragma unroll
  for(int r=0;r<16;++r)rli[r]=__builtin_amdgcn_rcpf(wsf[32+crow(r,hi)]);
  bf16*Ow=O+(rowbase+q0+wid*QBLK)*PO;
  { bf16*stg=(bf16*)(shm+LDS_OST)+wid*2048;
    #pragma unroll
    for(int r=0;r<16;++r){const int orow=crow(r,hi);
      #pragma unroll
      for(int d0=0;d0<2;++d0)stg[orow*64+d0*32+r32]=__float2bfloat16(o[d0][r]*rli[r]);}
    asm volatile("s_waitcnt lgkmcnt(0)":::"memory");
    #pragma unroll
    for(int i=0;i<4;++i){const int row=i*8+(lane>>3),ch=lane&7; const u32x4 v=*(const u32x4*)(stg+row*64+ch*8); ATTN_STORE16(Ow+(long)row*PO+ch*8,v);}
    if(DV2){ asm volatile("s_waitcnt lgkmcnt(0)":::"memory");
      #pragma unroll
      for(int r=0;r<16;++r){const int orow=crow(r,hi);
        #pragma unroll
        for(int d0=0;d0<2;++d0)stg[orow*64+d0*32+r32]=__float2bfloat16(o2[d0][r]*rli[r]);}
      asm volatile("s_waitcnt lgkmcnt(0)":::"memory");
      #pragma unroll
      for(int i=0;i<4;++i){const int row=i*8+(lane>>3),ch=lane&7; const u32x4 v=*(const u32x4*)(stg+row*64+ch*8); ATTN_STORE16(Ow+(long)row*PO+64+ch*8,v);} } }
  asm volatile("s_waitcnt lgkmcnt(0)\n\ts_barrier":::"memory");
  #undef DMA_K
  #undef DMA_V
  #undef CMASK
  #undef HOOK
  #undef HOOK_ISSUE
  #undef CND
  #undef START
  #undef RESC
  #undef ROT
}
constexpr int ATTN_LDS_BYTES=LDS_BYTES;
static_assert(LDS_BYTES <= 131072, "attention scratch fits the 128 KiB phase region");
#undef SBAR
#undef WAIT_BAR
}

__device__ __forceinline__ void attention_phase(Frame& F, char* lds_g, int amask, int l) {
    using namespace attn_body;
    typedef attn_body::bf16 abf;
    const int v = F.vcu, b = v >> 5, j = v & 31;
    unsigned char* ws = F.ws;
#ifndef AMODES
#define AMODES 7
#endif
    if ((AMODES & 1) && (amask & 1)) {
        const int hm = j >> 2, p0 = 2 * (j & 3);
        const abf* Q = (const abf*)(ws + WS_Z) + hm * 64; const abf* K = (const abf*)(ws + WS_Z + ZG) + hm * 64; const abf* V = (const abf*)(ws + WS_Z + 2 * ZG) + (hm >> 1) * 128;
        abf* O = (abf*)(ws + WS_OD) + hm * 128;
        for (int i = 0; i < 4; ++i) { const int p = p0 + (i >> 1), qb = (i & 1) ? p : 15 - p; attn_unit<16, 0, 1024>(b, qb, Q, K, V, O, lds_g, nullptr, F.tid); }
    }
    if ((AMODES & 2) && (amask & 2)) {
        const int h = j >> 2, p0 = 2 * (j & 3);
        const abf* Q = (const abf*)(ws + WS_Z + 3 * ZG) + h * 64; const abf* K = (const abf*)(ws + WS_Z + 4 * ZG) + h * 64; const abf* V = (const abf*)(ws + WS_Z + 5 * ZG) + h * 64;
        abf* O = (abf*)(ws + WS_OS) + h * 64;
        for (int i = 0; i < 4; ++i) { const int p = p0 + (i >> 1), qb = (i & 1) ? p : 15 - p; attn_unit<16, 2, 512>(b, qb, Q, K, V, O, lds_g, (const unsigned long long*)(ws + (l == 0 ? WS_MASK : WS_MASK1)), F.tid); }
    }
    if ((AMODES & 4) && (amask & 4)) {
        const int h = j >> 2, p0 = 2 * (j & 3);
        { LAS float* ct = (LAS float*)(F.lds + RING_OFF + LDS_CBT); const float* cb = (const float*)(ws + WS_CB) + (size_t)(b * 8 + h) * S;
          for (int i = F.tid; i < S; i += NWAVES * 64) ct[i] = ((const GAS float*)cb)[i];
          __syncthreads(); }
        const abf* Q = (const abf*)(ws + WS_Z + 6 * ZG) + h * 64; const abf* K = (const abf*)(ws + WS_Z + 7 * ZG) + h * 64; const abf* V = (const abf*)(ws + WS_Z + 8 * ZG) + h * 64;
        abf* O = (abf*)(ws + WS_OF) + h * 64;
        for (int i = 0; i < 4; ++i) { const int p = p0 + (i >> 1), qb = (i & 1) ? p : 15 - p; attn_unit<24, 1, 512>(b, qb, Q, K, V, O, lds_g, nullptr, F.tid);   }
    }
}
namespace dsa_sel {
typedef float f32x16 __attribute__((ext_vector_type(16)));
constexpr int HP = 257, CAP = 32;
constexpr int L_HIST = 0, L_PREFIX = 64 * HP * 4, L_KK = L_PREFIX + 256, L_TAU = L_KK + 256, L_NEED = L_TAU + 256, L_TSEL = L_NEED + 256, L_IDXT = L_TSEL + 256, L_FLAG = L_IDXT + 256, L_QF = L_FLAG + 256, L_LCNT = L_QF + 32768, L_LIST = L_LCNT + 256;
__device__ __forceinline__ unsigned f2key(float f) { const unsigned u = __float_as_uint(f); return u ^ ((unsigned)((int)u >> 31) | 0x80000000u); }
__device__ __forceinline__ float relu1(float x) { const int b = __builtin_bit_cast(int, x); return __builtin_bit_cast(float, b > 0 ? b : 0); }
__device__ __forceinline__ int crow(int r, int hi) { return (r & 3) + 8 * (r >> 2) + 4 * hi; }

template <int PM>
__device__ __forceinline__ void sweep(const unsigned short* ikb  , const LAS bf16x8* qfl0  , const f32x4& iw, int ntile, int kq, int lane, int ql  , int qg, int rot_seed,
                                      LAS unsigned* lds32, int shift, unsigned long long* mout  , unsigned inc = 1u) {
    asm volatile("" : "+v"(lane), "+v"(ql));
    const int i32 = lane & 31, hi = lane >> 5;
    const LAS bf16x8* qfl = qfl0 + qg * 1024 + lane;
    LAS unsigned* hist = lds32 + (L_HIST / 4) + ql * HP;
    unsigned prefix = 0, tau = 0, need = 0, tsel = 0, idxt = 0;
    if (PM == 0) prefix = lds32[L_PREFIX / 4 + ql];
    const unsigned pbase = prefix << 8;
    if (PM >= 1 && PM != 4) tau = lds32[L_TAU / 4 + ql];
    if (PM == 4) tau = lds32[L_PREFIX / 4 + ql];
    if (PM == 2) tsel = lds32[L_TSEL / 4 + ql];
    if (PM == 3) idxt = lds32[L_IDXT / 4 + ql];
    (void)need;
    bf16x8 bufA[4], bufB[4];
    const int cnt = (ntile - kq + 3) >> 2;
    const int rot = cnt > 0 ? (int)(((unsigned)rot_seed * 5u) % (unsigned)cnt) : 0;
    if (cnt > 0) {
        const int t0 = kq + 4 * rot;
#pragma unroll
        for (int ds = 0; ds < 4; ++ds) { bufA[ds] = *(const GAS bf16x8*)(ikb + (size_t)t0 * 4096 + (size_t)((ds * 64 + lane) * 8));
                                         bufB[ds] = *(const GAS bf16x8*)(ikb + (size_t)t0 * 4096 + (size_t)(((4 + ds) * 64 + lane) * 8)); }
    }
    for (int k = 0; k < cnt; ++k) {
        int kr = k + rot; if (kr >= cnt) kr -= cnt;
        int kr1 = kr + 1; if (kr1 >= cnt) kr1 -= cnt;
        const int t = kq + 4 * kr, tnext = kq + 4 * kr1; const bool has_next = (k + 1 < cnt);
        unsigned long long mine = 0ull;
#pragma unroll
        for (int kh = 0; kh < 2; ++kh) {
            f32x16 sc;
#pragma unroll
            for (int hp = 0; hp < 2; ++hp) {
                f32x16 a0 = {}, a1 = {};
#pragma unroll
                for (int ds = 0; ds < 4; ++ds) {
                    const bf16x8 kfr = kh == 0 ? bufA[ds] : bufB[ds];
                    a0 = __builtin_amdgcn_mfma_f32_32x32x16_bf16(kfr, qfl[((2 * hp) * 4 + ds) * 64], a0, 0, 0, 0);
                    a1 = __builtin_amdgcn_mfma_f32_32x32x16_bf16(kfr, qfl[((2 * hp + 1) * 4 + ds) * 64], a1, 0, 0, 0);
                }
                if (hp == 1) {
#pragma unroll
                    for (int ds = 0; ds < 4; ++ds) { const bf16x8 nv = *(const GAS bf16x8*)(ikb + (size_t)tnext * 4096 + (size_t)(((kh * 4 + ds) * 64 + lane) * 8)); if (kh == 0) bufA[ds] = nv; else bufB[ds] = nv; }
                    __builtin_amdgcn_sched_barrier(0);
                }
                const float w0 = iw[2 * hp], w1 = iw[2 * hp + 1];
                if (hp == 0) {
#pragma unroll
                    for (int r = 0; r < 16; ++r) sc[r] = fmaf(w1, relu1(a1[r]), fmaf(w0, relu1(a0[r]), 0.0f));
                } else {
#pragma unroll
                    for (int r = 0; r < 16; ++r) sc[r] = fmaf(w1, relu1(a1[r]), fmaf(w0, relu1(a0[r]), sc[r]));
                }
            }
            const unsigned tz = (unsigned)(64 * t + 32 * kh + 4 * hi) << 11;
#pragma unroll
            for (int r = 0; r < 16; ++r) {
                unsigned key = f2key(sc[r]);
                key = (key == 0x80000000u) ? (0x80000000u | ((4095u - (unsigned)((r & 3) + 8 * (r >> 2))) << 11)) - tz : key;
                if (PM == 0) {
                    const unsigned dg = (key >> shift) - pbase;
                    __hip_atomic_fetch_add(hist + (dg < 256u ? dg : 256u), inc, __ATOMIC_RELAXED, __HIP_MEMORY_SCOPE_WORKGROUP);
                } else if (PM == 1) {
                    __hip_atomic_fetch_add(hist + (key == tau ? (unsigned)t : 256u), 1u, __ATOMIC_RELAXED, __HIP_MEMORY_SCOPE_WORKGROUP);
                } else if (PM == 2) {
                    __hip_atomic_fetch_add(hist + ((key == tau && (unsigned)t == tsel) ? (unsigned)(32 * kh + crow(r, hi)) : 256u), 1u, __ATOMIC_RELAXED, __HIP_MEMORY_SCOPE_WORKGROUP);
                } else if (PM == 3) {
                    const unsigned idx = (unsigned)(64 * t + 32 * kh + crow(r, hi));
                    const bool sel = key > tau || (key == tau && idx <= idxt);
                    const unsigned long long bal = __ballot(sel);
                    if (lane == kh * 16 + r) mine = bal;
                } else {
                    const unsigned top = key >> 16;
                    const unsigned long long bal = __ballot(top > tau);
                    if (lane == kh * 16 + r) mine = bal;
                    if (top == tau) {
                        const unsigned slot = __hip_atomic_fetch_add(lds32 + L_LCNT / 4 + ql, 1u, __ATOMIC_RELAXED, __HIP_MEMORY_SCOPE_WORKGROUP);
                        if (slot < (unsigned)CAP) { lds32[L_LIST / 4 + (ql * CAP + slot) * 2] = key; lds32[L_LIST / 4 + (ql * CAP + slot) * 2 + 1] = (unsigned)(64 * t + 32 * kh + crow(r, hi)); }
                    }
                }
            }
        }
        if (PM >= 3) { if (lane < 32) mout[(size_t)t * 32 + lane] = mine; }
    }
}

__device__ __forceinline__ void select_phase(Frame& F, int l) {
    const int tid = F.tid, lane = F.lane, wid = F.wave;
    const int v = F.vcu, b = v >> 5, s = v & 31;
    const int qg = wid & 1, kq = wid >> 1;
    const int rot_seed = (v & 31) + 1;
    LAS unsigned* lds32 = (LAS unsigned*)(F.lds + RING_OFF);
    unsigned char* ws = F.ws;
    const unsigned short* ikb = (const unsigned short*)(ws + WS_IK) + (size_t)b * S * 64;
    unsigned long long* masks = (unsigned long long*)(ws + (l == 0 ? WS_MASK : WS_MASK1));
    for (int uu = 0; uu < 2; ++uu) {
        const int c = uu == 0 ? 63 - s : s;
        const int ntile = c + 1, q0 = c * 64;
        const int ql = 32 * qg + (lane & 31);
        const size_t qrow = (size_t)b * S + q0 + ql;
        unsigned long long* mout = masks + ((size_t)(b * 128 + (q0 >> 5) + qg) * 64) * 32;
        const int tend = 4 * (c >> 2) + 4;
        for (int t = ntile + kq; t < tend; t += 4) { if (lane < 32) mout[(size_t)t * 32 + lane] = 0ull; }
        if (ntile <= 4) {
            for (int t = kq; t < ntile; t += 4) { if (lane < 32) mout[(size_t)t * 32 + lane] = ~0ull; }
            continue;
        }
        f32x4 iw;
        LAS bf16x8* qfl0 = (LAS bf16x8*)((LAS unsigned char*)lds32 + L_QF);
        LAS bf16x8* qfl = qfl0 + qg * 1024 + lane;
        {
            const unsigned short* iq = (const unsigned short*)(ws + WS_IQ) + qrow * 256;
            __syncthreads();
            if (kq == 0) {
                bf16x8 qt[16];
#pragma unroll
                for (int f = 0; f < 16; ++f) qt[f] = *(const GAS bf16x8*)(iq + (f >> 2) * 64 + 16 * (f & 3) + 8 * (lane >> 5));
                asm volatile("s_waitcnt vmcnt(0)" ::: "memory");
#pragma unroll
                for (int f = 0; f < 16; ++f) qfl[f * 64] = qt[f];
            }
            iw = *(const GAS f32x4*)((const float*)(ws + WS_IW) + qrow * 4);
        }
        if (tid < 64) { lds32[L_PREFIX / 4 + tid] = 0u; lds32[L_KK / 4 + tid] = 256u; }
        if (tid == 0) { lds32[L_FLAG / 4] = 0u; lds32[L_FLAG / 4 + 1] = 0u; }
        if (tid < 64) lds32[L_LCNT / 4 + tid] = 0u;
        bool fast = false;
        for (int pass = 0; pass < 4; ++pass) {
            if (pass == 2) {
#ifdef PROBE_FORCE_FAST
                fast = true;
#else
                fast = lds32[L_FLAG / 4 + 1] == 0u;
#endif
#ifdef PROBE_COUNT
                if (tid == 0 && c >= 32) __hip_atomic_fetch_add((unsigned*)(ws + WS_CTL) + 66 + (fast ? 0 : 1), 1u, RLX_AGENT);
#endif
                if (fast) break;
            }
            for (int i = tid; i < 64 * HP; i += NWAVES * 64) lds32[L_HIST / 4 + i] = 0u;
            __syncthreads();
            sweep<0>(ikb, qfl0, iw, ntile, kq, lane, ql, qg, rot_seed, lds32, 24 - 8 * pass, nullptr);
#ifdef PROBE_SWEEP2
            sweep<0>(ikb, qfl0, iw, ntile, kq, lane, ql, qg, rot_seed, lds32, 24 - 8 * pass, nullptr, (unsigned)pass >> 4);
#endif
            __syncthreads();
            for (int qq = 0; qq < 8; ++qq) {
                const int qi = wid * 8 + qq;
                LAS unsigned* hq = lds32 + (L_HIST / 4) + qi * HP;
                const unsigned kk = lds32[L_KK / 4 + qi];
                const unsigned h0 = hq[4 * lane], h1 = hq[4 * lane + 1], h2 = hq[4 * lane + 2], h3 = hq[4 * lane + 3];
                const unsigned own = h0 + h1 + h2 + h3;
                unsigned suf = own;
#pragma unroll
                for (int o = 1; o < 64; o <<= 1) { const unsigned n = __shfl_down(suf, o); if (lane + o < 64) suf += n; }
                const unsigned above = suf - own;
                const bool here = above < kk && suf >= kk;
                if (here) {
                    unsigned cum = above; int d = 4 * lane + 3; unsigned hv = h3;
                    if (cum + hv < kk) { cum += hv; d = 4 * lane + 2; hv = h2; if (cum + hv < kk) { cum += hv; d = 4 * lane + 1; hv = h1; if (cum + hv < kk) { cum += hv; d = 4 * lane; hv = h0; } } }
                    const unsigned np = (lds32[L_PREFIX / 4 + qi] << 8) | (unsigned)d, nk = kk - cum;
                    lds32[L_PREFIX / 4 + qi] = np; lds32[L_KK / 4 + qi] = nk;
                    if (pass == 1 && hv > (unsigned)CAP) __hip_atomic_fetch_or(lds32 + L_FLAG / 4 + 1, 1u, __ATOMIC_RELAXED, __HIP_MEMORY_SCOPE_WORKGROUP);
                    if (pass == 3) { lds32[L_TAU / 4 + qi] = np; lds32[L_NEED / 4 + qi] = nk; lds32[L_IDXT / 4 + qi] = 0xffffu;
                        if (hv != nk) __hip_atomic_fetch_or(lds32 + L_FLAG / 4, 1u, __ATOMIC_RELAXED, __HIP_MEMORY_SCOPE_WORKGROUP); }
                }
            }
            __syncthreads();
        }
        if (fast) {
            sweep<4>(ikb, qfl0, iw, ntile, kq, lane, ql, qg, rot_seed, lds32, 0, mout);
            asm volatile("s_waitcnt vmcnt(0)" ::: "memory");
            __syncthreads();
            unsigned* m32 = (unsigned*)(masks + ((size_t)(b * 128 + (q0 >> 5)) * 64) * 32);
            for (int i = tid; i < 64 * CAP; i += NWAVES * 64) {
                const int qi = i / CAP, ci = i - qi * CAP; const unsigned n = lds32[L_LCNT / 4 + qi];
                if ((unsigned)ci < n) {
                    const LAS unsigned* lst = lds32 + L_LIST / 4 + qi * CAP * 2;
                    const unsigned key = lst[ci * 2], idx = lst[ci * 2 + 1]; unsigned rank = 0;
                    for (unsigned jj = 0; jj < n; ++jj) { const unsigned kj = lst[jj * 2], ij = lst[jj * 2 + 1]; rank += (kj > key || (kj == key && ij < idx)) ? 1u : 0u; }
                    if (rank < lds32[L_KK / 4 + qi]) {
                        const unsigned tl = idx >> 6, ps = idx & 63u, kh = ps >> 5, p5 = ps & 31u, hi = (p5 >> 2) & 1u, r = (p5 & 3u) + 4u * (p5 >> 3);
                        unsigned* w = m32 + ((((size_t)(qi >> 5) * 64 + tl) * 32 + kh * 16 + r) * 2 + hi);
                        __hip_atomic_fetch_or(w, 1u << (qi & 31), RLX_AGENT);
                    }
                }
            }
            __syncthreads();
            continue;
        }
        if (lds32[L_FLAG / 4] != 0u) {
            for (int i = tid; i < 64 * HP; i += NWAVES * 64) lds32[L_HIST / 4 + i] = 0u;
            __syncthreads();
            sweep<1>(ikb, qfl0, iw, ntile, kq, lane, ql, qg, rot_seed, lds32, 0, nullptr);
            __syncthreads();
            if (tid < 64) {
                LAS unsigned* hq = lds32 + (L_HIST / 4) + tid * HP;
                const unsigned need = lds32[L_NEED / 4 + tid]; unsigned cum = 0; int d = 0;
                for (; d < 63; ++d) { const unsigned hv = hq[d]; if (cum + hv >= need) break; cum += hv; }
                lds32[L_TSEL / 4 + tid] = (unsigned)d; lds32[L_NEED / 4 + tid] = need - cum;
            }
            __syncthreads();
            for (int i = tid; i < 64 * HP; i += NWAVES * 64) lds32[L_HIST / 4 + i] = 0u;
            __syncthreads();
            sweep<2>(ikb, qfl0, iw, ntile, kq, lane, ql, qg, rot_seed, lds32, 0, nullptr);
            __syncthreads();
            if (tid < 64) {
                LAS unsigned* hq = lds32 + (L_HIST / 4) + tid * HP;
                const unsigned need = lds32[L_NEED / 4 + tid]; unsigned cum = 0; int d = 0;
                for (; d < 63; ++d) { const unsigned hv = hq[d]; if (cum + hv >= need) break; cum += hv; }
                lds32[L_IDXT / 4 + tid] = lds32[L_TSEL / 4 + tid] * 64u + (unsigned)d;
            }
            __syncthreads();
        }
        sweep<3>(ikb, qfl0, iw, ntile, kq, lane, ql, qg, rot_seed, lds32, 0, mout);
        __syncthreads();
    }
}
}
constexpr int N_PHASES = 1 + 12 * DEPTH;
#ifndef ALIGN_P1
#define ALIGN_P1 true
#endif
#ifndef ALIGN_P6
#define ALIGN_P6 true
#endif
struct Args { const float* in[19]; float* out; unsigned char* ws; int ph_lo, ph_hi, li, amask; };

#ifndef PHMASK
#define PHMASK 0xFFFF
#endif
#ifdef PROBE_BARRIER2
#define PROBE_BAR2(b) xcd_barrier(b)
#else
#define PROBE_BAR2(b) do { } while (0)
#endif
#define IN(k) (lo <= (k) && (k) < hi)
#define INL(j) (((PHMASK >> ((j) + 1)) & 1) && IN(pb + (j)))
#define SEAM(k) do { if (IN(k) && IN((k) + 1)) { XcdBarrier b_; b_.bar = (unsigned*)((gu32*)(ws_a + WS_CTL) + CW_BAR) + li * XCD_BAR_WORDS; b_.x = xb_xcc_id(); b_.tid = (unsigned)F.tid; \
        b_.st = (volatile LAS unsigned*)((LAS unsigned char*)lds + MISC_OFF) + 8; xcd_barrier(b_); PROBE_BAR2(b_); } } while (0)
#define FRESH() do { int l_ = (int)__builtin_amdgcn_mbcnt_hi(~0u, __builtin_amdgcn_mbcnt_lo(~0u, 0u)); asm volatile("" : "+v"(l_)); F.lane = l_; F.wave = wave0; F.tid = wave0 * 64 + l_; \
        { unsigned char* w_ = ws_a; asm volatile("" : "+s"(w_)); F.ws = w_; float* o_ = out_a; asm volatile("" : "+s"(o_)); F.out = o_; } \
        int b_ = blockIdx.x; asm volatile("" : "+s"(b_)); F.G = gridDim.x; F.vcu = (F.G % 8 == 0) ? (b_ % 8) * (F.G / 8) + b_ / 8 : b_; } while (0)
#ifdef PROBE_STAMP
#define STP ((LAS unsigned long long*)((LAS unsigned char*)lds + LDSCTL_OFF + 512))
#define STAMP(j) do { if (blockIdx.x == 0 && F.tid == 0) { const unsigned long long t_ = __builtin_amdgcn_s_memrealtime(); STP[1 + (j)] += t_ - STP[0]; STP[0] = t_; } } while (0)
#else
#define STAMP(j) do { } while (0)
#endif
template <int l>
__device__ __forceinline__ void layer_phases(Frame& F, const int lo, const int hi, const int li, const int amask, unsigned char* const ws_a, float* const out_a, const int wave0, unsigned char* const lds) {
    const int bx = (int)blockIdx.x;
        const int pb = 1 + 12 * l;

        if (INL(0)) { FRESH(); unsigned char* ws = F.ws;
#ifdef PROBE_STAGGER
            if ((bx >> 3) & 1) { for (int i_ = 0; i_ < PROBE_STAGGER; ++i_) __builtin_amdgcn_s_sleep(127); }
#endif
            GPlain g{(const char*)(ws + WS_XN), (const char*)(ws + WS_WIN), D, D};
            SchedGrid Sc{T / 256, NPROJ / 256, F.G, bx};
            EpiProj E{ws, F.in[I_BF] + l * 8};
#ifdef PROBE_EPI1
#if PROBE_EPIVAR > 0
            if (l == 0 && li == 0 && hi == 2) { EpiProjT<PROBE_EPIVAR> Ep{ws, F.in[I_BF] + l * 8}; pg8::gemm_phase<GPlain, EpiProjT<PROBE_EPIVAR>, SchedGrid, ALIGN_P1>(F.lds + RING_OFF, g, Sc, Ep, F.tid); } else
#else
            if (l == 0 && li == 0 && hi == 2) { EpiPlain Ep{(bf16*)(ws + WS_Z), NPROJ, 0}; pg8::gemm_phase<GPlain, EpiPlain, SchedGrid, ALIGN_P1>(F.lds + RING_OFF, g, Sc, Ep, F.tid); } else
#endif
#endif
            pg8::gemm_phase<GPlain, EpiProj, SchedGrid, ALIGN_P1>(F.lds + RING_OFF, g, Sc, E, F.tid);
            SEAM(pb + 0); STAMP(0);
        }
        if (INL(1)) { FRESH();
#ifndef PROBE_NOSCAN
            fox_scan(F);
#endif
#ifndef PROBE_NOSEL
            dsa_sel::select_phase(F, l);
#endif
            SEAM(pb + 1); STAMP(1); }
        if (INL(2)) { FRESH(); attention_phase(F, (char*)lds + RING_OFF, amask, l); SEAM(pb + 2); STAMP(2); }
        if (INL(3)) { FRESH(); diff_combine(F, l); SEAM(pb + 3); STAMP(3); }
        if (INL(4)) { FRESH(); unsigned char* ws = F.ws;
            GBranch g{(const char*)ws, (const char*)(ws + WS_WBR), 512, 512};
            SchedU Sc{F.G, bx};
            EpiPlain E{(bf16*)(ws + WS_U), 3072, 1024};
            pg8::gemm_phase<GBranch, EpiPlain, SchedU, true>(F.lds + RING_OFF, g, Sc, E, F.tid);
            SEAM(pb + 4); STAMP(4);
        }
        if (INL(5)) { FRESH(); unsigned char* ws = F.ws;
            GGate g{(const char*)(ws + WS_XN), (const char*)(ws + WS_WIN), D, D};
            SchedY Sc{F.G, bx};
            EpiGate E{(const bf16*)(ws + WS_U), (bf16*)(ws + WS_Y)};
            pg8::gemm_phase<GGate, EpiGate, SchedY, ALIGN_P6>(F.lds + RING_OFF, g, Sc, E, F.tid);
            SEAM(pb + 5); STAMP(5);
        }
        if (INL(6)) { FRESH(); unsigned char* ws = F.ws;
            GPlain g{(const char*)(ws + WS_Y), (const char*)(ws + WS_WO), D, D};
            SchedGrid Sc{T / 256, D / 256, F.G, bx};
            EpiResid E{(bf16*)(ws + WS_S1), (const bf16*)(ws + WS_XN)};
            pg8::gemm_phase<GPlain, EpiResid, SchedGrid, true>(F.lds + RING_OFF, g, Sc, E, F.tid);
            SEAM(pb + 6); STAMP(6);
        }
        if (INL(7)) { FRESH(); p8_ln1_router(F, l); SEAM(pb + 7); STAMP(7); }
        if (INL(8)) { FRESH(); p9_placement(F); SEAM(pb + 8); STAMP(8); }
        if (INL(9)) { FRESH(); unsigned char* ws = F.ws;
            const int* tile_e = (const int*)(ws + WS_TILEE);
            const int ntiles = __builtin_amdgcn_readfirstlane(__hip_atomic_load(tile_e + NRT_MAX, RLX_AGENT));
            LAS int* tab = (LAS int*)(F.lds + TAB_OFF); LAS int* tabe = (LAS int*)(F.lds + LDSCTL_OFF + 640);
            SchedMoe Sc{tabe, ntiles, F.G, bx};
            { Unit u; const int* row_tok = (const int*)(ws + WS_ROWTOK);
              if (F.tid < 8 && Sc.unit(F.tid, u)) tabe[F.tid] = __hip_atomic_load(tile_e + u.pm, RLX_AGENT);
              int rt_[4]; const int t_ = F.tid & 255, ih_ = F.tid >> 8;
#pragma unroll
              for (int k = 0; k < 4; ++k) { rt_[k] = 0; if (Sc.unit(2 * k + ih_, u)) rt_[k] = *(const GAS int*)(row_tok + u.pm * 256 + t_); }
#pragma unroll
              for (int k = 0; k < 4; ++k) tab[(2 * k + ih_) * 256 + t_] = rt_[k]; }
            __syncthreads();
            GMoe1 g{(const char*)(ws + WS_XN), (const char*)(ws + WS_EW), D, tab};
            EpiSwiglu E{(bf16*)(ws + WS_HID)};
            pg8::gemm_phase<GMoe1, EpiSwiglu, SchedMoe, true>(F.lds + RING_OFF, g, Sc, E, F.tid);
            SEAM(pb + 9); STAMP(9);
        }
        if (INL(10)) { FRESH(); unsigned char* ws = F.ws;
            const int* tile_e = (const int*)(ws + WS_TILEE);
            const int ntiles = __builtin_amdgcn_readfirstlane(__hip_atomic_load(tile_e + NRT_MAX, RLX_AGENT));
            LAS int* tabe = (LAS int*)(F.lds + LDSCTL_OFF + 640);
            SchedMoe Sc{tabe, ntiles, F.G, bx};
            { Unit u; if (F.tid < 8 && Sc.unit(F.tid, u)) tabe[F.tid] = __hip_atomic_load(tile_e + u.pm, RLX_AGENT); }
            __syncthreads();
            GMoe2 g{(const char*)(ws + WS_HID), (const char*)(ws + WS_EWD), DE, DE};
            EpiPlain E{(bf16*)(ws + WS_YR), D, 0};
            pg8::gemm_phase<GMoe2, EpiPlain, SchedMoe, true>(F.lds + RING_OFF, g, Sc, E, F.tid);
            SEAM(pb + 10); STAMP(10);
        }
        if (INL(11)) { FRESH();
#ifdef PROBE_P12
            p12_combine_ln2(F, l, args.li == 0);
#endif
            p12_combine_ln2(F, l); SEAM(pb + 11); STAMP(11); }
}
__global__ void __launch_bounds__(NWAVES * 64, 2) mk_fwd(Args args) {
    extern __shared__ __attribute__((aligned(16))) unsigned char lds[];
    Frame F;
    F.lds = (LAS unsigned char*)lds;
    F.MISC = (volatile LAS unsigned*)(F.lds + MISC_OFF);
    F.tid = threadIdx.x; F.lane = F.tid & 63; F.wave = __builtin_amdgcn_readfirstlane(F.tid >> 6);
    F.G = gridDim.x; { const int bx = blockIdx.x; F.vcu = (F.G % 8 == 0) ? (bx % 8) * (F.G / 8) + bx / 8 : bx; }
    F.ws = args.ws; F.out = args.out; F.in = args.in;
    F.ctl = (gu32*)(F.ws + WS_CTL);
    for (int u = F.tid; u < (LDS_BYTES - LDSCTL_OFF) / 4; u += NWAVES * 64) ((LAS unsigned*)(F.lds + LDSCTL_OFF))[u] = 0u;
    __syncthreads();
    const int wave0 = F.wave;
    (void)xcd_barrier_post((unsigned*)(F.ctl + CW_BAR) + args.li * XCD_BAR_WORDS, F.MISC + 8);
    const int lo = args.ph_lo, hi = args.ph_hi;
    unsigned char* const ws_a = args.ws; float* const out_a = args.out; const int li = args.li;
#ifdef PROBE_STAMP
    if (threadIdx.x == 0) { for (int i = 1; i < 16; ++i) STP[i] = 0ull; STP[0] = __builtin_amdgcn_s_memrealtime(); }
#endif
    if ((PHMASK & 1) && IN(0)) { FRESH(); p0_prologue(F); SEAM(0); STAMP(12); }

    layer_phases<0>(F, lo, hi, li, args.amask, ws_a, out_a, wave0, lds);
    layer_phases<1>(F, lo, hi, li, args.amask, ws_a, out_a, wave0, lds);
    static_assert(DEPTH == 2, "two layer instantiations");
#ifdef PROBE_STAMP
    {
        FRESH();
        if (blockIdx.x == 0 && F.tid == 0) { float sa = 0.f, sb = 0.f;
            for (int j = 0; j < 13; ++j) { const float us = (float)STP[1 + j] * 0.01f; if ((PROBE_SELA >> j) & 1) sa += us; if ((PROBE_SELB >> j) & 1) sb += us; }
#ifdef PROBE_COUNT
            sa = (float)__hip_atomic_load((unsigned*)(F.ws + WS_CTL) + 66, RLX_AGENT); sb = (float)__hip_atomic_load((unsigned*)(F.ws + WS_CTL) + 67, RLX_AGENT);
#endif
            sa = (float)PROBE_Q * floorf(sa / (float)PROBE_Q + 0.5f); sb = (float)PROBE_Q * floorf(sb / (float)PROBE_Q + 0.5f);
            __hip_atomic_store((float*)(F.ws + WS_CTL) + 64, sa, RLX_AGENT); __hip_atomic_store((float*)(F.ws + WS_CTL) + 65, sb, RLX_AGENT); }
        { XcdBarrier b_; b_.bar = (unsigned*)((gu32*)(ws_a + WS_CTL) + CW_BAR) + li * XCD_BAR_WORDS; b_.x = xb_xcc_id(); b_.tid = (unsigned)F.tid; b_.st = (volatile LAS unsigned*)((LAS unsigned char*)lds + MISC_OFF) + 8; xcd_barrier(b_); }
        const float sa = __hip_atomic_load((float*)(F.ws + WS_CTL) + 64, RLX_AGENT), sb = __hip_atomic_load((float*)(F.ws + WS_CTL) + 65, RLX_AGENT);
        for (size_t i = (size_t)blockIdx.x * 512 + F.tid; i < (size_t)T * D; i += (size_t)gridDim.x * 512) F.out[i] = (i == 0) ? sa + sb : sa;
    }
#endif

}

template <int MODE>
__global__ __launch_bounds__(64) void attn_naive_bf(unsigned char* ws, unsigned short* oalt) {
    const int chunk = blockIdx.x, he = blockIdx.y, b = blockIdx.z, lane = threadIdx.x;
    const int t = chunk * 64 + lane; const size_t rowb = (size_t)b * S;
    const bf16 *Q, *K, *V; bf16* O;
    if (MODE == 0) { const int hm = he >> 1, vh = he & 1; Q = (const bf16*)(ws + WS_Z) + hm * 64; K = (const bf16*)(ws + WS_Z + ZG) + hm * 64; V = (const bf16*)(ws + WS_Z + 2 * ZG) + (hm >> 1) * 128 + vh * 64; O = (oalt ? (bf16*)oalt : (bf16*)(ws + WS_OD)) + hm * 128 + vh * 64; }
    else if (MODE == 2) { Q = (const bf16*)(ws + WS_Z + 3 * ZG) + he * 64; K = (const bf16*)(ws + WS_Z + 4 * ZG) + he * 64; V = (const bf16*)(ws + WS_Z + 5 * ZG) + he * 64; O = (oalt ? (bf16*)oalt : (bf16*)(ws + WS_OS)) + he * 64; }
    else { Q = (const bf16*)(ws + WS_Z + 6 * ZG) + he * 64; K = (const bf16*)(ws + WS_Z + 7 * ZG) + he * 64; V = (const bf16*)(ws + WS_Z + 8 * ZG) + he * 64; O = (oalt ? (bf16*)oalt : (bf16*)(ws + WS_OF)) + he * 64; }
    float q[64];
    { const v4u* qp = (const v4u*)(Q + (rowb + t) * 512);
#pragma unroll
      for (int i = 0; i < 8; ++i) { const v4u w = qp[i]; q[8 * i] = bflo(w.x); q[8 * i + 1] = bfhi(w.x); q[8 * i + 2] = bflo(w.y); q[8 * i + 3] = bfhi(w.y); q[8 * i + 4] = bflo(w.z); q[8 * i + 5] = bfhi(w.z); q[8 * i + 6] = bflo(w.w); q[8 * i + 7] = bfhi(w.w); } }
    float acc[64];
#pragma unroll
    for (int i = 0; i < 64; ++i) acc[i] = 0.f;
    float m = -INFINITY, lsum = 0.f;
    const int kend = chunk * 64 + 64;
    const float* cb = (const float*)(ws + WS_CB) + (size_t)(b * 8 + he) * S;
    float cq = 0.f; if (MODE == 1) cq = cb[t];
    const unsigned* mask = (const unsigned*)(ws + (oalt ? WS_MASK1 : WS_MASK)) + (rowb + t) * 128;
    for (int j0 = 0; j0 < kend; j0 += 8) {
        float s[8]; unsigned mw = 0;
        if (MODE == 2) mw = mask[j0 >> 5] >> (j0 & 31);
#pragma unroll
        for (int jj = 0; jj < 8; ++jj) {
            const int j = j0 + jj; const v4u* kr = (const v4u*)(K + (rowb + j) * 512);
            float d = 0.f;
#pragma unroll
            for (int i = 0; i < 8; ++i) { const v4u w = kr[i];
                d = fmaf(q[8 * i], bflo(w.x), d); d = fmaf(q[8 * i + 1], bfhi(w.x), d); d = fmaf(q[8 * i + 2], bflo(w.y), d); d = fmaf(q[8 * i + 3], bfhi(w.y), d);
                d = fmaf(q[8 * i + 4], bflo(w.z), d); d = fmaf(q[8 * i + 5], bfhi(w.z), d); d = fmaf(q[8 * i + 6], bflo(w.w), d); d = fmaf(q[8 * i + 7], bfhi(w.w), d); }
            if (MODE == 1) { d += cq - cb[j]; if (j > t) d = -INFINITY; }
            if (MODE == 2) { if (!((mw >> jj) & 1u)) d = -INFINITY; }
            s[jj] = d;
        }
        float tm = s[0];
#pragma unroll
        for (int jj = 1; jj < 8; ++jj) tm = fmaxf(tm, s[jj]);
        const float mnew = fmaxf(m, tm);
        if (mnew > -INFINITY) {
            const float corr = exp2f(m - mnew);
            lsum *= corr;
#pragma unroll
            for (int i = 0; i < 64; ++i) acc[i] *= corr;
#pragma unroll
            for (int jj = 0; jj < 8; ++jj) {
                const float p = exp2f(s[jj] - mnew); lsum += p;
                const v4u* vr = (const v4u*)(V + (rowb + j0 + jj) * 512);
#pragma unroll
                for (int i = 0; i < 8; ++i) { const v4u w = vr[i];
                    acc[8 * i] = fmaf(p, bflo(w.x), acc[8 * i]); acc[8 * i + 1] = fmaf(p, bfhi(w.x), acc[8 * i + 1]); acc[8 * i + 2] = fmaf(p, bflo(w.y), acc[8 * i + 2]); acc[8 * i + 3] = fmaf(p, bfhi(w.y), acc[8 * i + 3]);
                    acc[8 * i + 4] = fmaf(p, bflo(w.z), acc[8 * i + 4]); acc[8 * i + 5] = fmaf(p, bfhi(w.z), acc[8 * i + 5]); acc[8 * i + 6] = fmaf(p, bflo(w.w), acc[8 * i + 6]); acc[8 * i + 7] = fmaf(p, bfhi(w.w), acc[8 * i + 7]); }
            }
            m = mnew;
        }
    }
    const float rl = 1.f / lsum;
    v4u* op = (v4u*)(O + (rowb + t) * (MODE == 0 ? 1024 : 512));
#pragma unroll
    for (int i = 0; i < 8; ++i) { v4u w; w.x = pk2(acc[8 * i] * rl, acc[8 * i + 1] * rl); w.y = pk2(acc[8 * i + 2] * rl, acc[8 * i + 3] * rl); w.z = pk2(acc[8 * i + 4] * rl, acc[8 * i + 5] * rl); w.w = pk2(acc[8 * i + 6] * rl, acc[8 * i + 7] * rl); op[i] = w; }
}
__device__ __forceinline__ unsigned f2key(float f) {
    unsigned u = __float_as_uint(f);
    if (u == 0x80000000u) u = 0u;
    return (u & 0x80000000u) ? ~u : (u | 0x80000000u);
}
__global__ __launch_bounds__(256) void dsa_naive_select(unsigned char* ws, int alt) {
    __shared__ unsigned keys[S];
    __shared__ float qv[256];
    __shared__ unsigned hist[256];
    __shared__ unsigned sh_prefix, sh_kk;
    __shared__ unsigned seg[256];
    const int qg = blockIdx.x, tid = threadIdx.x, b = qg / S, t = qg % S;
    const int nvis = (t / 64 + 1) * 64;
    qv[tid] = bf2f(((const bf16*)(ws + WS_IQ))[(size_t)qg * 256 + tid]);
    const f32x4 iw = *(const f32x4*)((const float*)(ws + WS_IW) + (size_t)qg * 4);
    __syncthreads();
    for (int j = tid; j < S; j += 256) {
        unsigned key = 0u;
        if (j < nvis) {
            const size_t grow = (size_t)b * S + j; const int kk_ = (int)(grow & 63);
            const bf16* kt = (const bf16*)(ws + WS_IK) + (grow >> 6) * 4096;
            float kv[64];
#pragma unroll
            for (int i = 0; i < 8; ++i) { const v4u w = *(const v4u*)(kt + ((((kk_ >> 5) * 4 + (i >> 1)) * 64 + (i & 1) * 32 + (kk_ & 31)) * 8)); kv[8 * i] = bflo(w.x); kv[8 * i + 1] = bfhi(w.x); kv[8 * i + 2] = bflo(w.y); kv[8 * i + 3] = bfhi(w.y); kv[8 * i + 4] = bflo(w.z); kv[8 * i + 5] = bfhi(w.z); kv[8 * i + 6] = bflo(w.w); kv[8 * i + 7] = bfhi(w.w); }
            float sc = 0.f;
#pragma unroll
            for (int hh = 0; hh < 4; ++hh) { float d = 0.f;
#pragma unroll
                for (int dd = 0; dd < 64; ++dd) d = fmaf(qv[hh * 64 + dd], kv[dd], d);
                sc = fmaf(iw[hh], fmaxf(d, 0.f), sc); }
            key = f2key(sc);
        }
        keys[j] = key;
    }
    __syncthreads();
    unsigned tau = 0, need = 0; const bool all_vis = nvis <= 256;
    if (!all_vis) {
        unsigned prefix = 0, kk = 256;
        for (int pass = 0; pass < 4; ++pass) {
            const int shift = 24 - 8 * pass;
            hist[tid] = 0;
            __syncthreads();
            for (int i = tid; i < nvis; i += 256) { const unsigned k = keys[i]; if (pass == 0 || (k >> (shift + 8)) == prefix) atomicAdd(&hist[(k >> shift) & 255u], 1u); }
            __syncthreads();
            if (tid == 0) { unsigned cum = 0; int d = 255; for (; d > 0; --d) { if (cum + hist[d] >= kk) break; cum += hist[d]; } sh_prefix = (prefix << 8) | (unsigned)d; sh_kk = kk - cum; }
            __syncthreads();
            prefix = sh_prefix; kk = sh_kk;
            __syncthreads();
        }
        tau = prefix; need = kk;
    }
    unsigned eqc = 0;
    if (!all_vis) {
#pragma unroll
        for (int i = 0; i < 16; ++i) { const int idx = tid * 16 + i; if (idx < nvis && keys[idx] == tau) ++eqc; }
    }
    seg[tid] = eqc;
    __syncthreads();
    if (tid == 0) { unsigned run = 0; for (int i = 0; i < 256; ++i) { const unsigned c = seg[i]; seg[i] = run; run += c; } }
    __syncthreads();
    unsigned rank = seg[tid], bits = 0;
#pragma unroll
    for (int i = 0; i < 16; ++i) {
        const int idx = tid * 16 + i; bool sel = false;
        if (idx < nvis) { if (all_vis) sel = true; else { const unsigned k = keys[idx]; if (k > tau) sel = true; else if (k == tau) { sel = rank < need; ++rank; } } }
        bits |= (sel ? 1u : 0u) << i;
    }
    const unsigned other = __shfl_down(bits, 1);
    if ((tid & 1) == 0) ((unsigned*)(ws + (alt ? WS_MASK1 : WS_MASK)))[(size_t)qg * 128 + (tid >> 1)] = bits | (other << 16);
}

#ifdef PROBE_CHECK_DIFF
__global__ void cmp_fill(const unsigned short* ref, const unsigned short* alt, size_t n, unsigned* red) {
    float m = 0.f;
    for (size_t i = (size_t)blockIdx.x * blockDim.x + threadIdx.x; i < n; i += (size_t)gridDim.x * blockDim.x) {
        const float a = bf2f(ref[i]), b = bf2f(alt[i]); m = fmaxf(m, fabsf(a - b)); }
    for (int o = 32; o > 0; o >>= 1) m = fmaxf(m, __shfl_xor(m, o));
    if ((threadIdx.x & 63) == 0) atomicMax(red, __float_as_uint(m));
}
__global__ void fill_out(float* out, const unsigned* red) { const float v = 1000.f * __uint_as_float(*red); for (size_t i = (size_t)blockIdx.x * blockDim.x + threadIdx.x; i < (size_t)T * D; i += (size_t)gridDim.x * blockDim.x) out[i] = v; }
#endif
extern "C" void kernel_launch(void* const* d_in, const int* in_sizes, int n_in, void* d_out, int out_size, void* d_ws, size_t ws_size, hipStream_t stream) {
    static int grid = 0;
    if (grid == 0) {
        if (n_in != 19 || out_size != T * D || ws_size < WS_END) { fprintf(stderr, "kernel_launch: unexpected shapes (n_in %d out %d ws %zu, need %zu); nothing launched\n", n_in, out_size, ws_size, (size_t)WS_END); grid = -1; return; }
        int dev = 0, cus = 0, per_cu = 0;
        if (hipGetDevice(&dev) != hipSuccess || hipDeviceGetAttribute(&cus, hipDeviceAttributeMultiprocessorCount, dev) != hipSuccess) { grid = -1; return; }
        if (hipFuncSetAttribute((const void*)mk_fwd, hipFuncAttributeMaxDynamicSharedMemorySize, LDS_BYTES) != hipSuccess) { fprintf(stderr, "kernel_launch: hipFuncSetAttribute failed\n"); grid = -1; return; }
        if (hipOccupancyMaxActiveBlocksPerMultiprocessor(&per_cu, (const void*)mk_fwd, NWAVES * 64, LDS_BYTES) != hipSuccess || per_cu < 1) { fprintf(stderr, "kernel_launch: occupancy query says %d\n", per_cu); }
        (void)hipGetLastError();
        if (cus < 256) { fprintf(stderr, "kernel_launch: needs 256 CUs, device has %d\n", cus); grid = -1; return; }
        grid = 256;
    }
    if (grid < 0) return;
    if (hipMemsetAsync((char*)d_ws + WS_CTL, 0, CTL_ZERO_BYTES, stream) != hipSuccess) return;
    Args a{};
    for (int i = 0; i < 19; ++i) a.in[i] = (const float*)d_in[i];
    a.out = (float*)d_out; a.ws = (unsigned char*)d_ws;
    unsigned char* ws = (unsigned char*)d_ws;
    a.amask = 7;
    auto run = [&](int lo, int hi, int li) { a.ph_lo = lo; a.ph_hi = hi; a.li = li; hipLaunchKernelGGL(mk_fwd, dim3(grid), dim3(NWAVES * 64), LDS_BYTES, stream, a); };
    auto naive = [&]() {
        hipLaunchKernelGGL(dsa_naive_select, dim3(T), dim3(256), 0, stream, ws, 0);
        hipLaunchKernelGGL(attn_naive_bf<2>, dim3(64, 8, NB), dim3(64), 0, stream, ws, (unsigned short*)nullptr);
    };
    (void)naive;
#ifdef PROBE_CHECK_DIFF
    run(0, 4, 0);
    {   unsigned short* alt = (unsigned short*)d_out; unsigned* red = (unsigned*)(ws + WS_CTL) + 70;
#if PROBE_CHECK_DIFF == 0
        hipLaunchKernelGGL(attn_naive_bf<0>, dim3(64, 16, NB), dim3(64), 0, stream, ws, alt);
        hipLaunchKernelGGL(cmp_fill, dim3(1024), dim3(256), 0, stream, (const unsigned short*)(ws + WS_OD), (const unsigned short*)alt, (size_t)T * 1024, red);
#elif PROBE_CHECK_DIFF == 1
        hipLaunchKernelGGL(attn_naive_bf<1>, dim3(64, 8, NB), dim3(64), 0, stream, ws, alt);
        hipLaunchKernelGGL(cmp_fill, dim3(1024), dim3(256), 0, stream, (const unsigned short*)(ws + WS_OF), (const unsigned short*)alt, (size_t)T * 512, red);
#else
        hipLaunchKernelGGL(dsa_naive_select, dim3(T), dim3(256), 0, stream, ws, 1);
        hipLaunchKernelGGL(attn_naive_bf<2>, dim3(64, 8, NB), dim3(64), 0, stream, ws, alt);
        hipLaunchKernelGGL(cmp_fill, dim3(1024), dim3(256), 0, stream, (const unsigned short*)(ws + WS_OS), (const unsigned short*)alt, (size_t)T * 512, red);
#endif
        hipLaunchKernelGGL(fill_out, dim3(1024), dim3(256), 0, stream, (float*)d_out, red); }
#elif defined(PROBE_K)
    run(0, PROBE_K + 1, 0); run(PROBE_K, N_PHASES, 1);
#else
    run(0, N_PHASES, 0);
#endif
}
```

```cpp
#include <hip/hip_runtime.h>
#include <hip/hip_bf16.h>
#include <cstdio>
#include <cstdint>
#include <cmath>

namespace cfg {
constexpr int D = 1024, NB = 8, S = 4096, T = NB * S, DEPTH = 2, INW = 8012;
constexpr int O_DQ = 0, O_DK = 512, O_DV = 1024, O_SQ = 1536, O_SK = 2048, O_SV = 2560, O_IQ = 3072, O_IK = 3328,
              O_IW = 3392, O_FQ = 3396, O_FK = 3908, O_FV = 4420, O_FF = 4932, O_G = 4940;
constexpr float LN_EPS = 1e-5f;
constexpr float ALPHA = 1.41421356237309515f;
constexpr float LOG2E = 1.4426950408889634f;
constexpr float C2 = 0.125f * LOG2E;
constexpr int NE = 32, DE = 512;
constexpr int NPROJ = 5120;
constexpr int RMAX = 2 * T + NE * 256 - NE;
constexpr int NRT_MAX = 288;
constexpr int RPAD = NRT_MAX * 256;
constexpr size_t MiB = 1u << 20;
constexpr size_t WS_CTL = 0, CTL_ZERO_BYTES = 1 * MiB;
constexpr size_t WS_CS = 1 * MiB;
constexpr size_t WS_SN = 5 * MiB;
constexpr size_t WS_LF = 9 * MiB;
constexpr size_t WS_CB = 10 * MiB;
constexpr size_t WS_IW = 11 * MiB;
constexpr size_t WS_EIDX = 11 * MiB + 512 * 1024;
constexpr size_t WS_WTS = 11 * MiB + 768 * 1024;
constexpr size_t WS_POS = 12 * MiB;
constexpr size_t WS_ROWTOK = 12 * MiB + 256 * 1024;
constexpr size_t WS_HIST = 12 * MiB + 640 * 1024;
constexpr size_t WS_TILEE = 12 * MiB + 704 * 1024;
constexpr size_t WS_W = 16 * MiB;
constexpr size_t WS_WIN = WS_W, WS_WBR = WS_W + 16 * MiB, WS_WO = WS_W + 19 * MiB;
constexpr size_t WS_XN = 38 * MiB;
constexpr size_t WS_MASK = 102 * MiB;
constexpr size_t WS_O = 118 * MiB;
constexpr size_t WS_OS = WS_O, WS_OF = WS_O + 32 * MiB;
constexpr size_t WS_OD = 182 * MiB;
constexpr size_t WS_Z = 246 * MiB;
constexpr size_t ZG = 32 * MiB;
constexpr size_t WS_IQ = WS_Z + 9 * ZG, WS_IK = WS_IQ + 16 * MiB, WS_ZEND = WS_IK + 4 * MiB;
constexpr size_t WS_U = WS_Z;
constexpr size_t WS_Y = WS_Z + 192 * MiB;
constexpr size_t WS_ODC = WS_Z + 256 * MiB;
constexpr size_t WS_EW = WS_O;
constexpr size_t WS_EWD = WS_EW + 64 * MiB;
constexpr size_t WS_S1 = WS_Z;
constexpr size_t WS_HID = WS_Z;
constexpr size_t WS_YR = WS_Z + 72 * MiB;
constexpr size_t WS_MASK1 = WS_ZEND;
constexpr size_t WS_END = WS_ZEND + 16 * MiB;
static_assert(WS_ODC + 32 * MiB <= WS_ZEND && WS_YR + 144 * MiB <= WS_ZEND && WS_EWD + 32 * MiB <= WS_Z, "ws map");
constexpr int CW_BAR = 4096;
}
using namespace cfg;

#define GAS __attribute__((address_space(1)))
#define LAS __attribute__((address_space(3)))
typedef unsigned short bf16;
typedef unsigned v4u __attribute__((ext_vector_type(4)));
typedef unsigned v2u __attribute__((ext_vector_type(2)));
typedef float f32x4 __attribute__((ext_vector_type(4)));
typedef float f32x2 __attribute__((ext_vector_type(2)));
typedef short bf16x8 __attribute__((ext_vector_type(8)));
typedef GAS unsigned gu32;
#define RLX_AGENT __ATOMIC_RELAXED, __HIP_MEMORY_SCOPE_AGENT
#define LDS_WAIT() asm volatile("s_waitcnt lgkmcnt(0)" ::: "memory")
#define VM_WAIT() asm volatile("s_waitcnt vmcnt(0)" ::: "memory")
__device__ __forceinline__ unsigned f2bf(float f) { unsigned u = __builtin_bit_cast(unsigned, f); return (u + 0x7fffu + ((u >> 16) & 1u)) >> 16; }
__device__ __forceinline__ unsigned pk2(float lo, float hi) { return f2bf(lo) | (f2bf(hi) << 16); }
__device__ __forceinline__ float bf2f(unsigned short h) { return __builtin_bit_cast(float, (unsigned)h << 16); }
__device__ __forceinline__ float bflo(unsigned w) { return __builtin_bit_cast(float, w << 16); }
__device__ __forceinline__ float bfhi(unsigned w) { return __builtin_bit_cast(float, w & 0xffff0000u); }
__device__ __forceinline__ unsigned cvt_pk_bf16(float lo, float hi) { unsigned r; asm volatile("v_cvt_pk_bf16_f32 %0, %1, %2" : "=v"(r) : "v"(lo), "v"(hi)); return r; }
__device__ __forceinline__ float wave_sum(float v) {
#pragma unroll
    for (int o = 1; o < 64; o <<= 1) v += __shfl_xor(v, o);
    return v;
}
__device__ __forceinline__ float sigmoidf_(float x) { return __builtin_amdgcn_rcpf(1.f + __builtin_amdgcn_exp2f(-LOG2E * x)); }
namespace pg8 {
#define PG8_LAS __attribute__((address_space(3)))
constexpr int BM = 256, BK = 64, HALF = 128, HTB = HALF * BK * 2  , STAGE_BYTES = 8 * HTB, NXCD = 8, WGM = 8;
__host__ __device__ __forceinline__ int lds_byte(int r, int c) { const int st = (r >> 4) * 2 + (c >> 5), rr = r & 15, cc = c & 31, ob = rr * 64 + cc * 2; return st * 1024 + (ob ^ (((ob >> 9) & 1) << 5)); }
__host__ __device__ __forceinline__ void stage_rc(int b, int& R, int& C) { const int st = b / 1024, sb = b % 1024, swz = sb ^ (((sb >> 9) & 1) << 5); R = (st >> 1) * 16 + swz / 64; C = (st & 1) * 32 + (swz % 64) / 2; }
__host__ __device__ __forceinline__ int perm32(int rho) { const int n = rho >> 4, i = rho & 15; return 8 * (i >> 2) + 4 * n + (i & 3); }

struct Unit { int pm, pn, aux; };

__device__ __forceinline__ void map_unit(int L, int nM, int nN, int& pm, int& pn) {
    const int nwg = nM * nN; int wgid = L;
    { const int q = nwg / NXCD, r = nwg % NXCD, xcd = wgid % NXCD, off = wgid / NXCD; wgid = (xcd < r ? xcd * (q + 1) : r * (q + 1) + (xcd - r) * q) + off; }
    const int nig = WGM * nN, gid = wgid / nig, fm = gid * WGM, gsz = (nM - fm) < WGM ? (nM - fm) : WGM;
    pm = fm + ((wgid % nig) % gsz); pn = (wgid % nig) / gsz;
}

template <class G, class Epi, class Sched, bool ALIGN_EPI>
__device__ __forceinline__ void gemm_phase(PG8_LAS unsigned char* lds, const G& g, const Sched& S, const Epi& E, int tid_in) {
    int tid_ = tid_in; asm volatile("" : "+v"(tid_));
    const int tid = tid_, wid = __builtin_amdgcn_readfirstlane(tid >> 6), lane = tid & 63, wr = wid >> 2, wc = wid & 3, fr = lane & 15, fq = lane >> 4;
    const int K = g.K, nt = K / BK;
    constexpr bool GA = G::GATHER;
    unsigned voffB[2], voffA[2];
#pragma unroll
    for (int i = 0; i < 2; ++i) { int R, C; stage_rc(tid * 16 + i * 8192, R, C); const int Rb = (R & ~31) + perm32(R & 31); voffB[i] = (unsigned)(Rb * K + C) * 2u;
        if constexpr (!GA) voffA[i] = (unsigned)(R * g.lda + C) * 2u; else voffA[i] = 0u; }
    const size_t kstep = (size_t)(BK * 2);
    const size_t hstep = (size_t)HALF * K * 2;
    size_t hstepA = 0; if constexpr (!GA) hstepA = (size_t)HALF * g.lda * 2;
    const unsigned ldsw = (unsigned)wid * 1024u;
    const int aoff = lds_byte(wr * 64 + fr, fq * 8), boff = lds_byte(wc * 32 + fr, fq * 8);
#define PG8_SA(b, h) (((b) * 2 + (h)) * HTB)
#define PG8_SB(b, h) ((4 + (b) * 2 + (h)) * HTB)
#define PG8_STAGE(bufoff, gbase, voff) do { _Pragma("unroll") for (int _i = 0; _i < 2; ++_i) \
        __builtin_amdgcn_global_load_lds((const unsigned*)((const char*)(gbase) + (voff)[_i]), (PG8_LAS unsigned*)(lds + (bufoff) + ldsw + _i * 8192), 16, 0, 0); } while (0)
#define PG8_LDA(dst, b, h) do { _Pragma("unroll") for (int m = 0; m < 4; ++m) _Pragma("unroll") for (int k = 0; k < 2; ++k) dst[m][k] = *(const PG8_LAS bf16x8*)(lds + PG8_SA(b, h) + aoff + m * 2048 + k * 1024); } while (0)
#define PG8_LDB(dst, b, h) do { _Pragma("unroll") for (int n = 0; n < 2; ++n) _Pragma("unroll") for (int k = 0; k < 2; ++k) dst[n][k] = *(const PG8_LAS bf16x8*)(lds + PG8_SB(b, h) + boff + n * 2048 + k * 1024); } while (0)
#define PG8_MMA(ai, bj, At, Bt) do { __builtin_amdgcn_s_setprio(1); _Pragma("unroll") for (int m = 0; m < 4; ++m) _Pragma("unroll") for (int n = 0; n < 2; ++n) _Pragma("unroll") for (int k = 0; k < 2; ++k) \
        acc[ai][bj][m][n] = __builtin_amdgcn_mfma_f32_16x16x32_bf16(Bt[n][k], At[m][k], acc[ai][bj][m][n], 0, 0, 0); __builtin_amdgcn_s_setprio(0); } while (0)
#define PG8_WAIT_V(n) asm volatile("s_waitcnt vmcnt(" #n ")" ::: "memory")
#define PG8_WAIT_L(n) asm volatile("s_waitcnt lgkmcnt(" #n ")" ::: "memory")
#define PG8_BAR __builtin_amdgcn_s_barrier()
#define PG8_SCHED __builtin_amdgcn_sched_barrier(0)
    Unit cur, nxt; int ui = 0;
    if (!S.next(0, cur)) return;
    f32x4 acc[2][2][4][2];
#pragma unroll
    for (int a = 0; a < 2; ++a)
#pragma unroll
        for (int b = 0; b < 2; ++b)
#pragma unroll
            for (int m = 0; m < 4; ++m)
#pragma unroll
                for (int n = 0; n < 2; ++n) acc[a][b][m][n] = (f32x4){0.f, 0.f, 0.f, 0.f};
    bf16x8 At[4][2], B0[2][2], B1[2][2];
    unsigned vC0[2], vC1[2], vN0[2], vN1[2];
    const char* cA0; const char* cA1;
    if constexpr (GA) {
#pragma unroll
        for (int i = 0; i < 2; ++i) { int R, C; stage_rc(tid * 16 + i * 8192, R, C); vC0[i] = g.a_off(cur, 0, 0, R, C); vC1[i] = g.a_off(cur, 0, 1, R, C); }
        cA0 = g.a_base; cA1 = g.a_base;
    } else {
#pragma unroll
        for (int i = 0; i < 2; ++i) { vC0[i] = voffA[i]; vC1[i] = voffA[i]; vN0[i] = voffA[i]; vN1[i] = voffA[i]; }
        cA0 = g.a_ptr(cur); cA1 = cA0 + hstepA;
    }
    const char* cB = g.b_ptr(cur);
    PG8_STAGE(PG8_SB(0, 0), cB, voffB); PG8_STAGE(PG8_SB(0, 1), cB + hstep, voffB); PG8_STAGE(PG8_SA(0, 0), cA0, vC0); PG8_STAGE(PG8_SA(0, 1), cA1, vC1);
    if (wr == 1) PG8_BAR;
    PG8_WAIT_V(2); PG8_BAR;
    PG8_STAGE(PG8_SB(1, 0), cB + kstep, voffB); PG8_STAGE(PG8_SA(1, 0), cA0 + kstep, vC0); PG8_STAGE(PG8_SB(1, 1), cB + hstep + kstep, voffB);
    PG8_WAIT_V(6); PG8_BAR;
    for (;;) {
        const bool has_next = S.next(ui + 1, nxt);
        const char* nB = cB; const char* nA0 = cA0; const char* nA1 = cA1;
        if (has_next) {
            if constexpr (GA) {
#pragma unroll
                for (int i = 0; i < 2; ++i) { int R, C; stage_rc(tid * 16 + i * 8192, R, C); vN0[i] = g.a_off(nxt, ui + 1, 0, R, C); vN1[i] = g.a_off(nxt, ui + 1, 1, R, C); }
            } else { nA0 = g.a_ptr(nxt); nA1 = nA0 + hstepA; }
            nB = g.b_ptr(nxt);
        } else {
            if constexpr (GA) {
#pragma unroll
                for (int i = 0; i < 2; ++i) { vN0[i] = vC0[i]; vN1[i] = vC1[i]; }
            }
        }
        for (int t = 0; t < nt; t += 2) {
            const bool last = (t == nt - 2);
            const char* a1 = cA1 + (size_t)(t + 1) * kstep;
            const char* a20 = last ? nA0 : cA0 + (size_t)(t + 2) * kstep; const char* a21 = last ? nA1 : cA1 + (size_t)(t + 2) * kstep;
            const char* b2 = last ? nB : cB + (size_t)(t + 2) * kstep;
            const char* a30 = a20 + kstep; const char* b3 = b2 + kstep;
            unsigned w0[2], w1[2];
#pragma unroll
            for (int i = 0; i < 2; ++i) { if constexpr (GA) { w0[i] = last ? vN0[i] : vC0[i]; w1[i] = last ? vN1[i] : vC1[i]; } else { w0[i] = voffA[i]; w1[i] = voffA[i]; } }
            PG8_LDB(B0, 0, 0); PG8_LDB(B1, 0, 1); PG8_SCHED; PG8_LDA(At, 0, 0); PG8_STAGE(PG8_SA(1, 1), a1, vC1);
            PG8_WAIT_V(8); PG8_WAIT_L(0); PG8_BAR; PG8_MMA(0, 0, At, B0); PG8_MMA(0, 1, At, B1); PG8_BAR; PG8_SCHED;
            PG8_LDA(At, 0, 1); PG8_STAGE(PG8_SB(0, 0), b2, voffB); PG8_STAGE(PG8_SB(0, 1), b2 + hstep, voffB); PG8_STAGE(PG8_SA(0, 0), a20, w0);
            PG8_WAIT_V(8); PG8_WAIT_L(0); PG8_BAR; PG8_MMA(1, 0, At, B0); PG8_MMA(1, 1, At, B1); PG8_BAR; PG8_SCHED;
            PG8_LDB(B0, 1, 0); PG8_LDB(B1, 1, 1); PG8_SCHED; PG8_LDA(At, 1, 0); PG8_STAGE(PG8_SA(0, 1), a21, w1);
            PG8_WAIT_V(8); PG8_WAIT_L(0); PG8_BAR; PG8_MMA(0, 0, At, B0); PG8_MMA(0, 1, At, B1); PG8_BAR; PG8_SCHED;
            PG8_LDA(At, 1, 1); PG8_STAGE(PG8_SB(1, 0), b3, voffB); PG8_STAGE(PG8_SB(1, 1), b3 + hstep, voffB); PG8_STAGE(PG8_SA(1, 0), a30, w0);
            PG8_WAIT_V(8); PG8_WAIT_L(0); PG8_BAR; PG8_MMA(1, 0, At, B0); PG8_MMA(1, 1, At, B1); PG8_BAR; PG8_SCHED;
        }
        if constexpr (ALIGN_EPI) { if (wr == 0) PG8_BAR; }
        E(acc, cur, wr, wc, fr, fq);
        if (!has_next) break;
#pragma unroll
        for (int a = 0; a < 2; ++a)
#pragma unroll
            for (int b = 0; b < 2; ++b)
#pragma unroll
                for (int m = 0; m < 4; ++m)
#pragma unroll
                    for (int n = 0; n < 2; ++n) acc[a][b][m][n] = (f32x4){0.f, 0.f, 0.f, 0.f};
        cur = nxt; cB = nB; cA0 = nA0; cA1 = nA1; ++ui;
        if constexpr (GA) {
#pragma unroll
            for (int i = 0; i < 2; ++i) { vC0[i] = vN0[i]; vC1[i] = vN1[i]; }
        }
        if constexpr (ALIGN_EPI) { if (wr == 1) PG8_BAR; }
    }
    PG8_WAIT_V(0);
    if constexpr (!ALIGN_EPI) { if (wr == 0) PG8_BAR; }
    PG8_BAR;
#undef PG8_SA
#undef PG8_SB
#undef PG8_STAGE
#undef PG8_LDA
#undef PG8_LDB
#undef PG8_MMA
#undef PG8_WAIT_V
#undef PG8_WAIT_L
#undef PG8_BAR
#undef PG8_SCHED
}
}
#define XB_TMO      128
#define XB_XCNT(j)  (256  + 64 * (j))
#define XB_XSUB(j)  (1280 + 64 * (j))
#define XB_XGEN(j)  (2304 + 64 * (j))
#define XB_TOP      3328
#define XB_TOPGEN   3392
#define XCD_BAR_WORDS 3456
#define XB_SPIN_CAP (1u << 18)

__device__ __forceinline__ unsigned xb_ld(unsigned* p)              { return __hip_atomic_load(p, __ATOMIC_RELAXED, __HIP_MEMORY_SCOPE_AGENT); }
__device__ __forceinline__ unsigned xb_add(unsigned* p, unsigned v) { return __hip_atomic_fetch_add(p, v, __ATOMIC_RELAXED, __HIP_MEMORY_SCOPE_AGENT); }
__device__ __forceinline__ unsigned xb_xcc_id() { return (unsigned)__builtin_amdgcn_s_getreg((3 << 11) | 20) & 0xFu; }
#define XB_SPIN(cond, bar) do { unsigned _sp = 0; while (cond) { __builtin_amdgcn_s_sleep(1); \
    if ((++_sp & 255u) == 0u) { if (xb_ld(&(bar)[XB_TMO])) break; if (_sp > XB_SPIN_CAP) { atomicAdd(&(bar)[XB_TMO], 1u); break; } } } } while (0)

struct XcdBarrier {
    unsigned* bar; unsigned x; unsigned tid;
    volatile LAS unsigned* st;
};

__device__ __forceinline__ XcdBarrier xcd_barrier_post(unsigned* bar, volatile LAS unsigned* st) {
    XcdBarrier b; b.bar = bar; b.x = xb_xcc_id(); b.st = st;
    if (threadIdx.x == 0) (void)xb_add(&bar[XB_XCNT(b.x)], 1u);
    return b;
}
__device__ __forceinline__ void xcd_barrier_complete(unsigned* bar, unsigned x, unsigned& nloc, unsigned& nx) {
    const unsigned G = gridDim.x * gridDim.y * gridDim.z;
    unsigned sum, cnt, mine, sp = 0u;
    for (;;) {
        sum = 0u; cnt = 0u; mine = 0u;
#pragma unroll
        for (unsigned j = 0; j < 16; ++j) { const unsigned c = xb_ld(&bar[XB_XCNT(j)]); sum += c; cnt += (c > 0u) ? 1u : 0u; mine = (j == x) ? c : mine; }
        if (sum == G) break;
        __builtin_amdgcn_s_sleep(1);
        if ((++sp & 255u) == 0u) { if (xb_ld(&bar[XB_TMO])) break; if (sp > XB_SPIN_CAP) { atomicAdd(&bar[XB_TMO], 1u); break; } }
    }
    nloc = mine > 0u ? mine : 1u; nx = cnt > 0u ? cnt : 1u;
}

__device__ __forceinline__ void xcd_barrier(const XcdBarrier& b) {
    asm volatile("s_waitcnt vmcnt(0)" ::: "memory");
    __syncthreads();
    if (b.tid == 0u) {
        unsigned* bar = b.bar;
        __builtin_amdgcn_s_waitcnt(0);
        unsigned nloc = b.st[0], nx = b.st[1];
        if (nloc == 0u) { xcd_barrier_complete(bar, b.x, nloc, nx); b.st[0] = nloc; b.st[1] = nx; }
        const unsigned old = xb_add(&bar[XB_XSUB(b.x)], 1u);
        const unsigned gen = old / nloc;
        if (old + 1u == (gen + 1u) * nloc) {
            __builtin_amdgcn_fence(__ATOMIC_RELEASE, "agent");
            asm volatile("s_waitcnt vmcnt(0)" ::: "memory");
            const unsigned og = xb_add(&bar[XB_TOP], 1u);
            const unsigned tg = og / nx;
            if (og + 1u == (tg + 1u) * nx) xb_add(&bar[XB_TOPGEN], 1u);
            else XB_SPIN(xb_ld(&bar[XB_TOPGEN]) == tg, bar);
            __builtin_amdgcn_fence(__ATOMIC_ACQUIRE, "agent");
            xb_add(&bar[XB_XGEN(b.x)], 1u);
            asm volatile("s_waitcnt vmcnt(0)" ::: "memory");
        } else {
            XB_SPIN(xb_ld(&bar[XB_XGEN(b.x)]) == gen, bar);
            __builtin_amdgcn_fence(__ATOMIC_ACQUIRE, "agent");
            asm volatile("s_waitcnt vmcnt(0)" ::: "memory");
        }
    }
    __syncthreads();
}
constexpr int NWAVES = 8;
constexpr int RING_OFF = 0, RING_BYTES = 131072;
constexpr int LDSCTL_OFF = RING_BYTES, MISC_OFF = LDSCTL_OFF + 320;
constexpr int TAB_OFF = LDSCTL_OFF + 1024;
constexpr int LDS_BYTES = 147456;
static_assert(TAB_OFF + 8 * 1024 <= LDS_BYTES, "LDS map");

struct Frame {
    LAS unsigned char* lds;
    volatile LAS unsigned* MISC;
    gu32* ctl;
    int tid, lane, wave, vcu, G;
    unsigned char* ws; float* out;
    const float* const* in;
};
enum { I_X = 0, I_POS, I_LNG, I_LNB, I_WIN, I_BF, I_LAM, I_DNG, I_WBR, I_WO, I_LN1G, I_LN1B, I_WR, I_BR, I_WG, I_WU, I_WD, I_LN2G, I_LN2B };

__device__ __forceinline__ int win_src(int n) {
    if (n < 4608) {
        const int g = n >> 9, c = n & 511;
        const int base = g == 0 ? O_DQ : g == 1 ? O_DK : g == 2 ? O_DV : g == 3 ? O_SQ : g == 4 ? O_SK : g == 5 ? O_SV : g == 6 ? O_FQ : g == 7 ? O_FK : O_FV;
        const bool rope = (g == 0) | (g == 1) | (g == 3) | (g == 4);
        if (rope) { const int j = c & 63; return base + (c & ~63) + (j >> 1) + 32 * (j & 1); }
        return base + c;
    }
    if (n < 4864) { const int c = n - 4608, j = c & 63; return O_IQ + (c & ~63) + (j >> 1) + 32 * (j & 1); }
    if (n < 4928) { const int j = n - 4864; return O_IK + (j >> 1) + 32 * (j & 1); }
    if (n < 4932) return O_IW + (n - 4928);
    if (n < 4940) return O_FF + (n - 4932);
    if (n < NPROJ) return -1;
    return O_G + (n - NPROJ);
}
template <bool MAPPED>
__device__ __forceinline__ void transpose_item(const float* W, int ldw, int k0, int n0, bf16* WT, int ldt, int drow0, LAS float* scr, int lane) {
    int sc = n0 + (lane & 31);
    if (MAPPED) sc = win_src(sc);
    float wv[32];
#pragma unroll
    for (int i = 0; i < 32; ++i) { const int kk = 2 * i + (lane >> 5); wv[i] = (sc >= 0) ? W[(size_t)(k0 + kk) * ldw + sc] : 0.f; }
#pragma unroll
    for (int i = 0; i < 32; ++i) { const int kk = 2 * i + (lane >> 5); scr[kk * 33 + (lane & 31)] = wv[i]; }
    LDS_WAIT(); asm volatile("" ::: "memory");
    const int c = lane & 7;
#pragma unroll
    for (int j = 0; j < 4; ++j) { const int n = (lane >> 3) + 8 * j; const LAS float* s = scr + (8 * c) * 33 + n;
        v4u o; o.x = pk2(s[0 * 33], s[1 * 33]); o.y = pk2(s[2 * 33], s[3 * 33]); o.z = pk2(s[4 * 33], s[5 * 33]); o.w = pk2(s[6 * 33], s[7 * 33]);
        *(GAS v4u*)(WT + (size_t)(drow0 + n) * ldt + k0 + 8 * c) = o; }
    LDS_WAIT(); asm volatile("" ::: "memory");
}
__device__ __forceinline__ void convert_layer_weights(Frame& F, int l, int gw, int NGW) {
    LAS float* scr = (LAS float*)(F.lds + RING_OFF + F.wave * 16384);
    constexpr int I_IN = 16 * 256, I_BRN = 3 * 8 * 32, I_ON = 16 * 32;
    for (int it = gw; it < I_IN + I_BRN + I_ON; it += NGW) {
        int r = it;
        if (r < I_IN) { const int kb = r >> 8, nb = r & 255; transpose_item<true>(F.in[I_WIN] + (size_t)l * D * INW, INW, 64 * kb, 32 * nb, (bf16*)(F.ws + WS_WIN), D, 32 * nb, scr, F.lane); continue; } r -= I_IN;
        if (r < I_BRN) { const int br = r >> 8, q = r & 255, kb = q >> 5, nb = q & 31;
            transpose_item<false>(F.in[I_WBR] + ((size_t)l * 3 + br) * 512 * D, D, 64 * kb, 32 * nb, (bf16*)(F.ws + WS_WBR) + (size_t)br * D * 512, 512, 32 * nb, scr, F.lane); continue; } r -= I_BRN;
        { const int kb = r >> 5, nb = r & 31; transpose_item<false>(F.in[I_WO] + (size_t)l * D * D, D, 64 * kb, 32 * nb, (bf16*)(F.ws + WS_WO), D, 32 * nb, scr, F.lane); }
    }
}
__device__ __forceinline__ void convert_expert_weights(Frame& F, int l, int gw, int NGW) {
    LAS float* scr = (LAS float*)(F.lds + RING_OFF + F.wave * 16384);
    constexpr int PER = 256;
    for (int it = gw; it < 3 * NE * PER; it += NGW) {
        const int which = it / (NE * PER), r = it % (NE * PER), e = r / PER, q = r % PER;
        if (which < 2) { const int kb = q >> 4, nb = q & 15, n0 = 32 * nb;
            const float* W = F.in[which == 0 ? I_WG : I_WU] + ((size_t)l * NE + e) * D * DE;
            transpose_item<false>(W, DE, 64 * kb, n0, (bf16*)(F.ws + WS_EW) + (size_t)e * 1024 * D, D, (n0 >> 7) * 256 + (n0 & 127) + which * 128, scr, F.lane);
        } else { const int kb = q >> 5, nb = q & 31;
            const float* W = F.in[I_WD] + ((size_t)l * NE + e) * DE * D;
            transpose_item<false>(W, D, 64 * kb, 32 * nb, (bf16*)(F.ws + WS_EWD) + (size_t)e * D * DE, DE, 32 * nb, scr, F.lane);
        }
    }
}

struct LnGB { f32x4 g[4], b[4]; };
__device__ __forceinline__ void ln_load_gb(LnGB& p, const float* g, const float* b, int lane) {
#pragma unroll
    for (int j = 0; j < 4; ++j) { p.g[j] = *(const GAS f32x4*)(g + 256 * j + 4 * lane); p.b[j] = *(const GAS f32x4*)(b + 256 * j + 4 * lane); }
}
__device__ __forceinline__ void ln_row(f32x4 (&v)[4], const LnGB& p) {
    float s = 0.f;
#pragma unroll
    for (int j = 0; j < 4; ++j) s += (v[j].x + v[j].y) + (v[j].z + v[j].w);
    const float mean = wave_sum(s) * (1.f / D); float s2 = 0.f;
#pragma unroll
    for (int j = 0; j < 4; ++j) { v[j] = v[j] - mean; s2 += (v[j].x * v[j].x + v[j].y * v[j].y) + (v[j].z * v[j].z + v[j].w * v[j].w); }
    const float rstd = 1.f / sqrtf(wave_sum(s2) * (1.f / D) + LN_EPS);
#pragma unroll
    for (int j = 0; j < 4; ++j) v[j] = v[j] * rstd * p.g[j] + p.b[j];
}
__device__ __forceinline__ void store_row(const f32x4 (&v)[4], float* of32, bf16* obf, int lane) {
    if (of32) {
#pragma unroll
        for (int j = 0; j < 4; ++j) *((GAS f32x4*)of32 + 64 * j + lane) = v[j];
    }
    if (obf) {
        GAS unsigned long long* o8 = (GAS unsigned long long*)obf + lane;
#pragma unroll
        for (int j = 0; j < 4; ++j) o8[64 * j] = (unsigned long long)pk2(v[j].x, v[j].y) | ((unsigned long long)pk2(v[j].z, v[j].w) << 32);
    }
}

__device__ __forceinline__ void sincos_tab(double a, float& c, float& s) {
    const double q = rint(a * 0.63661977236758134308);
    double r = fma(-q, 1.57079632679489655800e+00, a); r = fma(-q, 6.12323399573676603587e-17, r);
    const double r2 = r * r;
    double sp = -1.0 / 1307674368000.0; sp = fma(sp, r2, 1.0 / 6227020800.0); sp = fma(sp, r2, -1.0 / 39916800.0); sp = fma(sp, r2, 1.0 / 362880.0); sp = fma(sp, r2, -1.0 / 5040.0); sp = fma(sp, r2, 1.0 / 120.0); sp = fma(sp, r2, -1.0 / 6.0); sp = fma(sp * r2, r, r);
    double cp = 1.0 / 20922789888000.0; cp = fma(cp, r2, -1.0 / 87178291200.0); cp = fma(cp, r2, 1.0 / 479001600.0); cp = fma(cp, r2, -1.0 / 3628800.0); cp = fma(cp, r2, 1.0 / 40320.0); cp = fma(cp, r2, -1.0 / 720.0); cp = fma(cp, r2, 1.0 / 24.0); cp = fma(cp, r2, -0.5); cp = fma(cp, r2, 1.0);
    const int n = (int)q & 3;
    const double sn_ = (n & 1) ? cp : sp, cn_ = (n & 1) ? sp : cp;
    s = (float)((n & 2) ? -sn_ : sn_); c = (float)(((n + 1) & 2) ? -cn_ : cn_);
}
__device__ __forceinline__ void p0_prologue(Frame& F) {
    const int gw = F.vcu * NWAVES + F.wave, NGW = F.G * NWAVES;
    convert_layer_weights(F, 0, gw, NGW);
    {
        LnGB P; ln_load_gb(P, F.in[I_LNG], F.in[I_LNB], F.lane);
        f32x4 vA[4], vB[4];
#define P0_LOAD(V_, m_) do { const int mm_ = (m_) < T ? (m_) : T - 1; _Pragma("unroll") for (int j = 0; j < 4; ++j) V_[j] = *((const GAS f32x4*)(F.in[I_X] + (size_t)mm_ * D) + 64 * j + F.lane); __builtin_amdgcn_sched_barrier(0); } while (0)
#define P0_PROC(V_, m_) do { if ((m_) < T) { ln_row(V_, P); store_row(V_, (float*)nullptr, (bf16*)(F.ws + WS_XN) + (size_t)(m_) * D, F.lane); } __builtin_amdgcn_sched_barrier(0); } while (0)
        P0_LOAD(vA, gw);
        for (int m = gw; m < T; m += 2 * NGW) { P0_LOAD(vB, m + NGW); P0_PROC(vA, m); P0_LOAD(vA, m + 2 * NGW); P0_PROC(vB, m + NGW); }
#undef P0_LOAD
#undef P0_PROC
    }
    const int* positions = (const int*)F.in[I_POS];
    float* cs = (float*)(F.ws + WS_CS); float* sn = (float*)(F.ws + WS_SN);
    for (int i = (F.vcu * NWAVES * 64) + F.tid; i < T * 32; i += F.G * NWAVES * 64) {
        const int t = i >> 5, k = i & 31;
        const float inv = powf(10000.0f, -(float)(2 * k) / 64.0f);
        const float ang = (float)positions[t] * inv;
        sincos_tab((double)ang, cs[i], sn[i]);
    }
}

__device__ __forceinline__ void fox_scan(Frame& F) {
    const int gw = F.vcu * NWAVES + F.wave;
    if (gw >= NB * 8) return;
    const int b = gw >> 3, h = gw & 7;
    const float* lf = (const float*)(F.ws + WS_LF) + (size_t)b * S * 8 + h;
    float* cb = (float*)(F.ws + WS_CB) + (size_t)gw * S;
    const int t0 = F.lane * 64;
    float x[64];
#pragma unroll
    for (int i = 0; i < 64; ++i) x[i] = ((const GAS float*)lf)[(size_t)(t0 + i) * 8];
    double tot = 0.0;
#pragma unroll
    for (int i = 0; i < 64; ++i) tot += (double)x[i];
    double inc = tot;
#pragma unroll
    for (int o = 1; o < 64; o <<= 1) { const double n = __shfl_up(inc, o); if (F.lane >= o) inc += n; }
    double run = inc - tot;
#pragma unroll
    for (int i = 0; i < 64; i += 4) { f32x4 o4;
#pragma unroll
        for (int k = 0; k < 4; ++k) { run += (double)x[i + k]; o4[k] = (float)run; }
        *(GAS f32x4*)(cb + t0 + i) = o4; }
}

__device__ __forceinline__ void diff_combine(Frame& F, int l) {
    const int gw = F.vcu * NWAVES + F.wave, NGW = F.G * NWAVES, lane = F.lane;
    const float* lamp = F.in[I_LAM] + l * 256; const float* g = F.in[I_DNG] + l * 128;
    const float lam_init = 0.8f - 0.6f * expf(-0.3f * (float)l);
    const float s1 = wave_sum(lamp[lane] * lamp[64 + lane]), s2 = wave_sum(lamp[128 + lane] * lamp[192 + lane]);
    const float lam = expf(s1) - expf(s2) + lam_init;
    const float g0 = g[2 * lane], g1 = g[2 * lane + 1];
    const GAS unsigned* od = (const GAS unsigned*)(F.ws + WS_OD); GAS unsigned* oc = (GAS unsigned*)(F.ws + WS_ODC);
    unsigned an[4], bn[4];
#pragma unroll
    for (int h = 0; h < 4; ++h) { an[h] = 0u; bn[h] = 0u; }
    if (gw < T) {
#pragma unroll
        for (int h = 0; h < 4; ++h) { an[h] = od[(size_t)gw * 512 + h * 128 + lane]; bn[h] = od[(size_t)gw * 512 + h * 128 + 64 + lane]; }
    }
    for (int t = gw; t < T; t += NGW) {
        unsigned a[4], b[4];
#pragma unroll
        for (int h = 0; h < 4; ++h) { a[h] = an[h]; b[h] = bn[h]; }
        { const int tn = t + NGW; if (tn < T) {
#pragma unroll
            for (int h = 0; h < 4; ++h) { an[h] = od[(size_t)tn * 512 + h * 128 + lane]; bn[h] = od[(size_t)tn * 512 + h * 128 + 64 + lane]; } } }
        float v0[4], v1[4], ss[4];
#pragma unroll
        for (int h = 0; h < 4; ++h) { v0[h] = bflo(a[h]) - lam * bflo(b[h]); v1[h] = bfhi(a[h]) - lam * bfhi(b[h]); ss[h] = v0[h] * v0[h] + v1[h] * v1[h]; }
#pragma unroll
        for (int o = 1; o < 64; o <<= 1) {
#pragma unroll
            for (int h = 0; h < 4; ++h) ss[h] += __shfl_xor(ss[h], o); }
#pragma unroll
        for (int h = 0; h < 4; ++h) { const float r = (1.f / sqrtf(ss[h] * (1.f / 128.f) + LN_EPS)) * (1.f - lam_init);
            oc[(size_t)t * 256 + h * 64 + lane] = pk2(v0[h] * r * g0, v1[h] * r * g1); }
    }
}

typedef float f32x16r __attribute__((ext_vector_type(16)));
__device__ __forceinline__ void p8_ln1_router(Frame& F, int l) {
    const int lane = F.lane, wid = F.wave, tid = F.tid;
    const int m0 = (int)blockIdx.x * 128;
    LAS float* part = (LAS float*)(F.lds + RING_OFF);
    LAS float* affl = (LAS float*)(F.lds + RING_OFF + 16384);
    LAS int* cnt = (LAS int*)(F.lds + TAB_OFF);
    if (tid < NE) cnt[tid] = 0;
    const float* g1 = F.in[I_LN1G] + l * D; const float* b1 = F.in[I_LN1B] + l * D;
    {
        LnGB P; ln_load_gb(P, g1, b1, lane);
        v2u bA[4], bB[4];
        const int r0 = m0 + wid * 16;
        const bf16* S1 = (const bf16*)(F.ws + WS_S1);
#define P8_LOAD(B_, m_) do { _Pragma("unroll") for (int j = 0; j < 4; ++j) B_[j] = *((const GAS v2u*)(S1 + (size_t)(m_) * D) + 64 * j + lane); __builtin_amdgcn_sched_barrier(0); } while (0)
#define P8_PROC(B_, m_) do { f32x4 v[4]; _Pragma("unroll") for (int j = 0; j < 4; ++j) v[j] = (f32x4){bflo(B_[j].x), bfhi(B_[j].x), bflo(B_[j].y), bfhi(B_[j].y)}; \
            ln_row(v, P); store_row(v, (float*)nullptr, (bf16*)(F.ws + WS_XN) + (size_t)(m_) * D, lane); __builtin_amdgcn_sched_barrier(0); } while (0)
        P8_LOAD(bA, r0);
#pragma unroll 1
        for (int rr = 0; rr < 16; rr += 2) { P8_LOAD(bB, r0 + rr + 1); P8_PROC(bA, r0 + rr); P8_LOAD(bA, r0 + (rr + 2 < 16 ? rr + 2 : 15)); P8_PROC(bB, r0 + rr + 1); }
#undef P8_LOAD
#undef P8_PROC
    }
    VM_WAIT(); __syncthreads();
    {
        const int t = wid & 3, kh = wid >> 2, i32 = lane & 31, kk = lane >> 5;
        const bf16* xrow = (const bf16*)(F.ws + WS_XN) + (size_t)(m0 + 32 * t + i32) * D + 512 * kh + 4 * kk;
        const float* wr = F.in[I_WR] + (size_t)(512 * kh + 4 * kk) * NE + i32;
        f32x16r acc = {};
        const GAS float* wrg = (const GAS float*)wr;
        v2u xA[4], xB[4]; float wA[16], wB[16];
#define RT_LOAD(X_, W_, grp_) do { const int c0_ = 4 * (grp_); _Pragma("unroll") for (int q = 0; q < 4; ++q) { X_[q] = *(const GAS v2u*)(xrow + 8 * (c0_ + q)); \
            _Pragma("unroll") for (int e = 0; e < 4; ++e) W_[4 * q + e] = wrg[(8 * (c0_ + q) + e) * NE]; } __builtin_amdgcn_sched_barrier(0); } while (0)
#define RT_MMA(X_, W_) do { _Pragma("unroll") for (int q = 0; q < 4; ++q) { const f32x4 a4 = {bflo(X_[q].x), bfhi(X_[q].x), bflo(X_[q].y), bfhi(X_[q].y)}; \
            _Pragma("unroll") for (int e = 0; e < 4; ++e) acc = __builtin_amdgcn_mfma_f32_32x32x2f32(a4[e], W_[4 * q + e], acc, 0, 0, 0); } __builtin_amdgcn_sched_barrier(0); } while (0)
        RT_LOAD(xA, wA, 0);
#pragma unroll 1
        for (int it = 0; it < 8; ++it) {
            RT_LOAD(xB, wB, 2 * it + 1); RT_MMA(xA, wA);
            RT_LOAD(xA, wA, (it < 7 ? 2 * it + 2 : 15)); RT_MMA(xB, wB);
        }
#undef RT_LOAD
#undef RT_MMA
        if (kh == 1) {
#pragma unroll
            for (int r = 0; r < 16; ++r) part[(t * 16 + r) * 64 + lane] = acc[r];
        }
        __syncthreads();
        if (kh == 0) {
#pragma unroll
            for (int r = 0; r < 16; ++r) { const float a = acc[r] + part[(t * 16 + r) * 64 + lane]; const int row = 32 * t + (r & 3) + 8 * (r >> 2) + 4 * kk;
                affl[row * 33 + i32] = 1.f / (1.f + expf(-a)); }
        }
        __syncthreads();
    }
    if (tid < 128) {
        const float* br = F.in[I_BR];
        const LAS float* af = affl + tid * 33;
        int gbest = 0; float gs = -INFINITY;
#pragma unroll
        for (int g = 0; g < 4; ++g) {
            float m1 = -INFINITY, m2 = -INFINITY;
#pragma unroll
            for (int i = 0; i < 8; ++i) { const float x = af[g * 8 + i] + br[g * 8 + i]; if (x > m1) { m2 = m1; m1 = x; } else if (x > m2) m2 = x; }
            const float sc = m1 + m2;
            if (sc > gs) { gs = sc; gbest = g; }
        }
        int i1 = 0, i2 = 0; float m1 = -INFINITY, m2 = -INFINITY, a1 = 0.f, a2 = 0.f;
        const f32x4 bsel0 = *(const GAS f32x4*)(br + gbest * 8), bsel1 = *(const GAS f32x4*)(br + gbest * 8 + 4);
#pragma unroll
        for (int i = 0; i < 8; ++i) { const float afv = af[gbest * 8 + i], x = afv + (i < 4 ? bsel0[i & 3] : bsel1[i & 3]);
            if (x > m1) { m2 = m1; i2 = i1; a2 = a1; m1 = x; i1 = i; a1 = afv; } else if (x > m2) { m2 = x; i2 = i; a2 = afv; } }
        const int e1 = gbest * 8 + i1, e2 = gbest * 8 + i2; const float sum = a1 + a2; const int m = m0 + tid;
        int* eidx = (int*)(F.ws + WS_EIDX); float* wts = (float*)(F.ws + WS_WTS);
        eidx[m * 2] = e1; eidx[m * 2 + 1] = e2; wts[m * 2] = a1 / sum; wts[m * 2 + 1] = a2 / sum;
        __hip_atomic_fetch_add(&cnt[e1], 1, __ATOMIC_RELAXED, __HIP_MEMORY_SCOPE_WORKGROUP); __hip_atomic_fetch_add(&cnt[e2], 1, __ATOMIC_RELAXED, __HIP_MEMORY_SCOPE_WORKGROUP);
    }
    __syncthreads();
    if (tid < NE) ((int*)(F.ws + WS_HIST))[blockIdx.x * NE + tid] = cnt[tid];
    int* row_tok = (int*)(F.ws + WS_ROWTOK);
    for (int i = tid; i < RPAD / 256; i += NWAVES * 64) row_tok[blockIdx.x * (RPAD / 256) + i] = 0;
    __syncthreads();
    const int gw = F.vcu * NWAVES + F.wave, NGW = F.G * NWAVES;
    convert_expert_weights(F, l, gw, NGW);
#ifdef PROBE_CONV2
    convert_expert_weights(F, l, gw, NGW);
#endif
    if (l + 1 < DEPTH) convert_layer_weights(F, l + 1, gw, NGW);
}

__device__ __forceinline__ void p9_placement(Frame& F) {
    LAS int* tot = (LAS int*)(F.lds + RING_OFF); LAS int* before = tot + 32; LAS int* start = tot + 64; LAS int* earr = tot + 128;
    const int* hist = (const int*)(F.ws + WS_HIST);
    const int blk = blockIdx.x;
    {
        LAS int* ptot = tot + 512; LAS int* pbef = tot + 1024;
        const int e = F.tid & 31, part = F.tid >> 5; int t = 0, bfr = 0;
#pragma unroll
        for (int i = 0; i < 16; ++i) { const int b = part * 16 + i; const int c = __hip_atomic_load(hist + b * NE + e, RLX_AGENT); t += c; bfr += (b < blk) ? c : 0; }
        ptot[part * 32 + e] = t; pbef[part * 32 + e] = bfr;
        __syncthreads();
        if (F.tid < NE) { int ts = 0, bs = 0;
#pragma unroll
            for (int p = 0; p < 16; ++p) { ts += ptot[p * 32 + F.tid]; bs += pbef[p * 32 + F.tid]; }
            tot[F.tid] = ts; before[F.tid] = bs; }
    }
    __syncthreads();
    if (F.tid == 0) { int run = 0; for (int e = 0; e < NE; ++e) { start[e] = run; run += (tot[e] + 255) & ~255; } start[NE] = run; }
    __syncthreads();
    const int* eidx = (const int*)(F.ws + WS_EIDX);
    int e = 0;
    if (F.tid < 256) { e = eidx[blk * 256 + F.tid]; earr[F.tid] = e; }
    __syncthreads();
    if (F.tid < 256) {
        int rank = 0;
        for (int a = 0; a < 256; ++a) rank += (a < F.tid && earr[a] == e) ? 1 : 0;
        const int p = start[e] + before[e] + rank;
        ((int*)(F.ws + WS_ROWTOK))[p] = blk * 128 + (F.tid >> 1);
        ((int*)(F.ws + WS_POS))[blk * 256 + F.tid] = p;
    }
    if (blk == 0) {
        int* tile_e = (int*)(F.ws + WS_TILEE);
        if (F.tid < NE) { const int t0 = start[F.tid] >> 8, t1 = start[F.tid + 1] >> 8; for (int t = t0; t < t1; ++t) tile_e[t] = F.tid; }
        if (F.tid == 0) tile_e[NRT_MAX] = start[NE] >> 8;
    }
    __syncthreads();
}

__device__ __forceinline__ void p12_combine_ln2(Frame& F, int l, bool dry = false) {
    const int gw = F.vcu * NWAVES + F.wave, NGW = F.G * NWAVES, lane = F.lane;
    const float* g2 = F.in[I_LN2G] + l * D; const float* b2 = F.in[I_LN2B] + l * D;
    const int* pos = (const int*)(F.ws + WS_POS); const float* wts = (const float*)(F.ws + WS_WTS);
    const bf16* yr = (const bf16*)(F.ws + WS_YR);
    LnGB P; ln_load_gb(P, g2, b2, lane);
    const GAS int* posg = (const GAS int*)pos; const GAS float* wtsg = (const GAS float*)wts; const bf16* xn = (const bf16*)(F.ws + WS_XN);
    v2u hA[4], aA[4], bA[4], hB[4], aB[4], bB[4]; float wA0, wA1, wB0, wB1, wN0, wN1; int pN0, pN1;
#define P12_POS(m_) do { const int mm_ = (m_) < T ? (m_) : T - 1; pN0 = posg[mm_ * 2]; pN1 = posg[mm_ * 2 + 1]; wN0 = wtsg[mm_ * 2]; wN1 = wtsg[mm_ * 2 + 1]; } while (0)
#define P12_LOAD(H_, A_, B_, W0_, W1_, m_) do { const int mm_ = (m_) < T ? (m_) : T - 1; W0_ = wN0; W1_ = wN1; _Pragma("unroll") for (int j = 0; j < 4; ++j) { H_[j] = *((const GAS v2u*)(xn + (size_t)mm_ * D) + 64 * j + lane); \
        A_[j] = *((const GAS v2u*)(yr + (size_t)pN0 * D) + 64 * j + lane); B_[j] = *((const GAS v2u*)(yr + (size_t)pN1 * D) + 64 * j + lane); } } while (0)
#define P12_PROC(H_, A_, B_, W0_, W1_, m_) do { if ((m_) < T) { f32x4 v[4]; _Pragma("unroll") for (int j = 0; j < 4; ++j) { \
            v[j].x = ALPHA * bflo(H_[j].x) + (W0_ * bflo(A_[j].x) + W1_ * bflo(B_[j].x)); v[j].y = ALPHA * bfhi(H_[j].x) + (W0_ * bfhi(A_[j].x) + W1_ * bfhi(B_[j].x)); \
            v[j].z = ALPHA * bflo(H_[j].y) + (W0_ * bflo(A_[j].y) + W1_ * bflo(B_[j].y)); v[j].w = ALPHA * bfhi(H_[j].y) + (W0_ * bfhi(A_[j].y) + W1_ * bfhi(B_[j].y)); } \
        ln_row(v, P); \
        store_row(v, (dry || l + 1 < DEPTH) ? (float*)nullptr : F.out + (size_t)(m_) * D, (l + 1 < DEPTH && !dry) ? (bf16*)(F.ws + WS_XN) + (size_t)(m_) * D : (bf16*)nullptr, lane); } __builtin_amdgcn_sched_barrier(0); } while (0)
    P12_POS(gw); P12_LOAD(hA, aA, bA, wA0, wA1, gw); P12_POS(gw + NGW); __builtin_amdgcn_sched_barrier(0);
    for (int m = gw; m < T; m += 2 * NGW) {
        P12_LOAD(hB, aB, bB, wB0, wB1, m + NGW); P12_POS(m + 2 * NGW); __builtin_amdgcn_sched_barrier(0);
        P12_PROC(hA, aA, bA, wA0, wA1, m);
        P12_LOAD(hA, aA, bA, wA0, wA1, m + 2 * NGW); P12_POS(m + 3 * NGW); __builtin_amdgcn_sched_barrier(0);
        P12_PROC(hB, aB, bB, wB0, wB1, m + NGW);
    }
#undef P12_POS
#undef P12_LOAD
#undef P12_PROC
}
using pg8::Unit;
struct SchedGrid {
    int nM, nN, G, c;
    __device__ __forceinline__ bool next(int i, Unit& u) const { const int L = i * G + c; if (L >= nM * nN) return false; pg8::map_unit(L, nM, nN, u.pm, u.pn); u.aux = 0; return true; }
};
struct SchedU {
    int G, c;
    __device__ __forceinline__ bool next(int i, Unit& u) const { const int L = i * G + c; if (L >= 3 * 512) return false; u.aux = L >> 9; pg8::map_unit(L & 511, 128, 4, u.pm, u.pn); return true; }
};
struct SchedY {
    int G, c;
    __device__ __forceinline__ bool next(int i, Unit& u) const { const int slot = i / 3, br = i - 3 * slot; const int L = slot * G + c; if (L >= 512) return false; pg8::map_unit(L, 128, 4, u.pm, u.pn); u.aux = br; return true; }
};
struct SchedMoe {
    const LAS int* tabe; int ntiles, G, c;
    __device__ __forceinline__ void a_ready(const Unit&, int, int) const {}
    __device__ __forceinline__ bool unit(int i, Unit& u) const { const int L = i * G + c; if (L >= ntiles * 4) return false; pg8::map_unit(L, ntiles, 4, u.pm, u.pn); return true; }
    __device__ __forceinline__ bool next(int i, Unit& u) const { if (!unit(i, u)) return false; u.aux = __builtin_amdgcn_readfirstlane(tabe[i]); return true; }
};

struct GPlain {
    static constexpr bool GATHER = false;
    const char* a_base; const char* b_base; int K, lda;
    __device__ __forceinline__ const char* a_ptr(const Unit& u) const { return a_base + (size_t)u.pm * 256 * lda * 2; }
    __device__ __forceinline__ const char* b_ptr(const Unit& u) const { return b_base + (size_t)u.pn * 256 * K * 2; }
};
struct GBranch {
    static constexpr bool GATHER = false;
    const char* a_base; const char* b_base; int K, lda;
    __device__ __forceinline__ const char* a_ptr(const Unit& u) const {
        const size_t base = u.aux == 0 ? WS_ODC : u.aux == 1 ? WS_OS : WS_OF;
        return a_base + base + (size_t)u.pm * 256 * 512 * 2;
    }
    __device__ __forceinline__ const char* b_ptr(const Unit& u) const { return b_base + ((size_t)u.aux * 1024 + (size_t)u.pn * 256) * 512 * 2; }
};
struct GGate {
    static constexpr bool GATHER = false;
    const char* a_base; const char* b_base; int K, lda;
    __device__ __forceinline__ const char* a_ptr(const Unit& u) const { return a_base + (size_t)u.pm * 256 * 1024 * 2; }
    __device__ __forceinline__ const char* b_ptr(const Unit& u) const { return b_base + ((size_t)NPROJ + (size_t)u.aux * 1024 + (size_t)u.pn * 256) * 1024 * 2; }
};
struct GMoe1 {
    static constexpr bool GATHER = true;
    const char* a_base; const char* b_base; int K; const LAS int* tab;
    __device__ __forceinline__ unsigned a_off(const Unit&, int ui, int half, int R, int C) const { return (unsigned)tab[ui * 256 + half * 128 + R] * 2048u + (unsigned)C * 2u; }
    __device__ __forceinline__ const char* b_ptr(const Unit& u) const { return b_base + ((size_t)u.aux * 1024 + (size_t)u.pn * 256) * 1024 * 2; }
};
struct GMoe2 {
    static constexpr bool GATHER = false;
    const char* a_base; const char* b_base; int K, lda;
    __device__ __forceinline__ const char* a_ptr(const Unit& u) const { return a_base + (size_t)u.pm * 256 * 512 * 2; }
    __device__ __forceinline__ const char* b_ptr(const Unit& u) const { return b_base + ((size_t)u.aux * 1024 + (size_t)u.pn * 256) * 512 * 2; }
};

typedef const f32x4 (&AccRef)[2][2][4][2];
__device__ __forceinline__ v4u pack8(f32x4 a, f32x4 b) { v4u w; w.x = cvt_pk_bf16(a[0], a[1]); w.y = cvt_pk_bf16(a[2], a[3]); w.z = cvt_pk_bf16(b[0], b[1]); w.w = cvt_pk_bf16(b[2], b[3]); return w; }
__device__ __forceinline__ void rope8(f32x4& a, f32x4& b, const float* cs, const float* sn) {
    const f32x4 c = *(const GAS f32x4*)cs, s = *(const GAS f32x4*)sn;
    const f32x4 a2 = {a[0] * c[0] - a[1] * s[0], a[1] * c[0] + a[0] * s[0], a[2] * c[1] - a[3] * s[1], a[3] * c[1] + a[2] * s[1]};
    const f32x4 b2 = {b[0] * c[2] - b[1] * s[2], b[1] * c[2] + b[0] * s[2], b[2] * c[3] - b[3] * s[3], b[3] * c[3] + b[2] * s[3]};
    a = a2; b = b2;
}
#ifndef PROBE_EPIVAR
#define PROBE_EPIVAR 0
#endif
template <int VAR>
struct EpiProjT {
    unsigned char* ws; const float* bforget;
    __device__ __forceinline__ void operator()(AccRef acc, const Unit& u, int wr, int wc, int fr, int fq) const { asm volatile("" : "+v"(fr), "+v"(fq));
        const float* cs = (const float*)(ws + WS_CS); const float* sn = (const float*)(ws + WS_SN);
        const int pn = u.pn, row0 = u.pm * 256 + wr * 64 + fr, cw = wc * 32 + 8 * fq;
        if (pn < 19) {
            const int grp = pn >> 1;
            const bool rope = (VAR & 1) ? false : ((grp == 0) | (grp == 1) | (grp == 3) | (grp == 4) | (pn == 18));
            const float sc = ((grp == 0) | (grp == 3) | (grp == 6)) ? C2 : 1.f;
            bf16* base = pn < 18 ? (bf16*)(ws + WS_Z + (size_t)grp * ZG) + (pn & 1) * 256 : (bf16*)(ws + WS_IQ);
            const int pitch = pn < 18 ? 512 : 256;
            if (rope) { const int i0 = (cw & 63) >> 1;
                f32x4 cB[8], sB[8];
#pragma unroll
                for (int g = 0; g < 8; ++g) { const size_t ro_ = (size_t)(row0 + (g >> 2) * 128 + (g & 3) * 16) * 32 + i0; if (VAR & 4) { const float f_ = (float)(ro_ & 1023) * 0.001f; cB[g] = (f32x4){f_, f_ + 1.f, f_ + 2.f, f_ + 3.f}; sB[g] = (f32x4){f_ + 4.f, f_ + 5.f, f_ + 6.f, f_ + 7.f}; } else { cB[g] = *(const GAS f32x4*)(cs + ro_); sB[g] = *(const GAS f32x4*)(sn + ro_); } }
#pragma unroll
                for (int g = 0; g < 8; ++g) { const int ai = g >> 2, m = g & 3; const int row = row0 + ai * 128 + m * 16; const f32x4 c = cB[g] * sc, s = sB[g] * sc;
#pragma unroll
                    for (int bj = 0; bj < 2; ++bj) { const int col = bj * 128 + cw; const f32x4 v0 = acc[ai][bj][m][0], v1 = acc[ai][bj][m][1];
                        const f32x4 a2 = {v0[0] * c[0] - v0[1] * s[0], v0[1] * c[0] + v0[0] * s[0], v0[2] * c[1] - v0[3] * s[1], v0[3] * c[1] + v0[2] * s[1]};
                        const f32x4 b2 = {v1[0] * c[2] - v1[1] * s[2], v1[1] * c[2] + v1[0] * s[2], v1[2] * c[3] - v1[3] * s[3], v1[3] * c[3] + v1[2] * s[3]};
                        *(GAS v4u*)(base + (size_t)row * pitch + col) = pack8(a2, b2); } }
            } else {
#pragma unroll
                for (int g = 0; g < 8; ++g) { const int ai = g >> 2, m = g & 3; const int row = row0 + ai * 128 + m * 16;
#pragma unroll
                    for (int bj = 0; bj < 2; ++bj) { const int col = bj * 128 + cw;
                        *(GAS v4u*)(base + (size_t)row * pitch + col) = pack8(acc[ai][bj][m][0] * sc, acc[ai][bj][m][1] * sc); } }
            }
        } else if (!(VAR & 2)) {
            bf16* ik = (bf16*)(ws + WS_IK); float* iw = (float*)(ws + WS_IW); float* lf = (float*)(ws + WS_LF);
            if (cw < 64) { const int i0 = cw >> 1, g_ = cw >> 3; f32x4 cB[8], sB[8];
#pragma unroll
                for (int g = 0; g < 8; ++g) { const size_t ro_ = (size_t)(row0 + (g >> 2) * 128 + (g & 3) * 16) * 32 + i0; cB[g] = *(const GAS f32x4*)(cs + ro_); sB[g] = *(const GAS f32x4*)(sn + ro_); }
#pragma unroll
                for (int g = 0; g < 8; ++g) { const int ai = g >> 2, m = g & 3; const int row = row0 + ai * 128 + m * 16, kk_ = row & 63; const f32x4 c = cB[g], s = sB[g];
                    const f32x4 v0 = acc[ai][0][m][0], v1 = acc[ai][0][m][1];
                    const f32x4 a2 = {v0[0] * c[0] - v0[1] * s[0], v0[1] * c[0] + v0[0] * s[0], v0[2] * c[1] - v0[3] * s[1], v0[3] * c[1] + v0[2] * s[1]};
                    const f32x4 b2 = {v1[0] * c[2] - v1[1] * s[2], v1[1] * c[2] + v1[0] * s[2], v1[2] * c[3] - v1[3] * s[3], v1[3] * c[3] + v1[2] * s[3]};
                    *(GAS v4u*)(ik + (size_t)(row >> 6) * 4096 + (size_t)((((kk_ >> 5) * 4 + (g_ >> 1)) * 64 + (g_ & 1) * 32 + (kk_ & 31)) * 8)) = pack8(a2, b2); }
            } else {
#pragma unroll
            for (int ai = 0; ai < 2; ++ai)
#pragma unroll
                for (int m = 0; m < 4; ++m) { const int row = row0 + ai * 128 + m * 16;
                    const f32x4 v0 = acc[ai][0][m][0], v1 = acc[ai][0][m][1];
                    if (cw == 64) { *(GAS f32x4*)(iw + (size_t)row * 4) = v0 * 0.0625f;
                        f32x4 o;
#pragma unroll
                        for (int j = 0; j < 4; ++j) { const float x = v1[j] + bforget[j]; o[j] = LOG2E * fminf(x, 0.f) - __builtin_amdgcn_logf(1.f + __builtin_amdgcn_exp2f(-LOG2E * fabsf(x))); }
                        *(GAS f32x4*)(lf + (size_t)row * 8) = o; }
                    else if (cw == 72) { f32x4 o;
#pragma unroll
                        for (int j = 0; j < 4; ++j) { const float x = v0[j] + bforget[4 + j]; o[j] = LOG2E * fminf(x, 0.f) - __builtin_amdgcn_logf(1.f + __builtin_amdgcn_exp2f(-LOG2E * fabsf(x))); }
                        *(GAS f32x4*)(lf + (size_t)row * 8 + 4) = o; } }
            }
        }
    }
};
typedef EpiProjT<0> EpiProj;
struct EpiPlain {
    bf16* O; int ldc, aux_cols;
    __device__ __forceinline__ void operator()(AccRef acc, const Unit& u, int wr, int wc, int fr, int fq) const { asm volatile("" : "+v"(fr), "+v"(fq));
        const int row0 = u.pm * 256 + wr * 64 + fr, col0 = u.aux * aux_cols + u.pn * 256 + wc * 32 + 8 * fq;
#pragma unroll
        for (int ai = 0; ai < 2; ++ai)
#pragma unroll
            for (int m = 0; m < 4; ++m) { bf16* rowp = O + (size_t)(row0 + ai * 128 + m * 16) * ldc + col0;
#pragma unroll
                for (int bj = 0; bj < 2; ++bj) *(GAS v4u*)(rowp + bj * 128) = pack8(acc[ai][bj][m][0], acc[ai][bj][m][1]); }
    }
};
struct EpiGate {
    const bf16* U; bf16* Y;
    __device__ __forceinline__ void operator()(AccRef acc, const Unit& u, int wr, int wc, int fr, int fq) const { asm volatile("" : "+v"(fr), "+v"(fq));
        const int row0 = u.pm * 256 + wr * 64 + fr, col0 = u.pn * 256 + wc * 32 + 8 * fq;
        const bool acc_y = u.aux != 0;
        v4u uB[3][2], yB[3][2];
#define EG_LOAD(g_, s_) do { const size_t rw_ = (size_t)(row0 + ((g_) >> 2) * 128 + ((g_) & 3) * 16); _Pragma("unroll") for (int bj = 0; bj < 2; ++bj) { const int col = col0 + bj * 128; \
            uB[s_][bj] = *(const GAS v4u*)(U + rw_ * 3072 + u.aux * 1024 + col); yB[s_][bj] = acc_y ? *(const GAS v4u*)(Y + rw_ * 1024 + col) : (v4u){0u, 0u, 0u, 0u}; } } while (0)
        EG_LOAD(0, 0); EG_LOAD(1, 1);
#pragma unroll
        for (int g = 0; g < 8; ++g) { const int ai = g >> 2, m = g & 3; const size_t row = (size_t)(row0 + ai * 128 + m * 16);
            if (g + 2 < 8) EG_LOAD(g + 2, (g + 2) % 3);
#pragma unroll
            for (int bj = 0; bj < 2; ++bj) { const int col = col0 + bj * 128;
                const v4u uu = uB[g % 3][bj], yy = yB[g % 3][bj];
                f32x4 a = acc[ai][bj][m][0], b = acc[ai][bj][m][1];
#pragma unroll
                for (int j = 0; j < 4; ++j) { a[j] = sigmoidf_(a[j]); b[j] = sigmoidf_(b[j]); }
                a[0] *= bflo(uu.x); a[1] *= bfhi(uu.x); a[2] *= bflo(uu.y); a[3] *= bfhi(uu.y);
                b[0] *= bflo(uu.z); b[1] *= bfhi(uu.z); b[2] *= bflo(uu.w); b[3] *= bfhi(uu.w);
                a[0] += bflo(yy.x); a[1] += bfhi(yy.x); a[2] += bflo(yy.y); a[3] += bfhi(yy.y);
                b[0] += bflo(yy.z); b[1] += bfhi(yy.z); b[2] += bflo(yy.w); b[3] += bfhi(yy.w);
                *(GAS v4u*)(Y + row * 1024 + col) = pack8(a, b); }
            asm volatile("" ::: "memory"); }
#undef EG_LOAD
    }
};
struct EpiResid {
    bf16* R; const bf16* XNp;
    __device__ __forceinline__ void operator()(AccRef acc, const Unit& u, int wr, int wc, int fr, int fq) const { asm volatile("" : "+v"(fr), "+v"(fq));
        const int row0 = u.pm * 256 + wr * 64 + fr, col0 = u.pn * 256 + wc * 32 + 8 * fq;
        v4u xB[3][2];
#define ER_LOAD(g_, s_) do { const size_t ro_ = (size_t)(row0 + ((g_) >> 2) * 128 + ((g_) & 3) * 16) * D + col0; _Pragma("unroll") for (int bj = 0; bj < 2; ++bj) xB[s_][bj] = *(const GAS v4u*)(XNp + ro_ + bj * 128); } while (0)
        ER_LOAD(0, 0); ER_LOAD(1, 1);
#pragma unroll
        for (int g = 0; g < 8; ++g) { const int ai = g >> 2, m = g & 3; const size_t ro = (size_t)(row0 + ai * 128 + m * 16) * D + col0;
            if (g + 2 < 8) ER_LOAD(g + 2, (g + 2) % 3);
#pragma unroll
            for (int bj = 0; bj < 2; ++bj) { const v4u x = xB[g % 3][bj];
                const f32x4 h0 = {bflo(x.x), bfhi(x.x), bflo(x.y), bfhi(x.y)}, h1 = {bflo(x.z), bfhi(x.z), bflo(x.w), bfhi(x.w)};
                *(GAS v4u*)(R + ro + bj * 128) = pack8(h0 * ALPHA + acc[ai][bj][m][0], h1 * ALPHA + acc[ai][bj][m][1]); }
            asm volatile("" ::: "memory"); }
#undef ER_LOAD
    }
};
struct EpiSwiglu {
    bf16* Hd;
    __device__ __forceinline__ void operator()(AccRef acc, const Unit& u, int wr, int wc, int fr, int fq) const { asm volatile("" : "+v"(fr), "+v"(fq));
        const int row0 = u.pm * 256 + wr * 64 + fr, col0 = u.pn * 128 + wc * 32 + 8 * fq;
#pragma unroll
        for (int ai = 0; ai < 2; ++ai)
#pragma unroll
            for (int m = 0; m < 4; ++m) { f32x4 a = acc[ai][0][m][0], b = acc[ai][0][m][1]; const f32x4 ua = acc[ai][1][m][0], ub = acc[ai][1][m][1];
#pragma unroll
                for (int j = 0; j < 4; ++j) { a[j] = a[j] * sigmoidf_(a[j]) * ua[j]; b[j] = b[j] * sigmoidf_(b[j]) * ub[j]; }
                *(GAS v4u*)(Hd + (size_t)(row0 + ai * 128 + m * 16) * DE + col0) = pack8(a, b); }
    }
};
namespace attn_body {
using bf16=__hip_bfloat16;
typedef unsigned long long u64x8 __attribute__((ext_vector_type(8)));
using bf16x8=__attribute__((ext_vector_type(8)))short;
using s16x4=__attribute__((ext_vector_type(4)))short;
using f32x16=__attribute__((ext_vector_type(16)))float;
using u32x4=__attribute__((ext_vector_type(4)))unsigned;
constexpr int SEQ=4096,D=64,DM=512;
constexpr int NW=8,QBLK=32,QB=QBLK*NW,KVBLK=64,NQB=SEQ/QB;
constexpr int ATTN_PITCH=DM, ATTN_UNIT_ROWS=QB;
__device__ __forceinline__ int crow(int r,int hi){return (r&3)+8*(r>>2)+4*hi;}
#define SBAR() __builtin_amdgcn_sched_barrier(0)
__device__ __forceinline__ void cmask(f32x16&p0,f32x16&p1,int jb,int qrel,int hi){
  const float NEG=-INFINITY; int kb=64*jb+4*hi;
  #pragma unroll
  for(int r=0;r<16;++r){int kv=kb+(r&3)+8*(r>>2); if(kv>qrel)p0[r]=NEG; if(kv+32>qrel)p1[r]=NEG;}
}

__device__ __forceinline__ void chunkmask(f32x16&p0,f32x16&p1,int jb,int wid){
  if(jb>(wid>>1)){ const float NEG=-INFINITY;
    #pragma unroll
    for(int r=0;r<16;++r){p0[r]=NEG;p1[r]=NEG;} }
}
constexpr int NSLOT=3, SLOTB=8192;
constexpr int LDS_K=0, LDS_V=NSLOT*SLOTB, LDS_WS=3*NSLOT*SLOTB, LDS_OST=LDS_WS+NW*64*4, LDS_CBT=LDS_OST+NW*4096, LDS_BYTES=LDS_CBT+16384;
constexpr float C2=0.125f*1.4426950408889634f;
__device__ __forceinline__ void glds16(const void*gsrc,unsigned lds_dst){unsigned keep;
  asm volatile("s_mov_b32 %0, m0\n\ts_mov_b32 m0, %2\n\ts_nop 0\n\tglobal_load_lds_dwordx4 %1, off\n\ts_mov_b32 m0, %0":"=&s"(keep):"v"(gsrc),"s"(lds_dst):"memory");}
__device__ __forceinline__ float max3f(float a,float b,float c){float r;asm("v_max3_f32 %0, %1, %2, %3":"=v"(r):"v"(a),"v"(b),"v"(c));return r;}
__device__ __forceinline__ float max2f(float a,float b){float r;asm("v_max_f32_e32 %0, %1, %2":"=v"(r):"v"(a),"v"(b));return r;}
__device__ __forceinline__ float fadd_s(float a,float b){float r;asm("v_add_f32_e32 %0, %1, %2":"=v"(r):"v"(a),"v"(b));return r;}
__device__ __forceinline__ float fsub_s(float a,float b){float r;asm("v_sub_f32_e32 %0, %1, %2":"=v"(r):"v"(a),"v"(b));return r;}
typedef float f32x2_t __attribute__((ext_vector_type(2))); typedef float f32x4_t __attribute__((ext_vector_type(4))); typedef __bf16 bf16x2_t __attribute__((ext_vector_type(2)));
__device__ __forceinline__ unsigned cvtpk_s(float lo,float hi){f32x2_t v={lo,hi};bf16x2_t b=__builtin_convertvector(v,bf16x2_t);return __builtin_bit_cast(unsigned,b);}
#define WAIT_BAR(N) asm volatile("s_waitcnt vmcnt(" #N ") lgkmcnt(0)\n\ts_barrier":::"memory")
#define WAIT_BAR2(N,N2) do{ if(DV2){WAIT_BAR(N2);}else{WAIT_BAR(N);} }while(0)

__device__ __forceinline__ void qkt(f32x16&p0,f32x16&p1,const char*Kslot,const bf16x8*qr,int r32,int hi){ const f32x16 negm=f32x16{};
  const char*kb=Kslot+hi*1024+r32*16;
  #pragma unroll
  for(int d0=0;d0<4;++d0){
    const bf16x8 b0=*reinterpret_cast<const bf16x8*>(kb+d0*2048);
    const bf16x8 b1=*reinterpret_cast<const bf16x8*>(kb+d0*2048+512);
    if(d0==0){p0=__builtin_amdgcn_mfma_f32_32x32x16_bf16(b0,qr[0],negm,0,0,0);p1=__builtin_amdgcn_mfma_f32_32x32x16_bf16(b1,qr[0],negm,0,0,0);}
    else{p0=__builtin_amdgcn_mfma_f32_32x32x16_bf16(b0,qr[d0],p0,0,0,0);p1=__builtin_amdgcn_mfma_f32_32x32x16_bf16(b1,qr[d0],p1,0,0,0);}}
}
typedef __attribute__((address_space(3))) const char* lds_cptr;
typedef short v4i16_t __attribute__((ext_vector_type(4)));
__device__ __forceinline__ void kload8(bf16x8*kf,lds_cptr kp){
  kf[0]=*(const __attribute__((address_space(3))) bf16x8*)(kp);      kf[1]=*(const __attribute__((address_space(3))) bf16x8*)(kp+512);
  kf[2]=*(const __attribute__((address_space(3))) bf16x8*)(kp+2048); kf[3]=*(const __attribute__((address_space(3))) bf16x8*)(kp+2560);
  kf[4]=*(const __attribute__((address_space(3))) bf16x8*)(kp+4096); kf[5]=*(const __attribute__((address_space(3))) bf16x8*)(kp+4608);
  kf[6]=*(const __attribute__((address_space(3))) bf16x8*)(kp+6144); kf[7]=*(const __attribute__((address_space(3))) bf16x8*)(kp+6656);
}
__device__ __forceinline__ void kload2(bf16x8*kf,lds_cptr kp,int j){ kf[2*j]=*(const __attribute__((address_space(3))) bf16x8*)(kp+j*2048); kf[2*j+1]=*(const __attribute__((address_space(3))) bf16x8*)(kp+j*2048+512); }
__device__ __forceinline__ s16x4 vtr(lds_cptr p){ return __builtin_bit_cast(s16x4,__builtin_amdgcn_ds_read_tr16_b64_v4i16((__attribute__((address_space(3))) v4i16_t*)p)); }
__device__ __forceinline__ float rowmax(const f32x16&p0,const f32x16&p1){
  float a=max3f(p0[0],p0[1],p1[0]),b=max3f(p0[2],p0[3],p1[1]);a=max3f(a,p1[2],p1[3]);
  #pragma unroll
  for(int r=4;r<16;r+=4){a=max3f(a,p0[r],p0[r+1]);b=max3f(b,p0[r+2],p0[r+3]);a=max3f(a,p1[r],p1[r+1]);b=max3f(b,p1[r+2],p1[r+3]);}
  const float m=max2f(a,b);
  auto rr=__builtin_amdgcn_permlane32_swap(__float_as_uint(m),__float_as_uint(m),false,false);
  return max2f(__uint_as_float(rr[0]),__uint_as_float(rr[1]));
}
__device__ __forceinline__ void pv(f32x16*o,int vb,bf16x8 pa0,bf16x8 pa1,bf16x8 pa2,bf16x8 pa3){
  #pragma unroll
  for(int d0=0;d0<2;++d0){s16x4 lo[4],hi[4];
    #pragma unroll
    for(int ks=0;ks<4;++ks){
      asm volatile("ds_read_b64_tr_b16 %0,%1 offset:%c2":"=&v"(lo[ks]):"v"(vb),"i"(d0*4096+ks*1024):"memory");
      asm volatile("ds_read_b64_tr_b16 %0,%1 offset:%c2":"=&v"(hi[ks]):"v"(vb),"i"(d0*4096+ks*1024+512):"memory");}
    asm volatile("s_waitcnt lgkmcnt(0)":::"memory");SBAR();
    #define PK(k) (bf16x8){lo[k][0],lo[k][1],lo[k][2],lo[k][3],hi[k][0],hi[k][1],hi[k][2],hi[k][3]}
    o[d0]=__builtin_amdgcn_mfma_f32_32x32x16_bf16(pa0,PK(0),o[d0],0,0,0);
    o[d0]=__builtin_amdgcn_mfma_f32_32x32x16_bf16(pa1,PK(1),o[d0],0,0,0);
    o[d0]=__builtin_amdgcn_mfma_f32_32x32x16_bf16(pa2,PK(2),o[d0],0,0,0);
    o[d0]=__builtin_amdgcn_mfma_f32_32x32x16_bf16(pa3,PK(3),o[d0],0,0,0);
    #undef PK
  }
}

#ifndef ATTN_STORE16
#define ATTN_STORE16(p,v) (*(GAS u32x4*)(p)=(v))
#endif
template<int THRL,int MODE,int PO> __device__ __forceinline__ void attn_unit(int b,int qb,const bf16*Q,const bf16*K,const bf16*V,bf16*O,char*shm,const unsigned long long*masks,int tid){
  constexpr bool DV2=(MODE==0);
  asm volatile("":"+v"(tid));
  const int lane=tid&63,r32=lane&31,hi=lane>>5; const int wid=__builtin_amdgcn_readfirstlane(tid>>6);
  const long rowbase=(long)b*SEQ; const int q0=qb*QB;
  const bf16*Qw=Q+(rowbase+q0+wid*QBLK)*DM;
  const bf16*Kh=K+rowbase*DM,*Vh=V+rowbase*DM;
  const unsigned lds0=(unsigned)(uintptr_t)shm;
  float*wsf=(float*)(shm+LDS_WS)+wid*64;
  const bf16*ksrc=Kh+(long)lane*DM+wid*8;
  const bf16*vsrc=Vh+(long)(16*(wid&3)+(lane>>2))*DM+(wid>>2)*32+(lane&3)*8;
  const unsigned kdst=lds0+LDS_K+wid*1024, vdst=lds0+LDS_V+wid*1024;
  #define DMA_K(t,slot) glds16(ksrc+(long)(t)*KVBLK*DM,(unsigned)__builtin_amdgcn_readfirstlane(kdst+(slot)))
  #define DMA_V(t,slot) do{ glds16(vsrc+(long)(t)*KVBLK*DM,(unsigned)__builtin_amdgcn_readfirstlane(vdst+2*(slot))); \
    if(DV2) glds16(vsrc+64+(long)(t)*KVBLK*DM,(unsigned)__builtin_amdgcn_readfirstlane(vdst+2*(slot)+8192)); }while(0)
  const int vb0=(int)(lds0+LDS_V)+((lane>>4)&1)*32+(lane&3)*8+(4*hi+((lane&15)>>2))*64;
  const char*Kbase=shm+LDS_K; bf16x8 kf[8];
  const lds_cptr shm3=(lds_cptr)shm; const lds_cptr shm3c=shm3; const lds_cptr kp0=shm3+LDS_K+hi*1024+r32*16; const lds_cptr vp0=shm3+LDS_V+((lane>>4)&1)*32+(lane&3)*8+(4*hi+((lane&15)>>2))*64;
  const int NT=(q0+QB)/KVBLK;
  DMA_K(0,0);DMA_V(0,0);DMA_K(1,SLOTB);
  bf16x8 qr[4];
  #pragma unroll
  for(int d0=0;d0<4;++d0)qr[d0]=*(const GAS bf16x8*)(&Qw[(long)r32*DM+d0*16+hi*8]);
  constexpr bool NEGM=(MODE==2);
  float mhat=0.f,l_reg=0.f;f32x16 o[2];o[0]=f32x16{};o[1]=f32x16{};f32x16 o2[2];o2[0]=f32x16{};o2[1]=f32x16{};f32x16 ZERO16=f32x16{}; if(NEGM){asm volatile("":"+v"(ZERO16));}
  const int qrel=wid*QBLK+r32;
  #define CMASK(P0,P1,t) do{ if(MODE!=2){ int jb_=(t)-(NT-4); if(jb_>=0){ if(MODE==0)chunkmask(P0,P1,jb_,wid); else cmask(P0,P1,jb_,qrel,hi);} } }while(0)
  const __attribute__((address_space(3))) float*ctab=(const __attribute__((address_space(3))) float*)(shm3c+LDS_CBT)+4*hi;
  const unsigned long long*mwave=masks+((size_t)(b*(SEQ/32)+(q0>>5)+wid)*(SEQ/64))*32;
  const float NEGINF=-INFINITY;
  #define CND(x,m) asm volatile("v_cndmask_b32_e64 %0, %2, %0, %1":"+v"(x):"s"(m),"v"(NEGINF))
  #define HOOK(P0,P1,t) do{ \
    if(MODE==1){ _Pragma("unroll") for(int g_=0;g_<4;++g_){ const f32x4_t b0_=*(const __attribute__((address_space(3))) f32x4_t*)(ctab+64*(t)+8*g_), b1_=*(const __attribute__((address_space(3))) f32x4_t*)(ctab+64*(t)+8*g_+32); \
        _Pragma("unroll") for(int i_=0;i_<4;i_+=2){ f32x2_t a_={P0[4*g_+i_],P0[4*g_+i_+1]}, c_={P1[4*g_+i_],P1[4*g_+i_+1]}; const f32x2_t x_={b0_[i_],b0_[i_+1]}, y_={b1_[i_],b1_[i_+1]}; a_=a_-x_; c_=c_-y_; \
          P0[4*g_+i_]=a_[0];P0[4*g_+i_+1]=a_[1];P1[4*g_+i_]=c_[0];P1[4*g_+i_+1]=c_[1]; } asm volatile("":::"memory"); } } \
    if(MODE==2){ asm volatile("s_waitcnt lgkmcnt(0)":::"memory"); \
      _Pragma("unroll") for(int r_=0;r_<8;++r_){ CND(P0[r_],mk0_[r_]); CND(P0[8+r_],mk1_[r_]); CND(P1[r_],mk2_[r_]); CND(P1[8+r_],mk3_[r_]); } } }while(0)
  u64x8 mk0_,mk1_,mk2_,mk3_;
  #define HOOK_ISSUE(t) do{ if(MODE==2){ const unsigned long long*mp_=mwave+(size_t)(t)*32; \
      const unsigned lo_=__builtin_amdgcn_readfirstlane((unsigned)(uintptr_t)mp_), hi_=__builtin_amdgcn_readfirstlane((unsigned)((uintptr_t)mp_>>32)); \
      const unsigned long long ma_=((unsigned long long)hi_<<32)|lo_; \
      asm volatile("s_load_dwordx16 %0, %4, 0x0\n\ts_load_dwordx16 %1, %4, 0x40\n\ts_load_dwordx16 %2, %4, 0x80\n\ts_load_dwordx16 %3, %4, 0xc0":"=&s"(mk0_),"=&s"(mk1_),"=&s"(mk2_),"=&s"(mk3_):"s"(ma_):"memory"); } }while(0)
  bool resc=false;
  #define START(P0,P1) do{ const float rm=rowmax(P0,P1); resc=false; \
    { const float dl=__builtin_fmaxf(rm,-256.f); mhat=fadd_s(mhat,dl); \
      _Pragma("unroll") for(int r=0;r<16;++r){P0[r]=fsub_s(P0[r],dl);P1[r]=fsub_s(P1[r],dl);} \
      if(NEGM){ _Pragma("unroll") for(int r=0;r<16;++r)ZERO16[r]=-mhat; asm volatile("":"+v"(ZERO16)); } } \
    _Pragma("unroll") for(int r=0;r<16;++r)P0[r]=__builtin_amdgcn_exp2f(P0[r]); }while(0)
  #define RESC() do{ if(resc){ asm volatile("s_waitcnt lgkmcnt(0)":::"memory"); \
      _Pragma("unroll") for(int d_=0;d_<2;++d_) _Pragma("unroll") for(int r=0;r<16;++r){ const float f_=wsf[crow(r,hi)]; o[d_][r]*=f_; if(DV2)o2[d_][r]*=f_; } } }while(0)
  f32x16 pA0,pA1,pB0,pB1;
  int sl_prev=0,sl_cur=0,sl_next=SLOTB;
  #define ROT() do{sl_prev=sl_cur;sl_cur=sl_next;sl_next=(sl_next==(NSLOT-1)*SLOTB)?0:sl_next+SLOTB;}while(0)
  DMA_K(2,2*SLOTB);
  WAIT_BAR2(3,4);
  HOOK_ISSUE(0); qkt(pA0,pA1,Kbase,qr,r32,hi);asm volatile("s_nop 15\n\ts_nop 7":"+v"(pA0),"+v"(pA1));HOOK(pA0,pA1,0);CMASK(pA0,pA1,0);
  START(pA0,pA1);
  _Pragma("unroll") for(int r=0;r<16;++r)pA1[r]=__builtin_amdgcn_exp2f(pA1[r]);
  WAIT_BAR(0);
  DMA_K(3,0);DMA_V(1,SLOTB);
  ROT();
  kload8(kf,kp0+sl_cur);
  WAIT_BAR2(2,3);
  s16x4 vlo[8],vhi[8]; u32x4 pw0,pw1,pw2,pw3;
  #define PKW(P,B) cvtpk_s(P[B],P[B+1])
  #define PAF(k) __builtin_bit_cast(bf16x8,pw##k)
  #define VFR(i) (bf16x8){vlo[i][0],vlo[i][1],vlo[i][2],vlo[i][3],vhi[i][0],vhi[i][1],vhi[i][2],vhi[i][3]}
  #define PIN(x) asm volatile("":"+v"(x))
  #define MX3(a,b,c) __builtin_fmaxf(__builtin_fmaxf((a),(b)),(c))
  #define GAPA(MF,A0,A1,A2,A3,W0,W1,PW) do{ MF; sacc+=A0; sacc+=A1; sacc+=A2; sacc+=A3; PIN(sacc); W0; W1; PIN(PW); SBAR(); }while(0)
  #define EX(v) __builtin_amdgcn_exp2f(v)
  #define GAPB(MF,X,B) do{ MF; X[B]=EX(X[B]); X[B+1]=EX(X[B+1]); X[B+2]=EX(X[B+2]); X[B+3]=EX(X[B+3]); PIN(X); SBAR(); }while(0)
  #define VRD(i) do{ vlo[i]=vtr(vp_+(((i)>>2)*4096+((i)&3)*1024)); vhi[i]=vtr(vp_+(((i)>>2)*4096+((i)&3)*1024+512)); }while(0)
  #define VRD2(i) do{ vlo[i]=vtr(vp_+8192+(((i)>>2)*4096+((i)&3)*1024)); vhi[i]=vtr(vp_+8192+(((i)>>2)*4096+((i)&3)*1024+512)); }while(0)
  #define KRD(G,j) do{ if(G){ kload2(kf,kp0+sl_next,j); SBAR(); } }while(0)
  #define STEP(C0,C1,P0,P1,t,GK,GV,GL) do{ SBAR(); HOOK_ISSUE(t); \
    const lds_cptr vp_=vp0+2*sl_prev; \
    VRD(0); SBAR(); float sacc=(P0[0]+P0[1]); \
    GAPA(C0=__builtin_amdgcn_mfma_f32_32x32x16_bf16(kf[0],qr[0],ZERO16,0,0,0), P0[2],P0[3],P0[4],P0[5],     pw0[0]=PKW(P0,0), pw0[1]=PKW(P0,2), pw0); \
    VRD(4); SBAR(); GAPA(C1=__builtin_amdgcn_mfma_f32_32x32x16_bf16(kf[1],qr[0],ZERO16,0,0,0), P0[6],P0[7],P0[8],P0[9],     pw0[2]=PKW(P0,4), pw0[3]=PKW(P0,6), pw0); \
    VRD(1); SBAR(); GAPA(C0=__builtin_amdgcn_mfma_f32_32x32x16_bf16(kf[2],qr[1],C0,0,0,0),   P0[10],P0[11],P0[12],P0[13], pw1[0]=PKW(P0,8), pw1[1]=PKW(P0,10), pw1); \
    VRD(5); SBAR(); GAPA(C1=__builtin_amdgcn_mfma_f32_32x32x16_bf16(kf[3],qr[1],C1,0,0,0),   P0[14],P0[15],P1[0],P1[1],   pw1[2]=PKW(P0,12),pw1[3]=PKW(P0,14), pw1); \
    VRD(2); SBAR(); GAPA(C0=__builtin_amdgcn_mfma_f32_32x32x16_bf16(kf[4],qr[2],C0,0,0,0),   P1[2],P1[3],P1[4],P1[5],     pw2[0]=PKW(P1,0), pw2[1]=PKW(P1,2), pw2); \
    VRD(6); SBAR(); GAPA(C1=__builtin_amdgcn_mfma_f32_32x32x16_bf16(kf[5],qr[2],C1,0,0,0),   P1[6],P1[7],P1[8],P1[9],     pw2[2]=PKW(P1,4), pw2[3]=PKW(P1,6), pw2); \
    VRD(3); SBAR(); GAPA(C0=__builtin_amdgcn_mfma_f32_32x32x16_bf16(kf[6],qr[3],C0,0,0,0),   P1[10],P1[11],P1[12],P1[13], pw3[0]=PKW(P1,8), pw3[1]=PKW(P1,10), pw3); \
    VRD(7); SBAR(); GAPA(C1=__builtin_amdgcn_mfma_f32_32x32x16_bf16(kf[7],qr[3],C1,0,0,0),   P1[14],P1[15],0.f,0.f,       pw3[2]=PKW(P1,12),pw3[3]=PKW(P1,14), pw3); \
    l_reg+=sacc; \
    if(GK){DMA_K((t)+3,sl_cur);} if(GV){DMA_V((t)+1,sl_next);} \
    if(!NEGM){ const f32x2_t mh2_={mhat,mhat}; _Pragma("unroll") for(int r=0;r<16;r+=2){ f32x2_t a_={C0[r],C0[r+1]}, b_={C1[r],C1[r+1]}; a_=a_-mh2_; b_=b_-mh2_; C0[r]=a_[0];C0[r+1]=a_[1];C1[r]=b_[0];C1[r+1]=b_[1]; } } \
    if(NEGM&&MODE==2){ asm volatile("s_nop 15\n\ts_nop 7":"+v"(C0),"+v"(C1)); }     \
    HOOK(C0,C1,t); CMASK(C0,C1,t); \
    { float a=MX3(C0[0],C0[1],C1[0]),b=MX3(C0[2],C0[3],C1[1]); a=MX3(a,C1[2],C1[3]); \
      _Pragma("unroll") for(int r=4;r<16;r+=4){a=MX3(a,C0[r],C0[r+1]);b=MX3(b,C0[r+2],C0[r+3]);a=MX3(a,C1[r],C1[r+1]);b=MX3(b,C1[r+2],C1[r+3]);} \
      float rm=__builtin_fmaxf(a,b); { auto rr=__builtin_amdgcn_permlane32_swap(__float_as_uint(rm),__float_as_uint(rm),false,false); rm=__builtin_fmaxf(__uint_as_float(rr[0]),__uint_as_float(rr[1])); } \
      resc=false; \
      if(__builtin_expect(__any(rm>(float)THRL),0)){ const float dl=__builtin_fmaxf(rm,0.f); mhat+=dl; \
        _Pragma("unroll") for(int r=0;r<16;++r){C0[r]-=dl;C1[r]-=dl;} \
        if(NEGM){ _Pragma("unroll") for(int r=0;r<16;++r)ZERO16[r]=-mhat; asm volatile("":"+v"(ZERO16)); } \
        const float f=__builtin_amdgcn_exp2f(-dl); l_reg*=f; if(hi==0)wsf[r32]=f; resc=true; } } \
    SBAR(); \
    GAPB(o[0]=__builtin_amdgcn_mfma_f32_32x32x16_bf16(PAF(0),VFR(0),o[0],0,0,0), C0,0); \
    GAPB(o[1]=__builtin_amdgcn_mfma_f32_32x32x16_bf16(PAF(0),VFR(4),o[1],0,0,0), C0,4); \
    KRD(GL,0); GAPB(o[0]=__builtin_amdgcn_mfma_f32_32x32x16_bf16(PAF(1),VFR(1),o[0],0,0,0), C0,8); \
    KRD(GL,1); GAPB(o[1]=__builtin_amdgcn_mfma_f32_32x32x16_bf16(PAF(1),VFR(5),o[1],0,0,0), C0,12); \
    KRD(GL,2); GAPB(o[0]=__builtin_amdgcn_mfma_f32_32x32x16_bf16(PAF(2),VFR(2),o[0],0,0,0), C1,0); \
    KRD(GL,3); GAPB(o[1]=__builtin_amdgcn_mfma_f32_32x32x16_bf16(PAF(2),VFR(6),o[1],0,0,0), C1,4); \
    GAPB(o[0]=__builtin_amdgcn_mfma_f32_32x32x16_bf16(PAF(3),VFR(3),o[0],0,0,0), C1,8); \
    GAPB(o[1]=__builtin_amdgcn_mfma_f32_32x32x16_bf16(PAF(3),VFR(7),o[1],0,0,0), C1,12); \
    if(DV2){   \
      VRD2(0);VRD2(4);VRD2(1);VRD2(5);VRD2(2);VRD2(6);VRD2(3);VRD2(7); SBAR(); \
      o2[0]=__builtin_amdgcn_mfma_f32_32x32x16_bf16(PAF(0),VFR(0),o2[0],0,0,0); o2[1]=__builtin_amdgcn_mfma_f32_32x32x16_bf16(PAF(0),VFR(4),o2[1],0,0,0); \
      o2[0]=__builtin_amdgcn_mfma_f32_32x32x16_bf16(PAF(1),VFR(1),o2[0],0,0,0); o2[1]=__builtin_amdgcn_mfma_f32_32x32x16_bf16(PAF(1),VFR(5),o2[1],0,0,0); \
      o2[0]=__builtin_amdgcn_mfma_f32_32x32x16_bf16(PAF(2),VFR(2),o2[0],0,0,0); o2[1]=__builtin_amdgcn_mfma_f32_32x32x16_bf16(PAF(2),VFR(6),o2[1],0,0,0); \
      o2[0]=__builtin_amdgcn_mfma_f32_32x32x16_bf16(PAF(3),VFR(3),o2[0],0,0,0); o2[1]=__builtin_amdgcn_mfma_f32_32x32x16_bf16(PAF(3),VFR(7),o2[1],0,0,0); SBAR(); } \
    }while(0)
  int t=1;
  #undef CMASK
  #define CMASK(P0,P1,t) do{}while(0)
  for(;t+5<NT;t+=2){
    STEP(pB0,pB1,pA0,pA1,t,true,true,true);     WAIT_BAR2(2,3); RESC(); ROT();
    STEP(pA0,pA1,pB0,pB1,t+1,true,true,true);   WAIT_BAR2(2,3); RESC(); ROT();
  }
  #undef CMASK
  #define CMASK(P0,P1,t) do{ if(MODE!=2){ int jb_=(t)-(NT-4); if(jb_>=0){ if(MODE==0)chunkmask(P0,P1,jb_,wid); else cmask(P0,P1,jb_,qrel,hi);} } }while(0)
  #define ENDW(tt) do{ if((tt)+3<NT){WAIT_BAR2(2,3);} else if((tt)+2<NT){WAIT_BAR2(1,2);} else {WAIT_BAR(0);} }while(0)
  for(;t+1<NT;t+=2){
    STEP(pB0,pB1,pA0,pA1,t,(t+3<NT),(t+1<NT),(t+1<NT));       ENDW(t);   RESC(); ROT();
    STEP(pA0,pA1,pB0,pB1,t+1,(t+4<NT),(t+2<NT),(t+2<NT));     ENDW(t+1); RESC(); ROT();
  }
  STEP(pB0,pB1,pA0,pA1,NT-1,false,false,false); RESC();
  { float sacc=pB0[0]+pB0[1]; _Pragma("unroll") for(int r=2;r<16;++r)sacc+=pB0[r]; _Pragma("unroll") for(int r=0;r<16;++r)sacc+=pB1[r]; l_reg+=sacc;
    pw0=(u32x4){PKW(pB0,0),PKW(pB0,2),PKW(pB0,4),PKW(pB0,6)};pw1=(u32x4){PKW(pB0,8),PKW(pB0,10),PKW(pB0,12),PKW(pB0,14)};pw2=(u32x4){PKW(pB1,0),PKW(pB1,2),PKW(pB1,4),PKW(pB1,6)};pw3=(u32x4){PKW(pB1,8),PKW(pB1,10),PKW(pB1,12),PKW(pB1,14)};
    SBAR(); pv(o,vb0+2*sl_cur,PAF(0),PAF(1),PAF(2),PAF(3)); if(DV2){ SBAR(); pv(o2,vb0+2*sl_cur+8192,PAF(0),PAF(1),PAF(2),PAF(3)); } }
  #undef PKW
  #undef PAF
  #undef VFR
  #undef PIN
  #undef MX3
  #undef GAPA
  #undef GAPB
  #undef EX
  #undef VRD
  #undef VRD2
  #undef KRD
  #undef STEP
  #undef ENDW
  {auto rr=__builtin_amdgcn_permlane32_swap(__float_as_uint(l_reg),__float_as_uint(l_reg),false,false);l_reg=__uint_as_float(rr[0])+__uint_as_float(rr[1]);}
  if(hi==0)wsf[32+r32]=l_reg;asm volatile("s_waitcnt lgkmcnt(0)":::"memory");
  float rli[16];
  #pragma unroll
  for(int r=0;r<16;++r)rli[r]=__builtin_amdgcn_rcpf(wsf[32+crow(r,hi)]);
  bf16*Ow=O+(rowbase+q0+wid*QBLK)*PO;
  { bf16*stg=(bf16*)(shm+LDS_OST)+wid*2048;
    #pragma unroll
    for(int r=0;r<16;++r){const int orow=crow(r,hi);
      #pragma unroll
      for(int d0=0;d0<2;++d0)stg[orow*64+d0*32+r32]=__float2bfloat16(o[d0][r]*rli[r]);}
    asm volatile("s_waitcnt lgkmcnt(0)":::"memory");
    #pragma unroll
    for(int i=0;i<4;++i){const int row=i*8+(lane>>3),ch=lane&7; const u32x4 v=*(const u32x4*)(stg+row*64+ch*8); ATTN_STORE16(Ow+(long)row*PO+ch*8,v);}
    if(DV2){ asm volatile("s_waitcnt lgkmcnt(0)":::"memory");
      #pragma unroll
      for(int r=0;r<16;++r){const int orow=crow(r,hi);
        #pragma unroll
        for(int d0=0;d0<2;++d0)stg[orow*64+d0*32+r32]=__float2bfloat16(o2[d0][r]*rli[r]);}
      asm volatile("s_waitcnt lgkmcnt(0)":::"memory");
      #pragma unroll
      for(int i=0;i<4;++i){const int row=i*8+(lane>>3),ch=lane&7; const u32x4 v=*(const u32x4*)(stg+row*64+ch*8); ATTN_STORE16(Ow+(long)row*PO+64+ch*8,v);} } }
  asm volatile("s_waitcnt lgkmcnt(0)\n\ts_barrier":::"memory");
  #undef DMA_K
  #undef DMA_V
  #undef CMASK
  #undef HOOK
  #undef HOOK_ISSUE
  #undef CND
  #undef START
  #undef RESC
  #undef ROT
}
constexpr int ATTN_LDS_BYTES=LDS_BYTES;
static_assert(LDS_BYTES <= 131072, "attention scratch fits the 128 KiB phase region");
#undef SBAR
#undef WAIT_BAR
}

__device__ __forceinline__ void attention_phase(Frame& F, char* lds_g, int amask, int l) {
    using namespace attn_body;
    typedef attn_body::bf16 abf;
    const int v = F.vcu, b = v >> 5, j = v & 31;
    unsigned char* ws = F.ws;
#ifndef AMODES
#define AMODES 7
#endif
    if ((AMODES & 1) && (amask & 1)) {
        const int hm = j >> 2, p0 = 2 * (j & 3);
        const abf* Q = (const abf*)(ws + WS_Z) + hm * 64; const abf* K = (const abf*)(ws + WS_Z + ZG) + hm * 64; const abf* V = (const abf*)(ws + WS_Z + 2 * ZG) + (hm >> 1) * 128;
        abf* O = (abf*)(ws + WS_OD) + hm * 128;
        for (int i = 0; i < 4; ++i) { const int p = p0 + (i >> 1), qb = (i & 1) ? p : 15 - p; attn_unit<16, 0, 1024>(b, qb, Q, K, V, O, lds_g, nullptr, F.tid); }
    }
    if ((AMODES & 2) && (amask & 2)) {
        const int h = j >> 2, p0 = 2 * (j & 3);
        const abf* Q = (const abf*)(ws + WS_Z + 3 * ZG) + h * 64; const abf* K = (const abf*)(ws + WS_Z + 4 * ZG) + h * 64; const abf* V = (const abf*)(ws + WS_Z + 5 * ZG) + h * 64;
        abf* O = (abf*)(ws + WS_OS) + h * 64;
        for (int i = 0; i < 4; ++i) { const int p = p0 + (i >> 1), qb = (i & 1) ? p : 15 - p; attn_unit<16, 2, 512>(b, qb, Q, K, V, O, lds_g, (const unsigned long long*)(ws + (l == 0 ? WS_MASK : WS_MASK1)), F.tid); }
    }
    if ((AMODES & 4) && (amask & 4)) {
        const int h = j >> 2, p0 = 2 * (j & 3);
        { LAS float* ct = (LAS float*)(F.lds + RING_OFF + LDS_CBT); const float* cb = (const float*)(ws + WS_CB) + (size_t)(b * 8 + h) * S;
          for (int i = F.tid; i < S; i += NWAVES * 64) ct[i] = ((const GAS float*)cb)[i];
          __syncthreads(); }
        const abf* Q = (const abf*)(ws + WS_Z + 6 * ZG) + h * 64; const abf* K = (const abf*)(ws + WS_Z + 7 * ZG) + h * 64; const abf* V = (const abf*)(ws + WS_Z + 8 * ZG) + h * 64;
        abf* O = (abf*)(ws + WS_OF) + h * 64;
        for (int i = 0; i < 4; ++i) { const int p = p0 + (i >> 1), qb = (i & 1) ? p : 15 - p; attn_unit<24, 1, 512>(b, qb, Q, K, V, O, lds_g, nullptr, F.tid);   }
    }
}
namespace dsa_sel {
typedef float f32x16 __attribute__((ext_vector_type(16)));
constexpr int HP = 257, CAP = 32;
constexpr int L_HIST = 0, L_PREFIX = 64 * HP * 4, L_KK = L_PREFIX + 256, L_TAU = L_KK + 256, L_NEED = L_TAU + 256, L_TSEL = L_NEED + 256, L_IDXT = L_TSEL + 256, L_FLAG = L_IDXT + 256, L_QF = L_FLAG + 256, L_LCNT = L_QF + 32768, L_LIST = L_LCNT + 256;
__device__ __forceinline__ unsigned f2key(float f) { const unsigned u = __float_as_uint(f); return u ^ ((unsigned)((int)u >> 31) | 0x80000000u); }
__device__ __forceinline__ float relu1(float x) { const int b = __builtin_bit_cast(int, x); return __builtin_bit_cast(float, b > 0 ? b : 0); }
__device__ __forceinline__ int crow(int r, int hi) { return (r & 3) + 8 * (r >> 2) + 4 * hi; }

template <int PM>
__device__ __forceinline__ void sweep(const unsigned short* ikb  , const LAS bf16x8* qfl0  , const f32x4& iw, int ntile, int kq, int lane, int ql  , int qg, int rot_seed,
                                      LAS unsigned* lds32, int shift, unsigned long long* mout  , unsigned inc = 1u) {
    asm volatile("" : "+v"(lane), "+v"(ql));
    const int i32 = lane & 31, hi = lane >> 5;
    const LAS bf16x8* qfl = qfl0 + qg * 1024 + lane;
    LAS unsigned* hist = lds32 + (L_HIST / 4) + ql * HP;
    unsigned prefix = 0, tau = 0, need = 0, tsel = 0, idxt = 0;
    if (PM == 0) prefix = lds32[L_PREFIX / 4 + ql];
    const unsigned pbase = prefix << 8;
    if (PM >= 1 && PM != 4) tau = lds32[L_TAU / 4 + ql];
    if (PM == 4) tau = lds32[L_PREFIX / 4 + ql];
    if (PM == 2) tsel = lds32[L_TSEL / 4 + ql];
    if (PM == 3) idxt = lds32[L_IDXT / 4 + ql];
    (void)need;
    bf16x8 bufA[4], bufB[4];
    const int cnt = (ntile - kq + 3) >> 2;
    const int rot = cnt > 0 ? (int)(((unsigned)rot_seed * 5u) % (unsigned)cnt) : 0;
    if (cnt > 0) {
        const int t0 = kq + 4 * rot;
#pragma unroll
        for (int ds = 0; ds < 4; ++ds) { bufA[ds] = *(const GAS bf16x8*)(ikb + (size_t)t0 * 4096 + (size_t)((ds * 64 + lane) * 8));
                                         bufB[ds] = *(const GAS bf16x8*)(ikb + (size_t)t0 * 4096 + (size_t)(((4 + ds) * 64 + lane) * 8)); }
    }
    for (int k = 0; k < cnt; ++k) {
        int kr = k + rot; if (kr >= cnt) kr -= cnt;
        int kr1 = kr + 1; if (kr1 >= cnt) kr1 -= cnt;
        const int t = kq + 4 * kr, tnext = kq + 4 * kr1; const bool has_next = (k + 1 < cnt);
        unsigned long long mine = 0ull;
#pragma unroll
        for (int kh = 0; kh < 2; ++kh) {
            f32x16 sc;
#pragma unroll
            for (int hp = 0; hp < 2; ++hp) {
                f32x16 a0 = {}, a1 = {};
#pragma unroll
                for (int ds = 0; ds < 4; ++ds) {
                    const bf16x8 kfr = kh == 0 ? bufA[ds] : bufB[ds];
                    a0 = __builtin_amdgcn_mfma_f32_32x32x16_bf16(kfr, qfl[((2 * hp) * 4 + ds) * 64], a0, 0, 0, 0);
                    a1 = __builtin_amdgcn_mfma_f32_32x32x16_bf16(kfr, qfl[((2 * hp + 1) * 4 + ds) * 64], a1, 0, 0, 0);
                }
                if (hp == 1) {
#pragma unroll
                    for (int ds = 0; ds < 4; ++ds) { const bf16x8 nv = *(const GAS bf16x8*)(ikb + (size_t)tnext * 4096 + (size_t)(((kh * 4 + ds) * 64 + lane) * 8)); if (kh == 0) bufA[ds] = nv; else bufB[ds] = nv; }
                    __builtin_amdgcn_sched_barrier(0);
                }
                const float w0 = iw[2 * hp], w1 = iw[2 * hp + 1];
                if (hp == 0) {
#pragma unroll
                    for (int r = 0; r < 16; ++r) sc[r] = fmaf(w1, relu1(a1[r]), fmaf(w0, relu1(a0[r]), 0.0f));
                } else {
#pragma unroll
                    for (int r = 0; r < 16; ++r) sc[r] = fmaf(w1, relu1(a1[r]), fmaf(w0, relu1(a0[r]), sc[r]));
                }
            }
            const unsigned tz = (unsigned)(64 * t + 32 * kh + 4 * hi) << 11;
#pragma unroll
            for (int r = 0; r < 16; ++r) {
                unsigned key = f2key(sc[r]);
                key = (key == 0x80000000u) ? (0x80000000u | ((4095u - (unsigned)((r & 3) + 8 * (r >> 2))) << 11)) - tz : key;
                if (PM == 0) {
                    const unsigned dg = (key >> shift) - pbase;
                    __hip_atomic_fetch_add(hist + (dg < 256u ? dg : 256u), inc, __ATOMIC_RELAXED, __HIP_MEMORY_SCOPE_WORKGROUP);
                } else if (PM == 1) {
                    __hip_atomic_fetch_add(hist + (key == tau ? (unsigned)t : 256u), 1u, __ATOMIC_RELAXED, __HIP_MEMORY_SCOPE_WORKGROUP);
                } else if (PM == 2) {
                    __hip_atomic_fetch_add(hist + ((key == tau && (unsigned)t == tsel) ? (unsigned)(32 * kh + crow(r, hi)) : 256u), 1u, __ATOMIC_RELAXED, __HIP_MEMORY_SCOPE_WORKGROUP);
                } else if (PM == 3) {
                    const unsigned idx = (unsigned)(64 * t + 32 * kh + crow(r, hi));
                    const bool sel = key > tau || (key == tau && idx <= idxt);
                    const unsigned long long bal = __ballot(sel);
                    if (lane == kh * 16 + r) mine = bal;
                } else {
                    const unsigned top = key >> 16;
                    const unsigned long long bal = __ballot(top > tau);
                    if (lane == kh * 16 + r) mine = bal;
                    if (top == tau) {
                        const unsigned slot = __hip_atomic_fetch_add(lds32 + L_LCNT / 4 + ql, 1u, __ATOMIC_RELAXED, __HIP_MEMORY_SCOPE_WORKGROUP);
                        if (slot < (unsigned)CAP) { lds32[L_LIST / 4 + (ql * CAP + slot) * 2] = key; lds32[L_LIST / 4 + (ql * CAP + slot) * 2 + 1] = (unsigned)(64 * t + 32 * kh + crow(r, hi)); }
                    }
                }
            }
        }
        if (PM >= 3) { if (lane < 32) mout[(size_t)t * 32 + lane] = mine; }
    }
}

__device__ __forceinline__ void select_phase(Frame& F, int l) {
    const int tid = F.tid, lane = F.lane, wid = F.wave;
    const int v = F.vcu, b = v >> 5, s = v & 31;
    const int qg = wid & 1, kq = wid >> 1;
    const int rot_seed = (v & 31) + 1;
    LAS unsigned* lds32 = (LAS unsigned*)(F.lds + RING_OFF);
    unsigned char* ws = F.ws;
    const unsigned short* ikb = (const unsigned short*)(ws + WS_IK) + (size_t)b * S * 64;
    unsigned long long* masks = (unsigned long long*)(ws + (l == 0 ? WS_MASK : WS_MASK1));
    for (int uu = 0; uu < 2; ++uu) {
        const int c = uu == 0 ? 63 - s : s;
        const int ntile = c + 1, q0 = c * 64;
        const int ql = 32 * qg + (lane & 31);
        const size_t qrow = (size_t)b * S + q0 + ql;
        unsigned long long* mout = masks + ((size_t)(b * 128 + (q0 >> 5) + qg) * 64) * 32;
        const int tend = 4 * (c >> 2) + 4;
        for (int t = ntile + kq; t < tend; t += 4) { if (lane < 32) mout[(size_t)t * 32 + lane] = 0ull; }
        if (ntile <= 4) {
            for (int t = kq; t < ntile; t += 4) { if (lane < 32) mout[(size_t)t * 32 + lane] = ~0ull; }
            continue;
        }
        f32x4 iw;
        LAS bf16x8* qfl0 = (LAS bf16x8*)((LAS unsigned char*)lds32 + L_QF);
        LAS bf16x8* qfl = qfl0 + qg * 1024 + lane;
        {
            const unsigned short* iq = (const unsigned short*)(ws + WS_IQ) + qrow * 256;
            __syncthreads();
            if (kq == 0) {
                bf16x8 qt[16];
#pragma unroll
                for (int f = 0; f < 16; ++f) qt[f] = *(const GAS bf16x8*)(iq + (f >> 2) * 64 + 16 * (f & 3) + 8 * (lane >> 5));
                asm volatile("s_waitcnt vmcnt(0)" ::: "memory");
#pragma unroll
                for (int f = 0; f < 16; ++f) qfl[f * 64] = qt[f];
            }
            iw = *(const GAS f32x4*)((const float*)(ws + WS_IW) + qrow * 4);
        }
        if (tid < 64) { lds32[L_PREFIX / 4 + tid] = 0u; lds32[L_KK / 4 + tid] = 256u; }
        if (tid == 0) { lds32[L_FLAG / 4] = 0u; lds32[L_FLAG / 4 + 1] = 0u; }
        if (tid < 64) lds32[L_LCNT / 4 + tid] = 0u;
        bool fast = false;
        for (int pass = 0; pass < 4; ++pass) {
            if (pass == 2) {
#ifdef PROBE_FORCE_FAST
                fast = true;
#else
                fast = lds32[L_FLAG / 4 + 1] == 0u;
#endif
#ifdef PROBE_COUNT
                if (tid == 0 && c >= 32) __hip_atomic_fetch_add((unsigned*)(ws + WS_CTL) + 66 + (fast ? 0 : 1), 1u, RLX_AGENT);
#endif
                if (fast) break;
            }
            for (int i = tid; i < 64 * HP; i += NWAVES * 64) lds32[L_HIST / 4 + i] = 0u;
            __syncthreads();
            sweep<0>(ikb, qfl0, iw, ntile, kq, lane, ql, qg, rot_seed, lds32, 24 - 8 * pass, nullptr);
#ifdef PROBE_SWEEP2
            sweep<0>(ikb, qfl0, iw, ntile, kq, lane, ql, qg, rot_seed, lds32, 24 - 8 * pass, nullptr, (unsigned)pass >> 4);
#endif
            __syncthreads();
            for (int qq = 0; qq < 8; ++qq) {
                const int qi = wid * 8 + qq;
                LAS unsigned* hq = lds32 + (L_HIST / 4) + qi * HP;
                const unsigned kk = lds32[L_KK / 4 + qi];
                const unsigned h0 = hq[4 * lane], h1 = hq[4 * lane + 1], h2 = hq[4 * lane + 2], h3 = hq[4 * lane + 3];
                const unsigned own = h0 + h1 + h2 + h3;
                unsigned suf = own;
#pragma unroll
                for (int o = 1; o < 64; o <<= 1) { const unsigned n = __shfl_down(suf, o); if (lane + o < 64) suf += n; }
                const unsigned above = suf - own;
                const bool here = above < kk && suf >= kk;
                if (here) {
                    unsigned cum = above; int d = 4 * lane + 3; unsigned hv = h3;
                    if (cum + hv < kk) { cum += hv; d = 4 * lane + 2; hv = h2; if (cum + hv < kk) { cum += hv; d = 4 * lane + 1; hv = h1; if (cum + hv < kk) { cum += hv; d = 4 * lane; hv = h0; } } }
                    const unsigned np = (lds32[L_PREFIX / 4 + qi] << 8) | (unsigned)d, nk = kk - cum;
                    lds32[L_PREFIX / 4 + qi] = np; lds32[L_KK / 4 + qi] = nk;
                    if (pass == 1 && hv > (unsigned)CAP) __hip_atomic_fetch_or(lds32 + L_FLAG / 4 + 1, 1u, __ATOMIC_RELAXED, __HIP_MEMORY_SCOPE_WORKGROUP);
                    if (pass == 3) { lds32[L_TAU / 4 + qi] = np; lds32[L_NEED / 4 + qi] = nk; lds32[L_IDXT / 4 + qi] = 0xffffu;
                        if (hv != nk) __hip_atomic_fetch_or(lds32 + L_FLAG / 4, 1u, __ATOMIC_RELAXED, __HIP_MEMORY_SCOPE_WORKGROUP); }
                }
            }
            __syncthreads();
        }
        if (fast) {
            sweep<4>(ikb, qfl0, iw, ntile, kq, lane, ql, qg, rot_seed, lds32, 0, mout);
            asm volatile("s_waitcnt vmcnt(0)" ::: "memory");
            __syncthreads();
            unsigned* m32 = (unsigned*)(masks + ((size_t)(b * 128 + (q0 >> 5)) * 64) * 32);
            for (int i = tid; i < 64 * CAP; i += NWAVES * 64) {
                const int qi = i / CAP, ci = i - qi * CAP; const unsigned n = lds32[L_LCNT / 4 + qi];
                if ((unsigned)ci < n) {
                    const LAS unsigned* lst = lds32 + L_LIST / 4 + qi * CAP * 2;
                    const unsigned key = lst[ci * 2], idx = lst[ci * 2 + 1]; unsigned rank = 0;
                    for (unsigned jj = 0; jj < n; ++jj) { const unsigned kj = lst[jj * 2], ij = lst[jj * 2 + 1]; rank += (kj > key || (kj == key && ij < idx)) ? 1u : 0u; }
                    if (rank < lds32[L_KK / 4 + qi]) {
                        const unsigned tl = idx >> 6, ps = idx & 63u, kh = ps >> 5, p5 = ps & 31u, hi = (p5 >> 2) & 1u, r = (p5 & 3u) + 4u * (p5 >> 3);
                        unsigned* w = m32 + ((((size_t)(qi >> 5) * 64 + tl) * 32 + kh * 16 + r) * 2 + hi);
                        __hip_atomic_fetch_or(w, 1u << (qi & 31), RLX_AGENT);
                    }
                }
            }
            __syncthreads();
            continue;
        }
        if (lds32[L_FLAG / 4] != 0u) {
            for (int i = tid; i < 64 * HP; i += NWAVES * 64) lds32[L_HIST / 4 + i] = 0u;
            __syncthreads();
            sweep<1>(ikb, qfl0, iw, ntile, kq, lane, ql, qg, rot_seed, lds32, 0, nullptr);
            __syncthreads();
            if (tid < 64) {
                LAS unsigned* hq = lds32 + (L_HIST / 4) + tid * HP;
                const unsigned need = lds32[L_NEED / 4 + tid]; unsigned cum = 0; int d = 0;
                for (; d < 63; ++d) { const unsigned hv = hq[d]; if (cum + hv >= need) break; cum += hv; }
                lds32[L_TSEL / 4 + tid] = (unsigned)d; lds32[L_NEED / 4 + tid] = need - cum;
            }
            __syncthreads();
            for (int i = tid; i < 64 * HP; i += NWAVES * 64) lds32[L_HIST / 4 + i] = 0u;
            __syncthreads();
            sweep<2>(ikb, qfl0, iw, ntile, kq, lane, ql, qg, rot_seed, lds32, 0, nullptr);
            __syncthreads();
            if (tid < 64) {
                LAS unsigned* hq = lds32 + (L_HIST / 4) + tid * HP;
                const unsigned need = lds32[L_NEED / 4 + tid]; unsigned cum = 0; int d = 0;
                for (; d < 63; ++d) { const unsigned hv = hq[d]; if (cum + hv >= need) break; cum += hv; }
                lds32[L_IDXT / 4 + tid] = lds32[L_TSEL / 4 + tid] * 64u + (unsigned)d;
            }
            __syncthreads();
        }
        sweep<3>(ikb, qfl0, iw, ntile, kq, lane, ql, qg, rot_seed, lds32, 0, mout);
        __syncthreads();
    }
}
}
constexpr int N_PHASES = 1 + 12 * DEPTH;
#ifndef ALIGN_P1
#define ALIGN_P1 true
#endif
#ifndef ALIGN_P6
#define ALIGN_P6 true
#endif
struct Args { const float* in[19]; float* out; unsigned char* ws; int ph_lo, ph_hi, li, amask; };

#ifndef PHMASK
#define PHMASK 0xFFFF
#endif
#ifdef PROBE_BARRIER2
#define PROBE_BAR2(b) xcd_barrier(b)
#else
#define PROBE_BAR2(b) do { } while (0)
#endif
#define IN(k) (lo <= (k) && (k) < hi)
#define INL(j) (((PHMASK >> ((j) + 1)) & 1) && IN(pb + (j)))
#define SEAM(k) do { if (IN(k) && IN((k) + 1)) { XcdBarrier b_; b_.bar = (unsigned*)((gu32*)(ws_a + WS_CTL) + CW_BAR) + li * XCD_BAR_WORDS; b_.x = xb_xcc_id(); b_.tid = (unsigned)F.tid; \
        b_.st = (volatile LAS unsigned*)((LAS unsigned char*)lds + MISC_OFF) + 8; xcd_barrier(b_); PROBE_BAR2(b_); } } while (0)
#define FRESH() do { int l_ = (int)__builtin_amdgcn_mbcnt_hi(~0u, __builtin_amdgcn_mbcnt_lo(~0u, 0u)); asm volatile("" : "+v"(l_)); F.lane = l_; F.wave = wave0; F.tid = wave0 * 64 + l_; \
        { unsigned char* w_ = ws_a; asm volatile("" : "+s"(w_)); F.ws = w_; float* o_ = out_a; asm volatile("" : "+s"(o_)); F.out = o_; } \
        int b_ = blockIdx.x; asm volatile("" : "+s"(b_)); F.G = gridDim.x; F.vcu = (F.G % 8 == 0) ? (b_ % 8) * (F.G / 8) + b_ / 8 : b_; } while (0)
#ifdef PROBE_STAMP
#define STP ((LAS unsigned long long*)((LAS unsigned char*)lds + LDSCTL_OFF + 512))
#define STAMP(j) do { if (blockIdx.x == 0 && F.tid == 0) { const unsigned long long t_ = __builtin_amdgcn_s_memrealtime(); STP[1 + (j)] += t_ - STP[0]; STP[0] = t_; } } while (0)
#else
#define STAMP(j) do { } while (0)
#endif
template <int l>
__device__ __forceinline__ void layer_phases(Frame& F, const int lo, const int hi, const int li, const int amask, unsigned char* const ws_a, float* const out_a, const int wave0, unsigned char* const lds) {
    const int bx = (int)blockIdx.x;
        const int pb = 1 + 12 * l;

        if (INL(0)) { FRESH(); unsigned char* ws = F.ws;
#ifdef PROBE_STAGGER
            if ((bx >> 3) & 1) { for (int i_ = 0; i_ < PROBE_STAGGER; ++i_) __builtin_amdgcn_s_sleep(127); }
#endif
            GPlain g{(const char*)(ws + WS_XN), (const char*)(ws + WS_WIN), D, D};
            SchedGrid Sc{T / 256, NPROJ / 256, F.G, bx};
            EpiProj E{ws, F.in[I_BF] + l * 8};
#ifdef PROBE_EPI1
#if PROBE_EPIVAR > 0
            if (l == 0 && li == 0 && hi == 2) { EpiProjT<PROBE_EPIVAR> Ep{ws, F.in[I_BF] + l * 8}; pg8::gemm_phase<GPlain, EpiProjT<PROBE_EPIVAR>, SchedGrid, ALIGN_P1>(F.lds + RING_OFF, g, Sc, Ep, F.tid); } else
#else
            if (l == 0 && li == 0 && hi == 2) { EpiPlain Ep{(bf16*)(ws + WS_Z), NPROJ, 0}; pg8::gemm_phase<GPlain, EpiPlain, SchedGrid, ALIGN_P1>(F.lds + RING_OFF, g, Sc, Ep, F.tid); } else
#endif
#endif
            pg8::gemm_phase<GPlain, EpiProj, SchedGrid, ALIGN_P1>(F.lds + RING_OFF, g, Sc, E, F.tid);
            SEAM(pb + 0); STAMP(0);
        }
        if (INL(1)) { FRESH();
#ifndef PROBE_NOSCAN
            fox_scan(F);
#endif
#ifndef PROBE_NOSEL
            dsa_sel::select_phase(F, l);
#endif
            SEAM(pb + 1); STAMP(1); }
        if (INL(2)) { FRESH(); attention_phase(F, (char*)lds + RING_OFF, amask, l); SEAM(pb + 2); STAMP(2); }
        if (INL(3)) { FRESH(); diff_combine(F, l); SEAM(pb + 3); STAMP(3); }
        if (INL(4)) { FRESH(); unsigned char* ws = F.ws;
            GBranch g{(const char*)ws, (const char*)(ws + WS_WBR), 512, 512};
            SchedU Sc{F.G, bx};
            EpiPlain E{(bf16*)(ws + WS_U), 3072, 1024};
            pg8::gemm_phase<GBranch, EpiPlain, SchedU, true>(F.lds + RING_OFF, g, Sc, E, F.tid);
            SEAM(pb + 4); STAMP(4);
        }
        if (INL(5)) { FRESH(); unsigned char* ws = F.ws;
            GGate g{(const char*)(ws + WS_XN), (const char*)(ws + WS_WIN), D, D};
            SchedY Sc{F.G, bx};
            EpiGate E{(const bf16*)(ws + WS_U), (bf16*)(ws + WS_Y)};
            pg8::gemm_phase<GGate, EpiGate, SchedY, ALIGN_P6>(F.lds + RING_OFF, g, Sc, E, F.tid);
            SEAM(pb + 5); STAMP(5);
        }
        if (INL(6)) { FRESH(); unsigned char* ws = F.ws;
            GPlain g{(const char*)(ws + WS_Y), (const char*)(ws + WS_WO), D, D};
            SchedGrid Sc{T / 256, D / 256, F.G, bx};
            EpiResid E{(bf16*)(ws + WS_S1), (const bf16*)(ws + WS_XN)};
            pg8::gemm_phase<GPlain, EpiResid, SchedGrid, true>(F.lds + RING_OFF, g, Sc, E, F.tid);
            SEAM(pb + 6); STAMP(6);
        }
        if (INL(7)) { FRESH(); p8_ln1_router(F, l); SEAM(pb + 7); STAMP(7); }
        if (INL(8)) { FRESH(); p9_placement(F); SEAM(pb + 8); STAMP(8); }
        if (INL(9)) { FRESH(); unsigned char* ws = F.ws;
            const int* tile_e = (const int*)(ws + WS_TILEE);
            const int ntiles = __builtin_amdgcn_readfirstlane(__hip_atomic_load(tile_e + NRT_MAX, RLX_AGENT));
            LAS int* tab = (LAS int*)(F.lds + TAB_OFF); LAS int* tabe = (LAS int*)(F.lds + LDSCTL_OFF + 640);
            SchedMoe Sc{tabe, ntiles, F.G, bx};
            { Unit u; const int* row_tok = (const int*)(ws + WS_ROWTOK);
              if (F.tid < 8 && Sc.unit(F.tid, u)) tabe[F.tid] = __hip_atomic_load(tile_e + u.pm, RLX_AGENT);
              int rt_[4]; const int t_ = F.tid & 255, ih_ = F.tid >> 8;
#pragma unroll
              for (int k = 0; k < 4; ++k) { rt_[k] = 0; if (Sc.unit(2 * k + ih_, u)) rt_[k] = *(const GAS int*)(row_tok + u.pm * 256 + t_); }
#pragma unroll
              for (int k = 0; k < 4; ++k) tab[(2 * k + ih_) * 256 + t_] = rt_[k]; }
            __syncthreads();
            GMoe1 g{(const char*)(ws + WS_XN), (const char*)(ws + WS_EW), D, tab};
            EpiSwiglu E{(bf16*)(ws + WS_HID)};
            pg8::gemm_phase<GMoe1, EpiSwiglu, SchedMoe, true>(F.lds + RING_OFF, g, Sc, E, F.tid);
            SEAM(pb + 9); STAMP(9);
        }
        if (INL(10)) { FRESH(); unsigned char* ws = F.ws;
            const int* tile_e = (const int*)(ws + WS_TILEE);
            const int ntiles = __builtin_amdgcn_readfirstlane(__hip_atomic_load(tile_e + NRT_MAX, RLX_AGENT));
            LAS int* tabe = (LAS int*)(F.lds + LDSCTL_OFF + 640);
            SchedMoe Sc{tabe, ntiles, F.G, bx};
            { Unit u; if (F.tid < 8 && Sc.unit(F.tid, u)) tabe[F.tid] = __hip_atomic_load(tile_e + u.pm, RLX_AGENT); }
            __syncthreads();
            GMoe2 g{(const char*)(ws + WS_HID), (const char*)(ws + WS_EWD), DE, DE};
            EpiPlain E{(bf16*)(ws + WS_YR), D, 0};
            pg8::gemm_phase<GMoe2, EpiPlain, SchedMoe, true>(F.lds + RING_OFF, g, Sc, E, F.tid);
            SEAM(pb + 10); STAMP(10);
        }
        if (INL(11)) { FRESH();
#ifdef PROBE_P12
            p12_combine_ln2(F, l, args.li == 0);
#endif
            p12_combine_ln2(F, l); SEAM(pb + 11); STAMP(11); }
}
__global__ void __launch_bounds__(NWAVES * 64, 2) mk_fwd(Args args) {
    extern __shared__ __attribute__((aligned(16))) unsigned char lds[];
    Frame F;
    F.lds = (LAS unsigned char*)lds;
    F.MISC = (volatile LAS unsigned*)(F.lds + MISC_OFF);
    F.tid = threadIdx.x; F.lane = F.tid & 63; F.wave = __builtin_amdgcn_readfirstlane(F.tid >> 6);
    F.G = gridDim.x; { const int bx = blockIdx.x; F.vcu = (F.G % 8 == 0) ? (bx % 8) * (F.G / 8) + bx / 8 : bx; }
    F.ws = args.ws; F.out = args.out; F.in = args.in;
    F.ctl = (gu32*)(F.ws + WS_CTL);
    for (int u = F.tid; u < (LDS_BYTES - LDSCTL_OFF) / 4; u += NWAVES * 64) ((LAS unsigned*)(F.lds + LDSCTL_OFF))[u] = 0u;
    __syncthreads();
    const int wave0 = F.wave;
    (void)xcd_barrier_post((unsigned*)(F.ctl + CW_BAR) + args.li * XCD_BAR_WORDS, F.MISC + 8);
    const int lo = args.ph_lo, hi = args.ph_hi;
    unsigned char* const ws_a = args.ws; float* const out_a = args.out; const int li = args.li;
#ifdef PROBE_STAMP
    if (threadIdx.x == 0) { for (int i = 1; i < 16; ++i) STP[i] = 0ull; STP[0] = __builtin_amdgcn_s_memrealtime(); }
#endif
    if ((PHMASK & 1) && IN(0)) { FRESH(); p0_prologue(F); SEAM(0); STAMP(12); }

    layer_phases<0>(F, lo, hi, li, args.amask, ws_a, out_a, wave0, lds);
    layer_phases<1>(F, lo, hi, li, args.amask, ws_a, out_a, wave0, lds);
    static_assert(DEPTH == 2, "two layer instantiations");
#ifdef PROBE_STAMP
    {
        FRESH();
        if (blockIdx.x == 0 && F.tid == 0) { float sa = 0.f, sb = 0.f;
            for (int j = 0; j < 13; ++j) { const float us = (float)STP[1 + j] * 0.01f; if ((PROBE_SELA >> j) & 1) sa += us; if ((PROBE_SELB >> j) & 1) sb += us; }
#ifdef PROBE_COUNT
            sa = (float)__hip_atomic_load((unsigned*)(F.ws + WS_CTL) + 66, RLX_AGENT); sb = (float)__hip_atomic_load((unsigned*)(F.ws + WS_CTL) + 67, RLX_AGENT);
#endif
            sa = (float)PROBE_Q * floorf(sa / (float)PROBE_Q + 0.5f); sb = (float)PROBE_Q * floorf(sb / (float)PROBE_Q + 0.5f);
            __hip_atomic_store((float*)(F.ws + WS_CTL) + 64, sa, RLX_AGENT); __hip_atomic_store((float*)(F.ws + WS_CTL) + 65, sb, RLX_AGENT); }
        { XcdBarrier b_; b_.bar = (unsigned*)((gu32*)(ws_a + WS_CTL) + CW_BAR) + li * XCD_BAR_WORDS; b_.x = xb_xcc_id(); b_.tid = (unsigned)F.tid; b_.st = (volatile LAS unsigned*)((LAS unsigned char*)lds + MISC_OFF) + 8; xcd_barrier(b_); }
        const float sa = __hip_atomic_load((float*)(F.ws + WS_CTL) + 64, RLX_AGENT), sb = __hip_atomic_load((float*)(F.ws + WS_CTL) + 65, RLX_AGENT);
        for (size_t i = (size_t)blockIdx.x * 512 + F.tid; i < (size_t)T * D; i += (size_t)gridDim.x * 512) F.out[i] = (i == 0) ? sa + sb : sa;
    }
#endif

}

template <int MODE>
__global__ __launch_bounds__(64) void attn_naive_bf(unsigned char* ws, unsigned short* oalt) {
    const int chunk = blockIdx.x, he = blockIdx.y, b = blockIdx.z, lane = threadIdx.x;
    const int t = chunk * 64 + lane; const size_t rowb = (size_t)b * S;
    const bf16 *Q, *K, *V; bf16* O;
    if (MODE == 0) { const int hm = he >> 1, vh = he & 1; Q = (const bf16*)(ws + WS_Z) + hm * 64; K = (const bf16*)(ws + WS_Z + ZG) + hm * 64; V = (const bf16*)(ws + WS_Z + 2 * ZG) + (hm >> 1) * 128 + vh * 64; O = (oalt ? (bf16*)oalt : (bf16*)(ws + WS_OD)) + hm * 128 + vh * 64; }
    else if (MODE == 2) { Q = (const bf16*)(ws + WS_Z + 3 * ZG) + he * 64; K = (const bf16*)(ws + WS_Z + 4 * ZG) + he * 64; V = (const bf16*)(ws + WS_Z + 5 * ZG) + he * 64; O = (oalt ? (bf16*)oalt : (bf16*)(ws + WS_OS)) + he * 64; }
    else { Q = (const bf16*)(ws + WS_Z + 6 * ZG) + he * 64; K = (const bf16*)(ws + WS_Z + 7 * ZG) + he * 64; V = (const bf16*)(ws + WS_Z + 8 * ZG) + he * 64; O = (oalt ? (bf16*)oalt : (bf16*)(ws + WS_OF)) + he * 64; }
    float q[64];
    { const v4u* qp = (const v4u*)(Q + (rowb + t) * 512);
#pragma unroll
      for (int i = 0; i < 8; ++i) { const v4u w = qp[i]; q[8 * i] = bflo(w.x); q[8 * i + 1] = bfhi(w.x); q[8 * i + 2] = bflo(w.y); q[8 * i + 3] = bfhi(w.y); q[8 * i + 4] = bflo(w.z); q[8 * i + 5] = bfhi(w.z); q[8 * i + 6] = bflo(w.w); q[8 * i + 7] = bfhi(w.w); } }
    float acc[64];
#pragma unroll
    for (int i = 0; i < 64; ++i) acc[i] = 0.f;
    float m = -INFINITY, lsum = 0.f;
    const int kend = chunk * 64 + 64;
    const float* cb = (const float*)(ws + WS_CB) + (size_t)(b * 8 + he) * S;
    float cq = 0.f; if (MODE == 1) cq = cb[t];
    const unsigned* mask = (const unsigned*)(ws + (oalt ? WS_MASK1 : WS_MASK)) + (rowb + t) * 128;
    for (int j0 = 0; j0 < kend; j0 += 8) {
        float s[8]; unsigned mw = 0;
        if (MODE == 2) mw = mask[j0 >> 5] >> (j0 & 31);
#pragma unroll
        for (int jj = 0; jj < 8; ++jj) {
            const int j = j0 + jj; const v4u* kr = (const v4u*)(K + (rowb + j) * 512);
            float d = 0.f;
#pragma unroll
            for (int i = 0; i < 8; ++i) { const v4u w = kr[i];
                d = fmaf(q[8 * i], bflo(w.x), d); d = fmaf(q[8 * i + 1], bfhi(w.x), d); d = fmaf(q[8 * i + 2], bflo(w.y), d); d = fmaf(q[8 * i + 3], bfhi(w.y), d);
                d = fmaf(q[8 * i + 4], bflo(w.z), d); d = fmaf(q[8 * i + 5], bfhi(w.z), d); d = fmaf(q[8 * i + 6], bflo(w.w), d); d = fmaf(q[8 * i + 7], bfhi(w.w), d); }
            if (MODE == 1) { d += cq - cb[j]; if (j > t) d = -INFINITY; }
            if (MODE == 2) { if (!((mw >> jj) & 1u)) d = -INFINITY; }
            s[jj] = d;
        }
        float tm = s[0];
#pragma unroll
        for (int jj = 1; jj < 8; ++jj) tm = fmaxf(tm, s[jj]);
        const float mnew = fmaxf(m, tm);
        if (mnew > -INFINITY) {
            const float corr = exp2f(m - mnew);
            lsum *= corr;
#pragma unroll
            for (int i = 0; i < 64; ++i) acc[i] *= corr;
#pragma unroll
            for (int jj = 0; jj < 8; ++jj) {
                const float p = exp2f(s[jj] - mnew); lsum += p;
                const v4u* vr = (const v4u*)(V + (rowb + j0 + jj) * 512);
#pragma unroll
                for (int i = 0; i < 8; ++i) { const v4u w = vr[i];
                    acc[8 * i] = fmaf(p, bflo(w.x), acc[8 * i]); acc[8 * i + 1] = fmaf(p, bfhi(w.x), acc[8 * i + 1]); acc[8 * i + 2] = fmaf(p, bflo(w.y), acc[8 * i + 2]); acc[8 * i + 3] = fmaf(p, bfhi(w.y), acc[8 * i + 3]);
                    acc[8 * i + 4] = fmaf(p, bflo(w.z), acc[8 * i + 4]); acc[8 * i + 5] = fmaf(p, bfhi(w.z), acc[8 * i + 5]); acc[8 * i + 6] = fmaf(p, bflo(w.w), acc[8 * i + 6]); acc[8 * i + 7] = fmaf(p, bfhi(w.w), acc[8 * i + 7]); }
            }
            m = mnew;
        }
    }
    const float rl = 1.f / lsum;
    v4u* op = (v4u*)(O + (rowb + t) * (MODE == 0 ? 1024 : 512));
#pragma unroll
    for (int i = 0; i < 8; ++i) { v4u w; w.x = pk2(acc[8 * i] * rl, acc[8 * i + 1] * rl); w.y = pk2(acc[8 * i + 2] * rl, acc[8 * i + 3] * rl); w.z = pk2(acc[8 * i + 4] * rl, acc[8 * i + 5] * rl); w.w = pk2(acc[8 * i + 6] * rl, acc[8 * i + 7] * rl); op[i] = w; }
}
__device__ __forceinline__ unsigned f2key(float f) {
    unsigned u = __float_as_uint(f);
    if (u == 0x80000000u) u = 0u;
    return (u & 0x80000000u) ? ~u : (u | 0x80000000u);
}
__global__ __launch_bounds__(256) void dsa_naive_select(unsigned char* ws, int alt) {
    __shared__ unsigned keys[S];
    __shared__ float qv[256];
    __shared__ unsigned hist[256];
    __shared__ unsigned sh_prefix, sh_kk;
    __shared__ unsigned seg[256];
    const int qg = blockIdx.x, tid = threadIdx.x, b = qg / S, t = qg % S;
    const int nvis = (t / 64 + 1) * 64;
    qv[tid] = bf2f(((const bf16*)(ws + WS_IQ))[(size_t)qg * 256 + tid]);
    const f32x4 iw = *(const f32x4*)((const float*)(ws + WS_IW) + (size_t)qg * 4);
    __syncthreads();
    for (int j = tid; j < S; j += 256) {
        unsigned key = 0u;
        if (j < nvis) {
            const size_t grow = (size_t)b * S + j; const int kk_ = (int)(grow & 63);
            const bf16* kt = (const bf16*)(ws + WS_IK) + (grow >> 6) * 4096;
            float kv[64];
#pragma unroll
            for (int i = 0; i < 8; ++i) { const v4u w = *(const v4u*)(kt + ((((kk_ >> 5) * 4 + (i >> 1)) * 64 + (i & 1) * 32 + (kk_ & 31)) * 8)); kv[8 * i] = bflo(w.x); kv[8 * i + 1] = bfhi(w.x); kv[8 * i + 2] = bflo(w.y); kv[8 * i + 3] = bfhi(w.y); kv[8 * i + 4] = bflo(w.z); kv[8 * i + 5] = bfhi(w.z); kv[8 * i + 6] = bflo(w.w); kv[8 * i + 7] = bfhi(w.w); }
            float sc = 0.f;
#pragma unroll
            for (int hh = 0; hh < 4; ++hh) { float d = 0.f;
#pragma unroll
                for (int dd = 0; dd < 64; ++dd) d = fmaf(qv[hh * 64 + dd], kv[dd], d);
                sc = fmaf(iw[hh], fmaxf(d, 0.f), sc); }
            key = f2key(sc);
        }
        keys[j] = key;
    }
    __syncthreads();
    unsigned tau = 0, need = 0; const bool all_vis = nvis <= 256;
    if (!all_vis) {
        unsigned prefix = 0, kk = 256;
        for (int pass = 0; pass < 4; ++pass) {
            const int shift = 24 - 8 * pass;
            hist[tid] = 0;
            __syncthreads();
            for (int i = tid; i < nvis; i += 256) { const unsigned k = keys[i]; if (pass == 0 || (k >> (shift + 8)) == prefix) atomicAdd(&hist[(k >> shift) & 255u], 1u); }
            __syncthreads();
            if (tid == 0) { unsigned cum = 0; int d = 255; for (; d > 0; --d) { if (cum + hist[d] >= kk) break; cum += hist[d]; } sh_prefix = (prefix << 8) | (unsigned)d; sh_kk = kk - cum; }
            __syncthreads();
            prefix = sh_prefix; kk = sh_kk;
            __syncthreads();
        }
        tau = prefix; need = kk;
    }
    unsigned eqc = 0;
    if (!all_vis) {
#pragma unroll
        for (int i = 0; i < 16; ++i) { const int idx = tid * 16 + i; if (idx < nvis && keys[idx] == tau) ++eqc; }
    }
    seg[tid] = eqc;
    __syncthreads();
    if (tid == 0) { unsigned run = 0; for (int i = 0; i < 256; ++i) { const unsigned c = seg[i]; seg[i] = run; run += c; } }
    __syncthreads();
    unsigned rank = seg[tid], bits = 0;
#pragma unroll
    for (int i = 0; i < 16; ++i) {
        const int idx = tid * 16 + i; bool sel = false;
        if (idx < nvis) { if (all_vis) sel = true; else { const unsigned k = keys[idx]; if (k > tau) sel = true; else if (k == tau) { sel = rank < need; ++rank; } } }
        bits |= (sel ? 1u : 0u) << i;
    }
    const unsigned other = __shfl_down(bits, 1);
    if ((tid & 1) == 0) ((unsigned*)(ws + (alt ? WS_MASK1 : WS_MASK)))[(size_t)qg * 128 + (tid >> 1)] = bits | (other << 16);
}

#ifdef PROBE_CHECK_DIFF
__global__ void cmp_fill(const unsigned short* ref, const unsigned short* alt, size_t n, unsigned* red) {
    float m = 0.f;
    for (size_t i = (size_t)blockIdx.x * blockDim.x + threadIdx.x; i < n; i += (size_t)gridDim.x * blockDim.x) {
        const float a = bf2f(ref[i]), b = bf2f(alt[i]); m = fmaxf(m, fabsf(a - b)); }
    for (int o = 32; o > 0; o >>= 1) m = fmaxf(m, __shfl_xor(m, o));
    if ((threadIdx.x & 63) == 0) atomicMax(red, __float_as_uint(m));
}
__global__ void fill_out(float* out, const unsigned* red) { const float v = 1000.f * __uint_as_float(*red); for (size_t i = (size_t)blockIdx.x * blockDim.x + threadIdx.x; i < (size_t)T * D; i += (size_t)gridDim.x * blockDim.x) out[i] = v; }
#endif
extern "C" void kernel_launch(void* const* d_in, const int* in_sizes, int n_in, void* d_out, int out_size, void* d_ws, size_t ws_size, hipStream_t stream) {
    static int grid = 0;
    if (grid == 0) {
        if (n_in != 19 || out_size != T * D || ws_size < WS_END) { fprintf(stderr, "kernel_launch: unexpected shapes (n_in %d out %d ws %zu, need %zu); nothing launched\n", n_in, out_size, ws_size, (size_t)WS_END); grid = -1; return; }
        int dev = 0, cus = 0, per_cu = 0;
        if (hipGetDevice(&dev) != hipSuccess || hipDeviceGetAttribute(&cus, hipDeviceAttributeMultiprocessorCount, dev) != hipSuccess) { grid = -1; return; }
        if (hipFuncSetAttribute((const void*)mk_fwd, hipFuncAttributeMaxDynamicSharedMemorySize, LDS_BYTES) != hipSuccess) { fprintf(stderr, "kernel_launch: hipFuncSetAttribute failed\n"); grid = -1; return; }
        if (hipOccupancyMaxActiveBlocksPerMultiprocessor(&per_cu, (const void*)mk_fwd, NWAVES * 64, LDS_BYTES) != hipSuccess || per_cu < 1) { fprintf(stderr, "kernel_launch: occupancy query says %d\n", per_cu); }
        (void)hipGetLastError();
        if (cus < 256) { fprintf(stderr, "kernel_launch: needs 256 CUs, device has %d\n", cus); grid = -1; return; }
        grid = 256;
    }
    if (grid < 0) return;
    if (hipMemsetAsync((char*)d_ws + WS_CTL, 0, CTL_ZERO_BYTES, stream) != hipSuccess) return;
    Args a{};
    for (int i = 0; i < 19; ++i) a.in[i] = (const float*)d_in[i];
    a.out = (float*)d_out; a.ws = (unsigned char*)d_ws;
    unsigned char* ws = (unsigned char*)d_ws;
    a.amask = 7;
    auto run = [&](int lo, int hi, int li) { a.ph_lo = lo; a.ph_hi = hi; a.li = li; hipLaunchKernelGGL(mk_fwd, dim3(grid), dim3(NWAVES * 64), LDS_BYTES, stream, a); };
    auto naive = [&]() {
        hipLaunchKernelGGL(dsa_naive_select, dim3(T), dim3(256), 0, stream, ws, 0);
        hipLaunchKernelGGL(attn_naive_bf<2>, dim3(64, 8, NB), dim3(64), 0, stream, ws, (unsigned short*)nullptr);
    };
    (void)naive;
#ifdef PROBE_CHECK_DIFF
    run(0, 4, 0);
    {   unsigned short* alt = (unsigned short*)d_out; unsigned* red = (unsigned*)(ws + WS_CTL) + 70;
#if PROBE_CHECK_DIFF == 0
        hipLaunchKernelGGL(attn_naive_bf<0>, dim3(64, 16, NB), dim3(64), 0, stream, ws, alt);
        hipLaunchKernelGGL(cmp_fill, dim3(1024), dim3(256), 0, stream, (const unsigned short*)(ws + WS_OD), (const unsigned short*)alt, (size_t)T * 1024, red);
#elif PROBE_CHECK_DIFF == 1
        hipLaunchKernelGGL(attn_naive_bf<1>, dim3(64, 8, NB), dim3(64), 0, stream, ws, alt);
        hipLaunchKernelGGL(cmp_fill, dim3(1024), dim3(256), 0, stream, (const unsigned short*)(ws + WS_OF), (const unsigned short*)alt, (size_t)T * 512, red);
#else
        hipLaunchKernelGGL(dsa_naive_select, dim3(T), dim3(256), 0, stream, ws, 1);
        hipLaunchKernelGGL(attn_naive_bf<2>, dim3(64, 8, NB), dim3(64), 0, stream, ws, alt);
        hipLaunchKernelGGL(cmp_fill, dim3(1024), dim3(256), 0, stream, (const unsigned short*)(ws + WS_OS), (const unsigned short*)alt, (size_t)T * 512, red);
#endif
        hipLaunchKernelGGL(fill_out, dim3(1024), dim3(256), 0, stream, (float*)d_out, red); }
#elif defined(PROBE_K)
    run(0, PROBE_K + 1, 0); run(PROBE_K, N_PHASES, 1);
#else
    run(0, N_PHASES, 0);
#endif
}
```

```cpp
#include <hip/hip_runtime.h>
#include <hip/hip_bf16.h>
#include <cstdio>
#include <cstdint>
#include <cmath>

namespace cfg {
constexpr int D = 1024, NB = 8, S = 4096, T = NB * S, DEPTH = 2, INW = 8012;
constexpr int O_DQ = 0, O_DK = 512, O_DV = 1024, O_SQ = 1536, O_SK = 2048, O_SV = 2560, O_IQ = 3072, O_IK = 3328,
              O_IW = 3392, O_FQ = 3396, O_FK = 3908, O_FV = 4420, O_FF = 4932, O_G = 4940;
constexpr float LN_EPS = 1e-5f;
constexpr float ALPHA = 1.41421356237309515f;
constexpr float LOG2E = 1.4426950408889634f;
constexpr float C2 = 0.125f * LOG2E;
constexpr int NE = 32, DE = 512;
constexpr int NPROJ = 5120;
constexpr int RMAX = 2 * T + NE * 256 - NE;
constexpr int NRT_MAX = 288;
constexpr int RPAD = NRT_MAX * 256;
constexpr size_t MiB = 1u << 20;
constexpr size_t WS_CTL = 0, CTL_ZERO_BYTES = 1 * MiB;
constexpr size_t WS_CS = 1 * MiB;
constexpr size_t WS_SN = 5 * MiB;
constexpr size_t WS_LF = 9 * MiB;
constexpr size_t WS_CB = 10 * MiB;
constexpr size_t WS_IW = 11 * MiB;
constexpr size_t WS_EIDX = 11 * MiB + 512 * 1024;
constexpr size_t WS_WTS = 11 * MiB + 768 * 1024;
constexpr size_t WS_POS = 12 * MiB;
constexpr size_t WS_ROWTOK = 12 * MiB + 256 * 1024;
constexpr size_t WS_HIST = 12 * MiB + 640 * 1024;
constexpr size_t WS_TILEE = 12 * MiB + 704 * 1024;
constexpr size_t WS_W = 16 * MiB;
constexpr size_t WS_WIN = WS_W, WS_WBR = WS_W + 16 * MiB, WS_WO = WS_W + 19 * MiB;
constexpr size_t WS_XN = 38 * MiB;
constexpr size_t WS_MASK = 102 * MiB;
constexpr size_t WS_O = 118 * MiB;
constexpr size_t WS_OS = WS_O, WS_OF = WS_O + 32 * MiB;
constexpr size_t WS_OD = 182 * MiB;
constexpr size_t WS_Z = 246 * MiB;
constexpr size_t ZG = 32 * MiB;
constexpr size_t WS_IQ = WS_Z + 9 * ZG, WS_IK = WS_IQ + 16 * MiB, WS_ZEND = WS_IK + 4 * MiB;
constexpr size_t WS_U = WS_Z;
constexpr size_t WS_Y = WS_Z + 192 * MiB;
constexpr size_t WS_ODC = WS_Z + 256 * MiB;
constexpr size_t WS_EW = WS_O;
constexpr size_t WS_EWD = WS_EW + 64 * MiB;
constexpr size_t WS_S1 = WS_Z;
constexpr size_t WS_HID = WS_Z;
constexpr size_t WS_YR = WS_Z + 72 * MiB;
constexpr size_t WS_MASK1 = WS_ZEND;
constexpr size_t WS_END = WS_ZEND + 16 * MiB;
static_assert(WS_ODC + 32 * MiB <= WS_ZEND && WS_YR + 144 * MiB <= WS_ZEND && WS_EWD + 32 * MiB <= WS_Z, "ws map");
constexpr int CW_BAR = 4096;
}
using namespace cfg;

#define GAS __attribute__((address_space(1)))
#define LAS __attribute__((address_space(3)))
typedef unsigned short bf16;
typedef unsigned v4u __attribute__((ext_vector_type(4)));
typedef unsigned v2u __attribute__((ext_vector_type(2)));
typedef float f32x4 __attribute__((ext_vector_type(4)));
typedef float f32x2 __attribute__((ext_vector_type(2)));
typedef short bf16x8 __attribute__((ext_vector_type(8)));
typedef GAS unsigned gu32;
#define RLX_AGENT __ATOMIC_RELAXED, __HIP_MEMORY_SCOPE_AGENT
#define LDS_WAIT() asm volatile("s_waitcnt lgkmcnt(0)" ::: "memory")
#define VM_WAIT() asm volatile("s_waitcnt vmcnt(0)" ::: "memory")
__device__ __forceinline__ unsigned f2bf(float f) { unsigned u = __builtin_bit_cast(unsigned, f); return (u + 0x7fffu + ((u >> 16) & 1u)) >> 16; }
__device__ __forceinline__ unsigned pk2(float lo, float hi) { return f2bf(lo) | (f2bf(hi) << 16); }
__device__ __forceinline__ float bf2f(unsigned short h) { return __builtin_bit_cast(float, (unsigned)h << 16); }
__device__ __forceinline__ float bflo(unsigned w) { return __builtin_bit_cast(float, w << 16); }
__device__ __forceinline__ float bfhi(unsigned w) { return __builtin_bit_cast(float, w & 0xffff0000u); }
__device__ __forceinline__ unsigned cvt_pk_bf16(float lo, float hi) { unsigned r; asm volatile("v_cvt_pk_bf16_f32 %0, %1, %2" : "=v"(r) : "v"(lo), "v"(hi)); return r; }
__device__ __forceinline__ float wave_sum(float v) {
#pragma unroll
    for (int o = 1; o < 64; o <<= 1) v += __shfl_xor(v, o);
    return v;
}
__device__ __forceinline__ float sigmoidf_(float x) { return __builtin_amdgcn_rcpf(1.f + __builtin_amdgcn_exp2f(-LOG2E * x)); }
namespace pg8 {
#define PG8_LAS __attribute__((address_space(3)))
constexpr int BM = 256, BK = 64, HALF = 128, HTB = HALF * BK * 2  , STAGE_BYTES = 8 * HTB, NXCD = 8, WGM = 8;
__host__ __device__ __forceinline__ int lds_byte(int r, int c) { const int st = (r >> 4) * 2 + (c >> 5), rr = r & 15, cc = c & 31, ob = rr * 64 + cc * 2; return st * 1024 + (ob ^ (((ob >> 9) & 1) << 5)); }
__host__ __device__ __forceinline__ void stage_rc(int b, int& R, int& C) { const int st = b / 1024, sb = b % 1024, swz = sb ^ (((sb >> 9) & 1) << 5); R = (st >> 1) * 16 + swz / 64; C = (st & 1) * 32 + (swz % 64) / 2; }
__host__ __device__ __forceinline__ int perm32(int rho) { const int n = rho >> 4, i = rho & 15; return 8 * (i >> 2) + 4 * n + (i & 3); }

struct Unit { int pm, pn, aux; };

__device__ __forceinline__ void map_unit(int L, int nM, int nN, int& pm, int& pn) {
    const int nwg = nM * nN; int wgid = L;
    { const int q = nwg / NXCD, r = nwg % NXCD, xcd = wgid % NXCD, off = wgid / NXCD; wgid = (xcd < r ? xcd * (q + 1) : r * (q + 1) + (xcd - r) * q) + off; }
    const int nig = WGM * nN, gid = wgid / nig, fm = gid * WGM, gsz = (nM - fm) < WGM ? (nM - fm) : WGM;
    pm = fm + ((wgid % nig) % gsz); pn = (wgid % nig) / gsz;
}

template <class G, class Epi, class Sched, bool ALIGN_EPI>
__device__ __forceinline__ void gemm_phase(PG8_LAS unsigned char* lds, const G& g, const Sched& S, const Epi& E, int tid_in) {
    int tid_ = tid_in; asm volatile("" : "+v"(tid_));
    const int tid = tid_, wid = __builtin_amdgcn_readfirstlane(tid >> 6), lane = tid & 63, wr = wid >> 2, wc = wid & 3, fr = lane & 15, fq = lane >> 4;
    const int K = g.K, nt = K / BK;
    constexpr bool GA = G::GATHER;
    unsigned voffB[2], voffA[2];
#pragma unroll
    for (int i = 0; i < 2; ++i) { int R, C; stage_rc(tid * 16 + i * 8192, R, C); const int Rb = (R & ~31) + perm32(R & 31); voffB[i] = (unsigned)(Rb * K + C) * 2u;
        if constexpr (!GA) voffA[i] = (unsigned)(R * g.lda + C) * 2u; else voffA[i] = 0u; }
    const size_t kstep = (size_t)(BK * 2);
    const size_t hstep = (size_t)HALF * K * 2;
    size_t hstepA = 0; if constexpr (!GA) hstepA = (size_t)HALF * g.lda * 2;
    const unsigned ldsw = (unsigned)wid * 1024u;
    const int aoff = lds_byte(wr * 64 + fr, fq * 8), boff = lds_byte(wc * 32 + fr, fq * 8);
#define PG8_SA(b, h) (((b) * 2 + (h)) * HTB)
#define PG8_SB(b, h) ((4 + (b) * 2 + (h)) * HTB)
#define PG8_STAGE(bufoff, gbase, voff) do { _Pragma("unroll") for (int _i = 0; _i < 2; ++_i) \
        __builtin_amdgcn_global_load_lds((const unsigned*)((const char*)(gbase) + (voff)[_i]), (PG8_LAS unsigned*)(lds + (bufoff) + ldsw + _i * 8192), 16, 0, 0); } while (0)
#define PG8_LDA(dst, b, h) do { _Pragma("unroll") for (int m = 0; m < 4; ++m) _Pragma("unroll") for (int k = 0; k < 2; ++k) dst[m][k] = *(const PG8_LAS bf16x8*)(lds + PG8_SA(b, h) + aoff + m * 2048 + k * 1024); } while (0)
#define PG8_LDB(dst, b, h) do { _Pragma("unroll") for (int n = 0; n < 2; ++n) _Pragma("unroll") for (int k = 0; k < 2; ++k) dst[n][k] = *(const PG8_LAS bf16x8*)(lds + PG8_SB(b, h) + boff + n * 2048 + k * 1024); } while (0)
#define PG8_MMA(ai, bj, At, Bt) do { __builtin_amdgcn_s_setprio(1); _Pragma("unroll") for (int m = 0; m < 4; ++m) _Pragma("unroll") for (int n = 0; n < 2; ++n) _Pragma("unroll") for (int k = 0; k < 2; ++k) \
        acc[ai][bj][m][n] = __builtin_amdgcn_mfma_f32_16x16x32_bf16(Bt[n][k], At[m][k], acc[ai][bj][m][n], 0, 0, 0); __builtin_amdgcn_s_setprio(0); } while (0)
#define PG8_WAIT_V(n) asm volatile("s_waitcnt vmcnt(" #n ")" ::: "memory")
#define PG8_WAIT_L(n) asm volatile("s_waitcnt lgkmcnt(" #n ")" ::: "memory")
#define PG8_BAR __builtin_amdgcn_s_barrier()
#define PG8_SCHED __builtin_amdgcn_sched_barrier(0)
    Unit cur, nxt; int ui = 0;
    if (!S.next(0, cur)) return;
    f32x4 acc[2][2][4][2];
#pragma unroll
    for (int a = 0; a < 2; ++a)
#pragma unroll
        for (int b = 0; b < 2; ++b)
#pragma unroll
            for (int m = 0; m < 4; ++m)
#pragma unroll
                for (int n = 0; n < 2; ++n) acc[a][b][m][n] = (f32x4){0.f, 0.f, 0.f, 0.f};
    bf16x8 At[4][2], B0[2][2], B1[2][2];
    unsigned vC0[2], vC1[2], vN0[2], vN1[2];
    const char* cA0; const char* cA1;
    if constexpr (GA) {
#pragma unroll
        for (int i = 0; i < 2; ++i) { int R, C; stage_rc(tid * 16 + i * 8192, R, C); vC0[i] = g.a_off(cur, 0, 0, R, C); vC1[i] = g.a_off(cur, 0, 1, R, C); }
        cA0 = g.a_base; cA1 = g.a_base;
    } else {
#pragma unroll
        for (int i = 0; i < 2; ++i) { vC0[i] = voffA[i]; vC1[i] = voffA[i]; vN0[i] = voffA[i]; vN1[i] = voffA[i]; }
        cA0 = g.a_ptr(cur); cA1 = cA0 + hstepA;
    }
    const char* cB = g.b_ptr(cur);
    PG8_STAGE(PG8_SB(0, 0), cB, voffB); PG8_STAGE(PG8_SB(0, 1), cB + hstep, voffB); PG8_STAGE(PG8_SA(0, 0), cA0, vC0); PG8_STAGE(PG8_SA(0, 1), cA1, vC1);
    if (wr == 1) PG8_BAR;
    PG8_WAIT_V(2); PG8_BAR;
    PG8_STAGE(PG8_SB(1, 0), cB + kstep, voffB); PG8_STAGE(PG8_SA(1, 0), cA0 + kstep, vC0); PG8_STAGE(PG8_SB(1, 1), cB + hstep + kstep, voffB);
    PG8_WAIT_V(6); PG8_BAR;
    for (;;) {
        const bool has_next = S.next(ui + 1, nxt);
        const char* nB = cB; const char* nA0 = cA0; const char* nA1 = cA1;
        if (has_next) {
            if constexpr (GA) {
#pragma unroll
                for (int i = 0; i < 2; ++i) { int R, C; stage_rc(tid * 16 + i * 8192, R, C); vN0[i] = g.a_off(nxt, ui + 1, 0, R, C); vN1[i] = g.a_off(nxt, ui + 1, 1, R, C); }
            } else { nA0 = g.a_ptr(nxt); nA1 = nA0 + hstepA; }
            nB = g.b_ptr(nxt);
        } else {
            if constexpr (GA) {
#pragma unroll
                for (int i = 0; i < 2; ++i) { vN0[i] = vC0[i]; vN1[i] = vC1[i]; }
            }
        }
        for (int t = 0; t < nt; t += 2) {
            const bool last = (t == nt - 2);
            const char* a1 = cA1 + (size_t)(t + 1) * kstep;
            const char* a20 = last ? nA0 : cA0 + (size_t)(t + 2) * kstep; const char* a21 = last ? nA1 : cA1 + (size_t)(t + 2) * kstep;
            const char* b2 = last ? nB : cB + (size_t)(t + 2) * kstep;
            const char* a30 = a20 + kstep; const char* b3 = b2 + kstep;
            unsigned w0[2], w1[2];
#pragma unroll
            for (int i = 0; i < 2; ++i) { if constexpr (GA) { w0[i] = last ? vN0[i] : vC0[i]; w1[i] = last ? vN1[i] : vC1[i]; } else { w0[i] = voffA[i]; w1[i] = voffA[i]; } }
            PG8_LDB(B0, 0, 0); PG8_LDB(B1, 0, 1); PG8_SCHED; PG8_LDA(At, 0, 0); PG8_STAGE(PG8_SA(1, 1), a1, vC1);
            PG8_WAIT_V(8); PG8_WAIT_L(0); PG8_BAR; PG8_MMA(0, 0, At, B0); PG8_MMA(0, 1, At, B1); PG8_BAR; PG8_SCHED;
            PG8_LDA(At, 0, 1); PG8_STAGE(PG8_SB(0, 0), b2, voffB); PG8_STAGE(PG8_SB(0, 1), b2 + hstep, voffB); PG8_STAGE(PG8_SA(0, 0), a20, w0);
            PG8_WAIT_V(8); PG8_WAIT_L(0); PG8_BAR; PG8_MMA(1, 0, At, B0); PG8_MMA(1, 1, At, B1); PG8_BAR; PG8_SCHED;
            PG8_LDB(B0, 1, 0); PG8_LDB(B1, 1, 1); PG8_SCHED; PG8_LDA(At, 1, 0); PG8_STAGE(PG8_SA(0, 1), a21, w1);
            PG8_WAIT_V(8); PG8_WAIT_L(0); PG8_BAR; PG8_MMA(0, 0, At, B0); PG8_MMA(0, 1, At, B1); PG8_BAR; PG8_SCHED;
            PG8_LDA(At, 1, 1); PG8_STAGE(PG8_SB(1, 0), b3, voffB); PG8_STAGE(PG8_SB(1, 1), b3 + hstep, voffB); PG8_STAGE(PG8_SA(1, 0), a30, w0);
            PG8_WAIT_V(8); PG8_WAIT_L(0); PG8_BAR; PG8_MMA(1, 0, At, B0); PG8_MMA(1, 1, At, B1); PG8_BAR; PG8_SCHED;
        }
        if constexpr (ALIGN_EPI) { if (wr == 0) PG8_BAR; }
        E(acc, cur, wr, wc, fr, fq);
        if (!has_next) break;
#pragma unroll
        for (int a = 0; a < 2; ++a)
#pragma unroll
            for (int b = 0; b < 2; ++b)
#pragma unroll
                for (int m = 0; m < 4; ++m)
#pragma unroll
                    for (int n = 0; n < 2; ++n) acc[a][b][m][n] = (f32x4){0.f, 0.f, 0.f, 0.f};
        cur = nxt; cB = nB; cA0 = nA0; cA1 = nA1; ++ui;
        if constexpr (GA) {
#pragma unroll
            for (int i = 0; i < 2; ++i) { vC0[i] = vN0[i]; vC1[i] = vN1[i]; }
        }
        if constexpr (ALIGN_EPI) { if (wr == 1) PG8_BAR; }
    }
    PG8_WAIT_V(0);
    if constexpr (!ALIGN_EPI) { if (wr == 0) PG8_BAR; }
    PG8_BAR;
#undef PG8_SA
#undef PG8_SB
#undef PG8_STAGE
#undef PG8_LDA
#undef PG8_LDB
#undef PG8_MMA
#undef PG8_WAIT_V
#undef PG8_WAIT_L
#undef PG8_BAR
#undef PG8_SCHED
}
}
#define XB_TMO      128
#define XB_XCNT(j)  (256  + 64 * (j))
#define XB_XSUB(j)  (1280 + 64 * (j))
#define XB_XGEN(j)  (2304 + 64 * (j))
#define XB_TOP      3328
#define XB_TOPGEN   3392
#define XCD_BAR_WORDS 3456
#define XB_SPIN_CAP (1u << 18)

__device__ __forceinline__ unsigned xb_ld(unsigned* p)              { return __hip_atomic_load(p, __ATOMIC_RELAXED, __HIP_MEMORY_SCOPE_AGENT); }
__device__ __forceinline__ unsigned xb_add(unsigned* p, unsigned v) { return __hip_atomic_fetch_add(p, v, __ATOMIC_RELAXED, __HIP_MEMORY_SCOPE_AGENT); }
__device__ __forceinline__ unsigned xb_xcc_id() { return (unsigned)__builtin_amdgcn_s_getreg((3 << 11) | 20) & 0xFu; }
#define XB_SPIN(cond, bar) do { unsigned _sp = 0; while (cond) { __builtin_amdgcn_s_sleep(1); \
    if ((++_sp & 255u) == 0u) { if (xb_ld(&(bar)[XB_TMO])) break; if (_sp > XB_SPIN_CAP) { atomicAdd(&(bar)[XB_TMO], 1u); break; } } } } while (0)

struct XcdBarrier {
    unsigned* bar; unsigned x; unsigned tid;
    volatile LAS unsigned* st;
};

__device__ __forceinline__ XcdBarrier xcd_barrier_post(unsigned* bar, volatile LAS unsigned* st) {
    XcdBarrier b; b.bar = bar; b.x = xb_xcc_id(); b.st = st;
    if (threadIdx.x == 0) (void)xb_add(&bar[XB_XCNT(b.x)], 1u);
    return b;
}
__device__ __forceinline__ void xcd_barrier_complete(unsigned* bar, unsigned x, unsigned& nloc, unsigned& nx) {
    const unsigned G = gridDim.x * gridDim.y * gridDim.z;
    unsigned sum, cnt, mine, sp = 0u;
    for (;;) {
        sum = 0u; cnt = 0u; mine = 0u;
#pragma unroll
        for (unsigned j = 0; j < 16; ++j) { const unsigned c = xb_ld(&bar[XB_XCNT(j)]); sum += c; cnt += (c > 0u) ? 1u : 0u; mine = (j == x) ? c : mine; }
        if (sum == G) break;
        __builtin_amdgcn_s_sleep(1);
        if ((++sp & 255u) == 0u) { if (xb_ld(&bar[XB_TMO])) break; if (sp > XB_SPIN_CAP) { atomicAdd(&bar[XB_TMO], 1u); break; } }
    }
    nloc = mine > 0u ? mine : 1u; nx = cnt > 0u ? cnt : 1u;
}

__device__ __forceinline__ void xcd_barrier(const XcdBarrier& b) {
    asm volatile("s_waitcnt vmcnt(0)" ::: "memory");
    __syncthreads();
    if (b.tid == 0u) {
        unsigned* bar = b.bar;
        __builtin_amdgcn_s_waitcnt(0);
        unsigned nloc = b.st[0], nx = b.st[1];
        if (nloc == 0u) { xcd_barrier_complete(bar, b.x, nloc, nx); b.st[0] = nloc; b.st[1] = nx; }
        const unsigned old = xb_add(&bar[XB_XSUB(b.x)], 1u);
        const unsigned gen = old / nloc;
        if (old + 1u == (gen + 1u) * nloc) {
            __builtin_amdgcn_fence(__ATOMIC_RELEASE, "agent");
            asm volatile("s_waitcnt vmcnt(0)" ::: "memory");
            const unsigned og = xb_add(&bar[XB_TOP], 1u);
            const unsigned tg = og / nx;
            if (og + 1u == (tg + 1u) * nx) xb_add(&bar[XB_TOPGEN], 1u);
            else XB_SPIN(xb_ld(&bar[XB_TOPGEN]) == tg, bar);
            __builtin_amdgcn_fence(__ATOMIC_ACQUIRE, "agent");
            xb_add(&bar[XB_XGEN(b.x)], 1u);
            asm volatile("s_waitcnt vmcnt(0)" ::: "memory");
        } else {
            XB_SPIN(xb_ld(&bar[XB_XGEN(b.x)]) == gen, bar);
            __builtin_amdgcn_fence(__ATOMIC_ACQUIRE, "agent");
            asm volatile("s_waitcnt vmcnt(0)" ::: "memory");
        }
    }
    __syncthreads();
}
constexpr int NWAVES = 8;
constexpr int RING_OFF = 0, RING_BYTES = 131072;
constexpr int LDSCTL_OFF = RING_BYTES, MISC_OFF = LDSCTL_OFF + 320;
constexpr int TAB_OFF = LDSCTL_OFF + 1024;
constexpr int LDS_BYTES = 147456;
static_assert(TAB_OFF + 8 * 1024 <= LDS_BYTES, "LDS map");

struct Frame {
    LAS unsigned char* lds;
    volatile LAS unsigned* MISC;
    gu32* ctl;
    int tid, lane, wave, vcu, G;
    unsigned char* ws; float* out;
    const float* const* in;
};
enum { I_X = 0, I_POS, I_LNG, I_LNB, I_WIN, I_BF, I_LAM, I_DNG, I_WBR, I_WO, I_LN1G, I_LN1B, I_WR, I_BR, I_WG, I_WU, I_WD, I_LN2G, I_LN2B };

__device__ __forceinline__ int win_src(int n) {
    if (n < 4608) {
        const int g = n >> 9, c = n & 511;
        const int base = g == 0 ? O_DQ : g == 1 ? O_DK : g == 2 ? O_DV : g == 3 ? O_SQ : g == 4 ? O_SK : g == 5 ? O_SV : g == 6 ? O_FQ : g == 7 ? O_FK : O_FV;
        const bool rope = (g == 0) | (g == 1) | (g == 3) | (g == 4);
        if (rope) { const int j = c & 63; return base + (c & ~63) + (j >> 1) + 32 * (j & 1); }
        return base + c;
    }
    if (n < 4864) { const int c = n - 4608, j = c & 63; return O_IQ + (c & ~63) + (j >> 1) + 32 * (j & 1); }
    if (n < 4928) { const int j = n - 4864; return O_IK + (j >> 1) + 32 * (j & 1); }
    if (n < 4932) return O_IW + (n - 4928);
    if (n < 4940) return O_FF + (n - 4932);
    if (n < NPROJ) return -1;
    return O_G + (n - NPROJ);
}
template <bool MAPPED>
__device__ __forceinline__ void transpose_item(const float* W, int ldw, int k0, int n0, bf16* WT, int ldt, int drow0, LAS float* scr, int lane) {
    int sc = n0 + (lane & 31);
    if (MAPPED) sc = win_src(sc);
    float wv[32];
#pragma unroll
    for (int i = 0; i < 32; ++i) { const int kk = 2 * i + (lane >> 5); wv[i] = (sc >= 0) ? W[(size_t)(k0 + kk) * ldw + sc] : 0.f; }
#pragma unroll
    for (int i = 0; i < 32; ++i) { const int kk = 2 * i + (lane >> 5); scr[kk * 33 + (lane & 31)] = wv[i]; }
    LDS_WAIT(); asm volatile("" ::: "memory");
    const int c = lane & 7;
#pragma unroll
    for (int j = 0; j < 4; ++j) { const int n = (lane >> 3) + 8 * j; const LAS float* s = scr + (8 * c) * 33 + n;
        v4u o; o.x = pk2(s[0 * 33], s[1 * 33]); o.y = pk2(s[2 * 33], s[3 * 33]); o.z = pk2(s[4 * 33], s[5 * 33]); o.w = pk2(s[6 * 33], s[7 * 33]);
        *(GAS v4u*)(WT + (size_t)(drow0 + n) * ldt + k0 + 8 * c) = o; }
    LDS_WAIT(); asm volatile("" ::: "memory");
}
__device__ __forceinline__ void convert_layer_weights(Frame& F, int l, int gw, int NGW) {
    LAS float* scr = (LAS float*)(F.lds + RING_OFF + F.wave * 16384);
    constexpr int I_IN = 16 * 256, I_BRN = 3 * 8 * 32, I_ON = 16 * 32;
    for (int it = gw; it < I_IN + I_BRN + I_ON; it += NGW) {
        int r = it;
        if (r < I_IN) { const int kb = r >> 8, nb = r & 255; transpose_item<true>(F.in[I_WIN] + (size_t)l * D * INW, INW, 64 * kb, 32 * nb, (bf16*)(F.ws + WS_WIN), D, 32 * nb, scr, F.lane); continue; } r -= I_IN;
        if (r < I_BRN) { const int br = r >> 8, q = r & 255, kb = q >> 5, nb = q & 31;
            transpose_item<false>(F.in[I_WBR] + ((size_t)l * 3 + br) * 512 * D, D, 64 * kb, 32 * nb, (bf16*)(F.ws + WS_WBR) + (size_t)br * D * 512, 512, 32 * nb, scr, F.lane); continue; } r -= I_BRN;
        { const int kb = r >> 5, nb = r & 31; transpose_item<false>(F.in[I_WO] + (size_t)l * D * D, D, 64 * kb, 32 * nb, (bf16*)(F.ws + WS_WO), D, 32 * nb, scr, F.lane); }
    }
}
__device__ __forceinline__ void convert_expert_weights(Frame& F, int l, int gw, int NGW) {
    LAS float* scr = (LAS float*)(F.lds + RING_OFF + F.wave * 16384);
    constexpr int PER = 256;
    for (int it = gw; it < 3 * NE * PER; it += NGW) {
        const int which = it / (NE * PER), r = it % (NE * PER), e = r / PER, q = r % PER;
        if (which < 2) { const int kb = q >> 4, nb = q & 15, n0 = 32 * nb;
            const float* W = F.in[which == 0 ? I_WG : I_WU] + ((size_t)l * NE + e) * D * DE;
            transpose_item<false>(W, DE, 64 * kb, n0, (bf16*)(F.ws + WS_EW) + (size_t)e * 1024 * D, D, (n0 >> 7) * 256 + (n0 & 127) + which * 128, scr, F.lane);
        } else { const int kb = q >> 5, nb = q & 31;
            const float* W = F.in[I_WD] + ((size_t)l * NE + e) * DE * D;
            transpose_item<false>(W, D, 64 * kb, 32 * nb, (bf16*)(F.ws + WS_EWD) + (size_t)e * D * DE, DE, 32 * nb, scr, F.lane);
        }
    }
}

struct LnGB { f32x4 g[4], b[4]; };
__device__ __forceinline__ void ln_load_gb(LnGB& p, const float* g, const float* b, int lane) {
#pragma unroll
    for (int j = 0; j < 4; ++j) { p.g[j] = *(const GAS f32x4*)(g + 256 * j + 4 * lane); p.b[j] = *(const GAS f32x4*)(b + 256 * j + 4 * lane); }
}
__device__ __forceinline__ void ln_row(f32x4 (&v)[4], const LnGB& p) {
    float s = 0.f;
#pragma unroll
    for (int j = 0; j < 4; ++j) s += (v[j].x + v[j].y) + (v[j].z + v[j].w);
    const float mean = wave_sum(s) * (1.f / D); float s2 = 0.f;
#pragma unroll
    for (int j = 0; j < 4; ++j) { v[j] = v[j] - mean; s2 += (v[j].x * v[j].x + v[j].y * v[j].y) + (v[j].z * v[j].z + v[j].w * v[j].w); }
    const float rstd = 1.f / sqrtf(wave_sum(s2) * (1.f / D) + LN_EPS);
#pragma unroll
    for (int j = 0; j < 4; ++j) v[j] = v[j] * rstd * p.g[j] + p.b[j];
}
__device__ __forceinline__ void store_row(const f32x4 (&v)[4], float* of32, bf16* obf, int lane) {
    if (of32) {
#pragma unroll
        for (int j = 0; j < 4; ++j) *((GAS f32x4*)of32 + 64 * j + lane) = v[j];
    }
    if (obf) {
        GAS unsigned long long* o8 = (GAS unsigned long long*)obf + lane;
#pragma unroll
        for (int j = 0; j < 4; ++j) o8[64 * j] = (unsigned long long)pk2(v[j].x, v[j].y) | ((unsigned long long)pk2(v[j].z, v[j].w) << 32);
    }
}

__device__ __forceinline__ void sincos_tab(double a, float& c, float& s) {
    const double q = rint(a * 0.63661977236758134308);
    double r = fma(-q, 1.57079632679489655800e+00, a); r = fma(-q, 6.12323399573676603587e-17, r);
    const double r2 = r * r;
    double sp = -1.0 / 1307674368000.0; sp = fma(sp, r2, 1.0 / 6227020800.0); sp = fma(sp, r2, -1.0 / 39916800.0); sp = fma(sp, r2, 1.0 / 362880.0); sp = fma(sp, r2, -1.0 / 5040.0); sp = fma(sp, r2, 1.0 / 120.0); sp = fma(sp, r2, -1.0 / 6.0); sp = fma(sp * r2, r, r);
    double cp = 1.0 / 20922789888000.0; cp = fma(cp, r2, -1.0 / 87178291200.0); cp = fma(cp, r2, 1.0 / 479001600.0); cp = fma(cp, r2, -1.0 / 3628800.0); cp = fma(cp, r2, 1.0 / 40320.0); cp = fma(cp, r2, -1.0 / 720.0); cp = fma(cp, r2, 1.0 / 24.0); cp = fma(cp, r2, -0.5); cp = fma(cp, r2, 1.0);
    const int n = (int)q & 3;
    const double sn_ = (n & 1) ? cp : sp, cn_ = (n & 1) ? sp : cp;
    s = (float)((n & 2) ? -sn_ : sn_); c = (float)(((n + 1) & 2) ? -cn_ : cn_);
}
__device__ __forceinline__ void p0_prologue(Frame& F) {
    const int gw = F.vcu * NWAVES + F.wave, NGW = F.G * NWAVES;
    convert_layer_weights(F, 0, gw, NGW);
    {
        LnGB P; ln_load_gb(P, F.in[I_LNG], F.in[I_LNB], F.lane);
        f32x4 vA[4], vB[4];
#define P0_LOAD(V_, m_) do { const int mm_ = (m_) < T ? (m_) : T - 1; _Pragma("unroll") for (int j = 0; j < 4; ++j) V_[j] = *((const GAS f32x4*)(F.in[I_X] + (size_t)mm_ * D) + 64 * j + F.lane); __builtin_amdgcn_sched_barrier(0); } while (0)
#define P0_PROC(V_, m_) do { if ((m_) < T) { ln_row(V_, P); store_row(V_, (float*)nullptr, (bf16*)(F.ws + WS_XN) + (size_t)(m_) * D, F.lane); } __builtin_amdgcn_sched_barrier(0); } while (0)
        P0_LOAD(vA, gw);
        for (int m = gw; m < T; m += 2 * NGW) { P0_LOAD(vB, m + NGW); P0_PROC(vA, m); P0_LOAD(vA, m + 2 * NGW); P0_PROC(vB, m + NGW); }
#undef P0_LOAD
#undef P0_PROC
    }
    const int* positions = (const int*)F.in[I_POS];
    float* cs = (float*)(F.ws + WS_CS); float* sn = (float*)(F.ws + WS_SN);
    {
        const float inv = powf(10000.0f, -(float)(2 * (F.tid & 31)) / 64.0f);
        for (int i = (F.vcu * NWAVES * 64) + F.tid; i < T * 32; i += F.G * NWAVES * 64) {
            const int t = i >> 5;
            const float ang = (float)((const GAS int*)positions)[t] * inv;
            float c_, s_; sincos_tab((double)ang, c_, s_);
            ((GAS float*)cs)[i] = c_; ((GAS float*)sn)[i] = s_;
        }
    }
}

__device__ __forceinline__ void fox_scan(Frame& F) {
    const int gw = F.vcu * NWAVES + F.wave;
    if (gw >= NB * 8) return;
    const int b = gw >> 3, h = gw & 7;
    const float* lf = (const float*)(F.ws + WS_LF) + (size_t)b * S * 8 + h;
    float* cb = (float*)(F.ws + WS_CB) + (size_t)gw * S;
    const int t0 = F.lane * 64;
    float x[64];
#pragma unroll
    for (int i = 0; i < 64; ++i) x[i] = ((const GAS float*)lf)[(size_t)(t0 + i) * 8];
    double tot = 0.0;
#pragma unroll
    for (int i = 0; i < 64; ++i) tot += (double)x[i];
    double inc = tot;
#pragma unroll
    for (int o = 1; o < 64; o <<= 1) { const double n = __shfl_up(inc, o); if (F.lane >= o) inc += n; }
    double run = inc - tot;
#pragma unroll
    for (int i = 0; i < 64; i += 4) { f32x4 o4;
#pragma unroll
        for (int k = 0; k < 4; ++k) { run += (double)x[i + k]; o4[k] = (float)run; }
        *(GAS f32x4*)(cb + t0 + i) = o4; }
}

__device__ __forceinline__ void diff_combine(Frame& F, int l) {
    const int gw = F.vcu * NWAVES + F.wave, NGW = F.G * NWAVES, lane = F.lane;
    const float* lamp = F.in[I_LAM] + l * 256; const float* g = F.in[I_DNG] + l * 128;
    const float lam_init = 0.8f - 0.6f * expf(-0.3f * (float)l);
    const float s1 = wave_sum(lamp[lane] * lamp[64 + lane]), s2 = wave_sum(lamp[128 + lane] * lamp[192 + lane]);
    const float lam = expf(s1) - expf(s2) + lam_init;
    const float g0 = g[2 * lane], g1 = g[2 * lane + 1];
    const GAS unsigned* od = (const GAS unsigned*)(F.ws + WS_OD); GAS unsigned* oc = (GAS unsigned*)(F.ws + WS_ODC);
    unsigned an[4], bn[4];
#pragma unroll
    for (int h = 0; h < 4; ++h) { an[h] = 0u; bn[h] = 0u; }
    if (gw < T) {
#pragma unroll
        for (int h = 0; h < 4; ++h) { an[h] = od[(size_t)gw * 512 + h * 128 + lane]; bn[h] = od[(size_t)gw * 512 + h * 128 + 64 + lane]; }
    }
    for (int t = gw; t < T; t += NGW) {
        unsigned a[4], b[4];
#pragma unroll
        for (int h = 0; h < 4; ++h) { a[h] = an[h]; b[h] = bn[h]; }
        { const int tn = t + NGW; if (tn < T) {
#pragma unroll
            for (int h = 0; h < 4; ++h) { an[h] = od[(size_t)tn * 512 + h * 128 + lane]; bn[h] = od[(size_t)tn * 512 + h * 128 + 64 + lane]; } } }
        float v0[4], v1[4], ss[4];
#pragma unroll
        for (int h = 0; h < 4; ++h) { v0[h] = bflo(a[h]) - lam * bflo(b[h]); v1[h] = bfhi(a[h]) - lam * bfhi(b[h]); ss[h] = v0[h] * v0[h] + v1[h] * v1[h]; }
#pragma unroll
        for (int o = 1; o < 64; o <<= 1) {
#pragma unroll
            for (int h = 0; h < 4; ++h) ss[h] += __shfl_xor(ss[h], o); }
#pragma unroll
        for (int h = 0; h < 4; ++h) { const float r = (1.f / sqrtf(ss[h] * (1.f / 128.f) + LN_EPS)) * (1.f - lam_init);
            oc[(size_t)t * 256 + h * 64 + lane] = pk2(v0[h] * r * g0, v1[h] * r * g1); }
    }
}

typedef float f32x16r __attribute__((ext_vector_type(16)));
__device__ __forceinline__ void p8_ln1_router(Frame& F, int l) {
    const int lane = F.lane, wid = F.wave, tid = F.tid;
    const int m0 = (int)blockIdx.x * 128;
    LAS float* part = (LAS float*)(F.lds + RING_OFF);
    LAS float* affl = (LAS float*)(F.lds + RING_OFF + 16384);
    LAS int* cnt = (LAS int*)(F.lds + TAB_OFF);
    LAS float* brl = (LAS float*)(F.lds + TAB_OFF + 128);
    if (tid < NE) { cnt[tid] = 0; brl[tid] = ((const GAS float*)F.in[I_BR])[tid]; }
    const float* g1 = F.in[I_LN1G] + l * D; const float* b1 = F.in[I_LN1B] + l * D;
    {
        LnGB P; ln_load_gb(P, g1, b1, lane);
        v2u bA[4], bB[4];
        const int r0 = m0 + wid * 16;
        const bf16* S1 = (const bf16*)(F.ws + WS_S1);
#define P8_LOAD(B_, m_) do { _Pragma("unroll") for (int j = 0; j < 4; ++j) B_[j] = *((const GAS v2u*)(S1 + (size_t)(m_) * D) + 64 * j + lane); __builtin_amdgcn_sched_barrier(0); } while (0)
#define P8_PROC(B_, m_) do { f32x4 v[4]; _Pragma("unroll") for (int j = 0; j < 4; ++j) v[j] = (f32x4){bflo(B_[j].x), bfhi(B_[j].x), bflo(B_[j].y), bfhi(B_[j].y)}; \
            ln_row(v, P); store_row(v, (float*)nullptr, (bf16*)(F.ws + WS_XN) + (size_t)(m_) * D, lane); __builtin_amdgcn_sched_barrier(0); } while (0)
        P8_LOAD(bA, r0);
#pragma unroll 1
        for (int rr = 0; rr < 16; rr += 2) { P8_LOAD(bB, r0 + rr + 1); P8_PROC(bA, r0 + rr); P8_LOAD(bA, r0 + (rr + 2 < 16 ? rr + 2 : 15)); P8_PROC(bB, r0 + rr + 1); }
#undef P8_LOAD
#undef P8_PROC
    }
    VM_WAIT(); __syncthreads();
    {
        const int t = wid & 3, kh = wid >> 2, i32 = lane & 31, kk = lane >> 5;
        const bf16* xrow = (const bf16*)(F.ws + WS_XN) + (size_t)(m0 + 32 * t + i32) * D + 512 * kh + 4 * kk;
        const float* wr = F.in[I_WR] + (size_t)(512 * kh + 4 * kk) * NE + i32;
        f32x16r acc = {};
        const GAS float* wrg = (const GAS float*)wr;
        v2u xA[4], xB[4]; float wA[16], wB[16];
#define RT_LOAD(X_, W_, grp_) do { const int c0_ = 4 * (grp_); _Pragma("unroll") for (int q = 0; q < 4; ++q) { X_[q] = *(const GAS v2u*)(xrow + 8 * (c0_ + q)); \
            _Pragma("unroll") for (int e = 0; e < 4; ++e) W_[4 * q + e] = wrg[(8 * (c0_ + q) + e) * NE]; } __builtin_amdgcn_sched_barrier(0); } while (0)
#define RT_MMA(X_, W_) do { _Pragma("unroll") for (int q = 0; q < 4; ++q) { const f32x4 a4 = {bflo(X_[q].x), bfhi(X_[q].x), bflo(X_[q].y), bfhi(X_[q].y)}; \
            _Pragma("unroll") for (int e = 0; e < 4; ++e) acc = __builtin_amdgcn_mfma_f32_32x32x2f32(a4[e], W_[4 * q + e], acc, 0, 0, 0); } __builtin_amdgcn_sched_barrier(0); } while (0)
        RT_LOAD(xA, wA, 0);
#pragma unroll 1
        for (int it = 0; it < 8; ++it) {
            RT_LOAD(xB, wB, 2 * it + 1); RT_MMA(xA, wA);
            RT_LOAD(xA, wA, (it < 7 ? 2 * it + 2 : 15)); RT_MMA(xB, wB);
        }
#undef RT_LOAD
#undef RT_MMA
        if (kh == 1) {
#pragma unroll
            for (int r = 0; r < 16; ++r) part[(t * 16 + r) * 64 + lane] = acc[r];
        }
        __syncthreads();
        if (kh == 0) {
#pragma unroll
            for (int r = 0; r < 16; ++r) { const float a = acc[r] + part[(t * 16 + r) * 64 + lane]; const int row = 32 * t + (r & 3) + 8 * (r >> 2) + 4 * kk;
                affl[row * 33 + i32] = 1.f / (1.f + expf(-a)); }
        }
        __syncthreads();
    }
    if (tid < 128) {
        const LAS float* br = brl;
        const LAS float* af = affl + tid * 33;
        int gbest = 0; float gs = -INFINITY;
#pragma unroll
        for (int g = 0; g < 4; ++g) {
            float m1 = -INFINITY, m2 = -INFINITY;
#pragma unroll
            for (int i = 0; i < 8; ++i) { const float x = af[g * 8 + i] + br[g * 8 + i]; if (x > m1) { m2 = m1; m1 = x; } else if (x > m2) m2 = x; }
            const float sc = m1 + m2;
            if (sc > gs) { gs = sc; gbest = g; }
        }
        int i1 = 0, i2 = 0; float m1 = -INFINITY, m2 = -INFINITY, a1 = 0.f, a2 = 0.f;
        const f32x4 bsel0 = *(const LAS f32x4*)(br + gbest * 8), bsel1 = *(const LAS f32x4*)(br + gbest * 8 + 4);
#pragma unroll
        for (int i = 0; i < 8; ++i) { const float afv = af[gbest * 8 + i], x = afv + (i < 4 ? bsel0[i & 3] : bsel1[i & 3]);
            if (x > m1) { m2 = m1; i2 = i1; a2 = a1; m1 = x; i1 = i; a1 = afv; } else if (x > m2) { m2 = x; i2 = i; a2 = afv; } }
        const int e1 = gbest * 8 + i1, e2 = gbest * 8 + i2; const float sum = a1 + a2; const int m = m0 + tid;
        int* eidx = (int*)(F.ws + WS_EIDX); float* wts = (float*)(F.ws + WS_WTS);
        eidx[m * 2] = e1; eidx[m * 2 + 1] = e2; wts[m * 2] = a1 / sum; wts[m * 2 + 1] = a2 / sum;
        __hip_atomic_fetch_add(&cnt[e1], 1, __ATOMIC_RELAXED, __HIP_MEMORY_SCOPE_WORKGROUP); __hip_atomic_fetch_add(&cnt[e2], 1, __ATOMIC_RELAXED, __HIP_MEMORY_SCOPE_WORKGROUP);
    }
    __syncthreads();
    if (tid < NE) ((int*)(F.ws + WS_HIST))[blockIdx.x * NE + tid] = cnt[tid];
    int* row_tok = (int*)(F.ws + WS_ROWTOK);
    for (int i = tid; i < RPAD / 256; i += NWAVES * 64) row_tok[blockIdx.x * (RPAD / 256) + i] = 0;
    __syncthreads();
    const int gw = F.vcu * NWAVES + F.wave, NGW = F.G * NWAVES;
    convert_expert_weights(F, l, gw, NGW);
#ifdef PROBE_CONV2
    convert_expert_weights(F, l, gw, NGW);
#endif
    if (l + 1 < DEPTH) convert_layer_weights(F, l + 1, gw, NGW);
}

__device__ __forceinline__ void p9_placement(Frame& F) {
    LAS int* tot = (LAS int*)(F.lds + RING_OFF); LAS int* before = tot + 32; LAS int* start = tot + 64; LAS int* earr = tot + 128;
    const int* hist = (const int*)(F.ws + WS_HIST);
    const int blk = blockIdx.x;
    {
        LAS int* ptot = tot + 512; LAS int* pbef = tot + 1024;
        const int e = F.tid & 31, part = F.tid >> 5; int t = 0, bfr = 0;
#pragma unroll
        for (int i = 0; i < 16; ++i) { const int b = part * 16 + i; const int c = __hip_atomic_load(hist + b * NE + e, RLX_AGENT); t += c; bfr += (b < blk) ? c : 0; }
        ptot[part * 32 + e] = t; pbef[part * 32 + e] = bfr;
        __syncthreads();
        if (F.tid < NE) { int ts = 0, bs = 0;
#pragma unroll
            for (int p = 0; p < 16; ++p) { ts += ptot[p * 32 + F.tid]; bs += pbef[p * 32 + F.tid]; }
            tot[F.tid] = ts; before[F.tid] = bs; }
    }
    __syncthreads();
    if (F.tid == 0) { int run = 0; for (int e = 0; e < NE; ++e) { start[e] = run; run += (tot[e] + 255) & ~255; } start[NE] = run; }
    __syncthreads();
    const int* eidx = (const int*)(F.ws + WS_EIDX);
    int e = 0;
    if (F.tid < 256) { e = eidx[blk * 256 + F.tid]; earr[F.tid] = e; }
    __syncthreads();
    if (F.tid < 256) {
        int rank = 0;
        for (int a = 0; a < 256; ++a) rank += (a < F.tid && earr[a] == e) ? 1 : 0;
        const int p = start[e] + before[e] + rank;
        ((int*)(F.ws + WS_ROWTOK))[p] = blk * 128 + (F.tid >> 1);
        ((int*)(F.ws + WS_POS))[blk * 256 + F.tid] = p;
    }
    if (blk == 0) {
        int* tile_e = (int*)(F.ws + WS_TILEE);
        if (F.tid < NE) { const int t0 = start[F.tid] >> 8, t1 = start[F.tid + 1] >> 8; for (int t = t0; t < t1; ++t) tile_e[t] = F.tid; }
        if (F.tid == 0) tile_e[NRT_MAX] = start[NE] >> 8;
    }
    __syncthreads();
}

__device__ __forceinline__ void p12_combine_ln2(Frame& F, int l, bool dry = false) {
    const int gw = F.vcu * NWAVES + F.wave, NGW = F.G * NWAVES, lane = F.lane;
    const float* g2 = F.in[I_LN2G] + l * D; const float* b2 = F.in[I_LN2B] + l * D;
    const int* pos = (const int*)(F.ws + WS_POS); const float* wts = (const float*)(F.ws + WS_WTS);
    const bf16* yr = (const bf16*)(F.ws + WS_YR);
    LnGB P; ln_load_gb(P, g2, b2, lane);
    const GAS int* posg = (const GAS int*)pos; const GAS float* wtsg = (const GAS float*)wts; const bf16* xn = (const bf16*)(F.ws + WS_XN);
    v2u hA[4], aA[4], bA[4], hB[4], aB[4], bB[4]; float wA0, wA1, wB0, wB1, wN0, wN1; int pN0, pN1;
#define P12_POS(m_) do { const int mm_ = (m_) < T ? (m_) : T - 1; pN0 = posg[mm_ * 2]; pN1 = posg[mm_ * 2 + 1]; wN0 = wtsg[mm_ * 2]; wN1 = wtsg[mm_ * 2 + 1]; } while (0)
#define P12_LOAD(H_, A_, B_, W0_, W1_, m_) do { const int mm_ = (m_) < T ? (m_) : T - 1; W0_ = wN0; W1_ = wN1; _Pragma("unroll") for (int j = 0; j < 4; ++j) { H_[j] = *((const GAS v2u*)(xn + (size_t)mm_ * D) + 64 * j + lane); \
        A_[j] = *((const GAS v2u*)(yr + (size_t)pN0 * D) + 64 * j + lane); B_[j] = *((const GAS v2u*)(yr + (size_t)pN1 * D) + 64 * j + lane); } } while (0)
#define P12_PROC(H_, A_, B_, W0_, W1_, m_) do { if ((m_) < T) { f32x4 v[4]; _Pragma("unroll") for (int j = 0; j < 4; ++j) { \
            v[j].x = ALPHA * bflo(H_[j].x) + (W0_ * bflo(A_[j].x) + W1_ * bflo(B_[j].x)); v[j].y = ALPHA * bfhi(H_[j].x) + (W0_ * bfhi(A_[j].x) + W1_ * bfhi(B_[j].x)); \
            v[j].z = ALPHA * bflo(H_[j].y) + (W0_ * bflo(A_[j].y) + W1_ * bflo(B_[j].y)); v[j].w = ALPHA * bfhi(H_[j].y) + (W0_ * bfhi(A_[j].y) + W1_ * bfhi(B_[j].y)); } \
        ln_row(v, P); \
        store_row(v, (dry || l + 1 < DEPTH) ? (float*)nullptr : F.out + (size_t)(m_) * D, (l + 1 < DEPTH && !dry) ? (bf16*)(F.ws + WS_XN) + (size_t)(m_) * D : (bf16*)nullptr, lane); } __builtin_amdgcn_sched_barrier(0); } while (0)
    P12_POS(gw); P12_LOAD(hA, aA, bA, wA0, wA1, gw); P12_POS(gw + NGW); __builtin_amdgcn_sched_barrier(0);
    for (int m = gw; m < T; m += 2 * NGW) {
        P12_LOAD(hB, aB, bB, wB0, wB1, m + NGW); P12_POS(m + 2 * NGW); __builtin_amdgcn_sched_barrier(0);
        P12_PROC(hA, aA, bA, wA0, wA1, m);
        P12_LOAD(hA, aA, bA, wA0, wA1, m + 2 * NGW); P12_POS(m + 3 * NGW); __builtin_amdgcn_sched_barrier(0);
        P12_PROC(hB, aB, bB, wB0, wB1, m + NGW);
    }
#undef P12_POS
#undef P12_LOAD
#undef P12_PROC
}
using pg8::Unit;
struct SchedGrid {
    int nM, nN, G, c;
    __device__ __forceinline__ bool next(int i, Unit& u) const { const int L = i * G + c; if (L >= nM * nN) return false; pg8::map_unit(L, nM, nN, u.pm, u.pn); u.aux = 0; return true; }
};
struct SchedU {
    int G, c;
    __device__ __forceinline__ bool next(int i, Unit& u) const { const int L = i * G + c; if (L >= 3 * 512) return false; u.aux = L >> 9; pg8::map_unit(L & 511, 128, 4, u.pm, u.pn); return true; }
};
struct SchedY {
    int G, c;
    __device__ __forceinline__ bool next(int i, Unit& u) const { const int slot = i / 3, br = i - 3 * slot; const int L = slot * G + c; if (L >= 512) return false; pg8::map_unit(L, 128, 4, u.pm, u.pn); u.aux = br; return true; }
};
struct SchedMoe {
    const LAS int* tabe; int ntiles, G, c;
    __device__ __forceinline__ void a_ready(const Unit&, int, int) const {}
    __device__ __forceinline__ bool unit(int i, Unit& u) const { const int L = i * G + c; if (L >= ntiles * 4) return false; pg8::map_unit(L, ntiles, 4, u.pm, u.pn); return true; }
    __device__ __forceinline__ bool next(int i, Unit& u) const { if (!unit(i, u)) return false; u.aux = __builtin_amdgcn_readfirstlane(tabe[i]); return true; }
};

struct GPlain {
    static constexpr bool GATHER = false;
    const char* a_base; const char* b_base; int K, lda;
    __device__ __forceinline__ const char* a_ptr(const Unit& u) const { return a_base + (size_t)u.pm * 256 * lda * 2; }
    __device__ __forceinline__ const char* b_ptr(const Unit& u) const { return b_base + (size_t)u.pn * 256 * K * 2; }
};
struct GBranch {
    static constexpr bool GATHER = false;
    const char* a_base; const char* b_base; int K, lda;
    __device__ __forceinline__ const char* a_ptr(const Unit& u) const {
        const size_t base = u.aux == 0 ? WS_ODC : u.aux == 1 ? WS_OS : WS_OF;
        return a_base + base + (size_t)u.pm * 256 * 512 * 2;
    }
    __device__ __forceinline__ const char* b_ptr(const Unit& u) const { return b_base + ((size_t)u.aux * 1024 + (size_t)u.pn * 256) * 512 * 2; }
};
struct GGate {
    static constexpr bool GATHER = false;
    const char* a_base; const char* b_base; int K, lda;
    __device__ __forceinline__ const char* a_ptr(const Unit& u) const { return a_base + (size_t)u.pm * 256 * 1024 * 2; }
    __device__ __forceinline__ const char* b_ptr(const Unit& u) const { return b_base + ((size_t)NPROJ + (size_t)u.aux * 1024 + (size_t)u.pn * 256) * 1024 * 2; }
};
struct GMoe1 {
    static constexpr bool GATHER = true;
    const char* a_base; const char* b_base; int K; const LAS int* tab;
    __device__ __forceinline__ unsigned a_off(const Unit&, int ui, int half, int R, int C) const { return (unsigned)tab[ui * 256 + half * 128 + R] * 2048u + (unsigned)C * 2u; }
    __device__ __forceinline__ const char* b_ptr(const Unit& u) const { return b_base + ((size_t)u.aux * 1024 + (size_t)u.pn * 256) * 1024 * 2; }
};
struct GMoe2 {
    static constexpr bool GATHER = false;
    const char* a_base; const char* b_base; int K, lda;
    __device__ __forceinline__ const char* a_ptr(const Unit& u) const { return a_base + (size_t)u.pm * 256 * 512 * 2; }
    __device__ __forceinline__ const char* b_ptr(const Unit& u) const { return b_base + ((size_t)u.aux * 1024 + (size_t)u.pn * 256) * 512 * 2; }
};

typedef const f32x4 (&AccRef)[2][2][4][2];
__device__ __forceinline__ v4u pack8(f32x4 a, f32x4 b) { v4u w; w.x = cvt_pk_bf16(a[0], a[1]); w.y = cvt_pk_bf16(a[2], a[3]); w.z = cvt_pk_bf16(b[0], b[1]); w.w = cvt_pk_bf16(b[2], b[3]); return w; }
__device__ __forceinline__ void rope8(f32x4& a, f32x4& b, const float* cs, const float* sn) {
    const f32x4 c = *(const GAS f32x4*)cs, s = *(const GAS f32x4*)sn;
    const f32x4 a2 = {a[0] * c[0] - a[1] * s[0], a[1] * c[0] + a[0] * s[0], a[2] * c[1] - a[3] * s[1], a[3] * c[1] + a[2] * s[1]};
    const f32x4 b2 = {b[0] * c[2] - b[1] * s[2], b[1] * c[2] + b[0] * s[2], b[2] * c[3] - b[3] * s[3], b[3] * c[3] + b[2] * s[3]};
    a = a2; b = b2;
}
#ifndef PROBE_EPIVAR
#define PROBE_EPIVAR 0
#endif
template <int VAR>
struct EpiProjT {
    unsigned char* ws; const float* bforget;
    __device__ __forceinline__ void operator()(AccRef acc, const Unit& u, int wr, int wc, int fr, int fq) const { asm volatile("" : "+v"(fr), "+v"(fq));
        const float* cs = (const float*)(ws + WS_CS); const float* sn = (const float*)(ws + WS_SN);
        const int pn = u.pn, row0 = u.pm * 256 + wr * 64 + fr, cw = wc * 32 + 8 * fq;
        if (pn < 19) {
            const int grp = pn >> 1;
            const bool rope = (VAR & 1) ? false : ((grp == 0) | (grp == 1) | (grp == 3) | (grp == 4) | (pn == 18));
            const float sc = ((grp == 0) | (grp == 3) | (grp == 6)) ? C2 : 1.f;
            bf16* base = pn < 18 ? (bf16*)(ws + WS_Z + (size_t)grp * ZG) + (pn & 1) * 256 : (bf16*)(ws + WS_IQ);
            const int pitch = pn < 18 ? 512 : 256;
            if (rope) { const int i0 = (cw & 63) >> 1;
                f32x4 cB[8], sB[8];
#pragma unroll
                for (int g = 0; g < 8; ++g) { const size_t ro_ = (size_t)(row0 + (g >> 2) * 128 + (g & 3) * 16) * 32 + i0; if (VAR & 4) { const float f_ = (float)(ro_ & 1023) * 0.001f; cB[g] = (f32x4){f_, f_ + 1.f, f_ + 2.f, f_ + 3.f}; sB[g] = (f32x4){f_ + 4.f, f_ + 5.f, f_ + 6.f, f_ + 7.f}; } else { cB[g] = *(const GAS f32x4*)(cs + ro_); sB[g] = *(const GAS f32x4*)(sn + ro_); } }
#pragma unroll
                for (int g = 0; g < 8; ++g) { const int ai = g >> 2, m = g & 3; const int row = row0 + ai * 128 + m * 16; const f32x4 c = cB[g] * sc, s = sB[g] * sc;
#pragma unroll
                    for (int bj = 0; bj < 2; ++bj) { const int col = bj * 128 + cw; const f32x4 v0 = acc[ai][bj][m][0], v1 = acc[ai][bj][m][1];
                        const f32x4 a2 = {v0[0] * c[0] - v0[1] * s[0], v0[1] * c[0] + v0[0] * s[0], v0[2] * c[1] - v0[3] * s[1], v0[3] * c[1] + v0[2] * s[1]};
                        const f32x4 b2 = {v1[0] * c[2] - v1[1] * s[2], v1[1] * c[2] + v1[0] * s[2], v1[2] * c[3] - v1[3] * s[3], v1[3] * c[3] + v1[2] * s[3]};
                        *(GAS v4u*)(base + (size_t)row * pitch + col) = pack8(a2, b2); } }
            } else {
#pragma unroll
                for (int g = 0; g < 8; ++g) { const int ai = g >> 2, m = g & 3; const int row = row0 + ai * 128 + m * 16;
#pragma unroll
                    for (int bj = 0; bj < 2; ++bj) { const int col = bj * 128 + cw;
                        *(GAS v4u*)(base + (size_t)row * pitch + col) = pack8(acc[ai][bj][m][0] * sc, acc[ai][bj][m][1] * sc); } }
            }
        } else if (!(VAR & 2)) {
            bf16* ik = (bf16*)(ws + WS_IK); float* iw = (float*)(ws + WS_IW); float* lf = (float*)(ws + WS_LF);
            if (cw < 64) { const int i0 = cw >> 1, g_ = cw >> 3; f32x4 cB[8], sB[8];
#pragma unroll
                for (int g = 0; g < 8; ++g) { const size_t ro_ = (size_t)(row0 + (g >> 2) * 128 + (g & 3) * 16) * 32 + i0; cB[g] = *(const GAS f32x4*)(cs + ro_); sB[g] = *(const GAS f32x4*)(sn + ro_); }
#pragma unroll
                for (int g = 0; g < 8; ++g) { const int ai = g >> 2, m = g & 3; const int row = row0 + ai * 128 + m * 16, kk_ = row & 63; const f32x4 c = cB[g], s = sB[g];
                    const f32x4 v0 = acc[ai][0][m][0], v1 = acc[ai][0][m][1];
                    const f32x4 a2 = {v0[0] * c[0] - v0[1] * s[0], v0[1] * c[0] + v0[0] * s[0], v0[2] * c[1] - v0[3] * s[1], v0[3] * c[1] + v0[2] * s[1]};
                    const f32x4 b2 = {v1[0] * c[2] - v1[1] * s[2], v1[1] * c[2] + v1[0] * s[2], v1[2] * c[3] - v1[3] * s[3], v1[3] * c[3] + v1[2] * s[3]};
                    *(GAS v4u*)(ik + (size_t)(row >> 6) * 4096 + (size_t)((((kk_ >> 5) * 4 + (g_ >> 1)) * 64 + (g_ & 1) * 32 + (kk_ & 31)) * 8)) = pack8(a2, b2); }
            } else {
            const f32x4 bf0 = *(const GAS f32x4*)bforget, bf1 = *(const GAS f32x4*)(bforget + 4);
#pragma unroll
            for (int ai = 0; ai < 2; ++ai)
#pragma unroll
                for (int m = 0; m < 4; ++m) { const int row = row0 + ai * 128 + m * 16;
                    const f32x4 v0 = acc[ai][0][m][0], v1 = acc[ai][0][m][1];
                    if (cw == 64) { *(GAS f32x4*)(iw + (size_t)row * 4) = v0 * 0.0625f;
                        f32x4 o;
#pragma unroll
                        for (int j = 0; j < 4; ++j) { const float x = v1[j] + bf0[j]; o[j] = LOG2E * fminf(x, 0.f) - __builtin_amdgcn_logf(1.f + __builtin_amdgcn_exp2f(-LOG2E * fabsf(x))); }
                        *(GAS f32x4*)(lf + (size_t)row * 8) = o; }
                    else if (cw == 72) { f32x4 o;
#pragma unroll
                        for (int j = 0; j < 4; ++j) { const float x = v0[j] + bf1[j]; o[j] = LOG2E * fminf(x, 0.f) - __builtin_amdgcn_logf(1.f + __builtin_amdgcn_exp2f(-LOG2E * fabsf(x))); }
                        *(GAS f32x4*)(lf + (size_t)row * 8 + 4) = o; } }
            }
        }
    }
};
typedef EpiProjT<0> EpiProj;
struct EpiPlain {
    bf16* O; int ldc, aux_cols;
    __device__ __forceinline__ void operator()(AccRef acc, const Unit& u, int wr, int wc, int fr, int fq) const { asm volatile("" : "+v"(fr), "+v"(fq));
        const int row0 = u.pm * 256 + wr * 64 + fr, col0 = u.aux * aux_cols + u.pn * 256 + wc * 32 + 8 * fq;
#pragma unroll
        for (int ai = 0; ai < 2; ++ai)
#pragma unroll
            for (int m = 0; m < 4; ++m) { bf16* rowp = O + (size_t)(row0 + ai * 128 + m * 16) * ldc + col0;
#pragma unroll
                for (int bj = 0; bj < 2; ++bj) *(GAS v4u*)(rowp + bj * 128) = pack8(acc[ai][bj][m][0], acc[ai][bj][m][1]); }
    }
};
struct EpiGate {
    const bf16* U; bf16* Y;
    __device__ __forceinline__ void operator()(AccRef acc, const Unit& u, int wr, int wc, int fr, int fq) const { asm volatile("" : "+v"(fr), "+v"(fq));
        const int row0 = u.pm * 256 + wr * 64 + fr, col0 = u.pn * 256 + wc * 32 + 8 * fq;
        const bool acc_y = u.aux != 0;
        v4u uB[3][2], yB[3][2];
#define EG_LOAD(g_, s_) do { const size_t rw_ = (size_t)(row0 + ((g_) >> 2) * 128 + ((g_) & 3) * 16); _Pragma("unroll") for (int bj = 0; bj < 2; ++bj) { const int col = col0 + bj * 128; \
            uB[s_][bj] = *(const GAS v4u*)(U + rw_ * 3072 + u.aux * 1024 + col); yB[s_][bj] = acc_y ? *(const GAS v4u*)(Y + rw_ * 1024 + col) : (v4u){0u, 0u, 0u, 0u}; } } while (0)
        EG_LOAD(0, 0); EG_LOAD(1, 1);
#pragma unroll
        for (int g = 0; g < 8; ++g) { const int ai = g >> 2, m = g & 3; const size_t row = (size_t)(row0 + ai * 128 + m * 16);
            if (g + 2 < 8) EG_LOAD(g + 2, (g + 2) % 3);
#pragma unroll
            for (int bj = 0; bj < 2; ++bj) { const int col = col0 + bj * 128;
                const v4u uu = uB[g % 3][bj], yy = yB[g % 3][bj];
                f32x4 a = acc[ai][bj][m][0], b = acc[ai][bj][m][1];
#pragma unroll
                for (int j = 0; j < 4; ++j) { a[j] = sigmoidf_(a[j]); b[j] = sigmoidf_(b[j]); }
                a[0] *= bflo(uu.x); a[1] *= bfhi(uu.x); a[2] *= bflo(uu.y); a[3] *= bfhi(uu.y);
                b[0] *= bflo(uu.z); b[1] *= bfhi(uu.z); b[2] *= bflo(uu.w); b[3] *= bfhi(uu.w);
                a[0] += bflo(yy.x); a[1] += bfhi(yy.x); a[2] += bflo(yy.y); a[3] += bfhi(yy.y);
                b[0] += bflo(yy.z); b[1] += bfhi(yy.z); b[2] += bflo(yy.w); b[3] += bfhi(yy.w);
                *(GAS v4u*)(Y + row * 1024 + col) = pack8(a, b); }
            asm volatile("" ::: "memory"); }
#undef EG_LOAD
    }
};
struct EpiResid {
    bf16* R; const bf16* XNp;
    __device__ __forceinline__ void operator()(AccRef acc, const Unit& u, int wr, int wc, int fr, int fq) const { asm volatile("" : "+v"(fr), "+v"(fq));
        const int row0 = u.pm * 256 + wr * 64 + fr, col0 = u.pn * 256 + wc * 32 + 8 * fq;
        v4u xB[3][2];
#define ER_LOAD(g_, s_) do { const size_t ro_ = (size_t)(row0 + ((g_) >> 2) * 128 + ((g_) & 3) * 16) * D + col0; _Pragma("unroll") for (int bj = 0; bj < 2; ++bj) xB[s_][bj] = *(const GAS v4u*)(XNp + ro_ + bj * 128); } while (0)
        ER_LOAD(0, 0); ER_LOAD(1, 1);
#pragma unroll
        for (int g = 0; g < 8; ++g) { const int ai = g >> 2, m = g & 3; const size_t ro = (size_t)(row0 + ai * 128 + m * 16) * D + col0;
            if (g + 2 < 8) ER_LOAD(g + 2, (g + 2) % 3);
#pragma unroll
            for (int bj = 0; bj < 2; ++bj) { const v4u x = xB[g % 3][bj];
                const f32x4 h0 = {bflo(x.x), bfhi(x.x), bflo(x.y), bfhi(x.y)}, h1 = {bflo(x.z), bfhi(x.z), bflo(x.w), bfhi(x.w)};
                *(GAS v4u*)(R + ro + bj * 128) = pack8(h0 * ALPHA + acc[ai][bj][m][0], h1 * ALPHA + acc[ai][bj][m][1]); }
            asm volatile("" ::: "memory"); }
#undef ER_LOAD
    }
};
struct EpiSwiglu {
    bf16* Hd;
    __device__ __forceinline__ void operator()(AccRef acc, const Unit& u, int wr, int wc, int fr, int fq) const { asm volatile("" : "+v"(fr), "+v"(fq));
        const int row0 = u.pm * 256 + wr * 64 + fr, col0 = u.pn * 128 + wc * 32 + 8 * fq;
#pragma unroll
        for (int ai = 0; ai < 2; ++ai)
#pragma unroll
            for (int m = 0; m < 4; ++m) { f32x4 a = acc[ai][0][m][0], b = acc[ai][0][m][1]; const f32x4 ua = acc[ai][1][m][0], ub = acc[ai][1][m][1];
#pragma unroll
                for (int j = 0; j < 4; ++j) { a[j] = a[j] * sigmoidf_(a[j]) * ua[j]; b[j] = b[j] * sigmoidf_(b[j]) * ub[j]; }
                *(GAS v4u*)(Hd + (size_t)(row0 + ai * 128 + m * 16) * DE + col0) = pack8(a, b); }
    }
};
namespace attn_body {
using bf16=__hip_bfloat16;
typedef unsigned long long u64x8 __attribute__((ext_vector_type(8)));
using bf16x8=__attribute__((ext_vector_type(8)))short;
using s16x4=__attribute__((ext_vector_type(4)))short;
using f32x16=__attribute__((ext_vector_type(16)))float;
using u32x4=__attribute__((ext_vector_type(4)))unsigned;
constexpr int SEQ=4096,D=64,DM=512;
constexpr int NW=8,QBLK=32,QB=QBLK*NW,KVBLK=64,NQB=SEQ/QB;
constexpr int ATTN_PITCH=DM, ATTN_UNIT_ROWS=QB;
__device__ __forceinline__ int crow(int r,int hi){return (r&3)+8*(r>>2)+4*hi;}
#define SBAR() __builtin_amdgcn_sched_barrier(0)
__device__ __forceinline__ void cmask(f32x16&p0,f32x16&p1,int jb,int qrel,int hi){
  const float NEG=-INFINITY; int kb=64*jb+4*hi;
  #pragma unroll
  for(int r=0;r<16;++r){int kv=kb+(r&3)+8*(r>>2); if(kv>qrel)p0[r]=NEG; if(kv+32>qrel)p1[r]=NEG;}
}

__device__ __forceinline__ void chunkmask(f32x16&p0,f32x16&p1,int jb,int wid){
  if(jb>(wid>>1)){ const float NEG=-INFINITY;
    #pragma unroll
    for(int r=0;r<16;++r){p0[r]=NEG;p1[r]=NEG;} }
}
constexpr int NSLOT=3, SLOTB=8192;
constexpr int LDS_K=0, LDS_V=NSLOT*SLOTB, LDS_WS=3*NSLOT*SLOTB, LDS_OST=LDS_WS+NW*64*4, LDS_CBT=LDS_OST+NW*4096, LDS_BYTES=LDS_CBT+16384;
constexpr float C2=0.125f*1.4426950408889634f;
__device__ __forceinline__ void glds16(const void*gsrc,unsigned lds_dst){unsigned keep;
  asm volatile("s_mov_b32 %0, m0\n\ts_mov_b32 m0, %2\n\ts_nop 0\n\tglobal_load_lds_dwordx4 %1, off\n\ts_mov_b32 m0, %0":"=&s"(keep):"v"(gsrc),"s"(lds_dst):"memory");}
__device__ __forceinline__ float max3f(float a,float b,float c){float r;asm("v_max3_f32 %0, %1, %2, %3":"=v"(r):"v"(a),"v"(b),"v"(c));return r;}
__device__ __forceinline__ float max2f(float a,float b){float r;asm("v_max_f32_e32 %0, %1, %2":"=v"(r):"v"(a),"v"(b));return r;}
__device__ __forceinline__ float fadd_s(float a,float b){float r;asm("v_add_f32_e32 %0, %1, %2":"=v"(r):"v"(a),"v"(b));return r;}
__device__ __forceinline__ float fsub_s(float a,float b){float r;asm("v_sub_f32_e32 %0, %1, %2":"=v"(r):"v"(a),"v"(b));return r;}
typedef float f32x2_t __attribute__((ext_vector_type(2))); typedef float f32x4_t __attribute__((ext_vector_type(4))); typedef __bf16 bf16x2_t __attribute__((ext_vector_type(2)));
__device__ __forceinline__ unsigned cvtpk_s(float lo,float hi){f32x2_t v={lo,hi};bf16x2_t b=__builtin_convertvector(v,bf16x2_t);return __builtin_bit_cast(unsigned,b);}
#define WAIT_BAR(N) asm volatile("s_waitcnt vmcnt(" #N ") lgkmcnt(0)\n\ts_barrier":::"memory")
#define WAIT_BAR2(N,N2) do{ if(DV2){WAIT_BAR(N2);}else{WAIT_BAR(N);} }while(0)

__device__ __forceinline__ void qkt(f32x16&p0,f32x16&p1,const char*Kslot,const bf16x8*qr,int r32,int hi){ const f32x16 negm=f32x16{};
  const char*kb=Kslot+hi*1024+r32*16;
  #pragma unroll
  for(int d0=0;d0<4;++d0){
    const bf16x8 b0=*reinterpret_cast<const bf16x8*>(kb+d0*2048);
    const bf16x8 b1=*reinterpret_cast<const bf16x8*>(kb+d0*2048+512);
    if(d0==0){p0=__builtin_amdgcn_mfma_f32_32x32x16_bf16(b0,qr[0],negm,0,0,0);p1=__builtin_amdgcn_mfma_f32_32x32x16_bf16(b1,qr[0],negm,0,0,0);}
    else{p0=__builtin_amdgcn_mfma_f32_32x32x16_bf16(b0,qr[d0],p0,0,0,0);p1=__builtin_amdgcn_mfma_f32_32x32x16_bf16(b1,qr[d0],p1,0,0,0);}}
}
typedef __attribute__((address_space(3))) const char* lds_cptr;
typedef short v4i16_t __attribute__((ext_vector_type(4)));
__device__ __forceinline__ void kload8(bf16x8*kf,lds_cptr kp){
  kf[0]=*(const __attribute__((address_space(3))) bf16x8*)(kp);      kf[1]=*(const __attribute__((address_space(3))) bf16x8*)(kp+512);
  kf[2]=*(const __attribute__((address_space(3))) bf16x8*)(kp+2048); kf[3]=*(const __attribute__((address_space(3))) bf16x8*)(kp+2560);
  kf[4]=*(const __attribute__((address_space(3))) bf16x8*)(kp+4096); kf[5]=*(const __attribute__((address_space(3))) bf16x8*)(kp+4608);
  kf[6]=*(const __attribute__((address_space(3))) bf16x8*)(kp+6144); kf[7]=*(const __attribute__((address_space(3))) bf16x8*)(kp+6656);
}
__device__ __forceinline__ void kload2(bf16x8*kf,lds_cptr kp,int j){ kf[2*j]=*(const __attribute__((address_space(3))) bf16x8*)(kp+j*2048); kf[2*j+1]=*(const __attribute__((address_space(3))) bf16x8*)(kp+j*2048+512); }
__device__ __forceinline__ s16x4 vtr(lds_cptr p){ return __builtin_bit_cast(s16x4,__builtin_amdgcn_ds_read_tr16_b64_v4i16((__attribute__((address_space(3))) v4i16_t*)p)); }
__device__ __forceinline__ float rowmax(const f32x16&p0,const f32x16&p1){
  float a=max3f(p0[0],p0[1],p1[0]),b=max3f(p0[2],p0[3],p1[1]);a=max3f(a,p1[2],p1[3]);
  #pragma unroll
  for(int r=4;r<16;r+=4){a=max3f(a,p0[r],p0[r+1]);b=max3f(b,p0[r+2],p0[r+3]);a=max3f(a,p1[r],p1[r+1]);b=max3f(b,p1[r+2],p1[r+3]);}
  const float m=max2f(a,b);
  auto rr=__builtin_amdgcn_permlane32_swap(__float_as_uint(m),__float_as_uint(m),false,false);
  return max2f(__uint_as_float(rr[0]),__uint_as_float(rr[1]));
}
__device__ __forceinline__ void pv(f32x16*o,int vb,bf16x8 pa0,bf16x8 pa1,bf16x8 pa2,bf16x8 pa3){
  #pragma unroll
  for(int d0=0;d0<2;++d0){s16x4 lo[4],hi[4];
    #pragma unroll
    for(int ks=0;ks<4;++ks){
      asm volatile("ds_read_b64_tr_b16 %0,%1 offset:%c2":"=&v"(lo[ks]):"v"(vb),"i"(d0*4096+ks*1024):"memory");
      asm volatile("ds_read_b64_tr_b16 %0,%1 offset:%c2":"=&v"(hi[ks]):"v"(vb),"i"(d0*4096+ks*1024+512):"memory");}
    asm volatile("s_waitcnt lgkmcnt(0)":::"memory");SBAR();
    #define PK(k) (bf16x8){lo[k][0],lo[k][1],lo[k][2],lo[k][3],hi[k][0],hi[k][1],hi[k][2],hi[k][3]}
    o[d0]=__builtin_amdgcn_mfma_f32_32x32x16_bf16(pa0,PK(0),o[d0],0,0,0);
    o[d0]=__builtin_amdgcn_mfma_f32_32x32x16_bf16(pa1,PK(1),o[d0],0,0,0);
    o[d0]=__builtin_amdgcn_mfma_f32_32x32x16_bf16(pa2,PK(2),o[d0],0,0,0);
    o[d0]=__builtin_amdgcn_mfma_f32_32x32x16_bf16(pa3,PK(3),o[d0],0,0,0);
    #undef PK
  }
}

#ifndef ATTN_STORE16
#define ATTN_STORE16(p,v) (*(GAS u32x4*)(p)=(v))
#endif
template<int THRL,int MODE,int PO> __device__ __forceinline__ void attn_unit(int b,int qb,const bf16*Q,const bf16*K,const bf16*V,bf16*O,char*shm,const unsigned long long*masks,int tid){
  constexpr bool DV2=(MODE==0);
  asm volatile("":"+v"(tid));
  const int lane=tid&63,r32=lane&31,hi=lane>>5; const int wid=__builtin_amdgcn_readfirstlane(tid>>6);
  const long rowbase=(long)b*SEQ; const int q0=qb*QB;
  const bf16*Qw=Q+(rowbase+q0+wid*QBLK)*DM;
  const bf16*Kh=K+rowbase*DM,*Vh=V+rowbase*DM;
  const unsigned lds0=(unsigned)(uintptr_t)shm;
  float*wsf=(float*)(shm+LDS_WS)+wid*64;
  const bf16*ksrc=Kh+(long)lane*DM+wid*8;
  const bf16*vsrc=Vh+(long)(16*(wid&3)+(lane>>2))*DM+(wid>>2)*32+(lane&3)*8;
  const unsigned kdst=lds0+LDS_K+wid*1024, vdst=lds0+LDS_V+wid*1024;
  #define DMA_K(t,slot) glds16(ksrc+(long)(t)*KVBLK*DM,(unsigned)__builtin_amdgcn_readfirstlane(kdst+(slot)))
  #define DMA_V(t,slot) do{ glds16(vsrc+(long)(t)*KVBLK*DM,(unsigned)__builtin_amdgcn_readfirstlane(vdst+2*(slot))); \
    if(DV2) glds16(vsrc+64+(long)(t)*KVBLK*DM,(unsigned)__builtin_amdgcn_readfirstlane(vdst+2*(slot)+8192)); }while(0)
  const int vb0=(int)(lds0+LDS_V)+((lane>>4)&1)*32+(lane&3)*8+(4*hi+((lane&15)>>2))*64;
  const char*Kbase=shm+LDS_K; bf16x8 kf[8];
  const lds_cptr shm3=(lds_cptr)shm; const lds_cptr shm3c=shm3; const lds_cptr kp0=shm3+LDS_K+hi*1024+r32*16; const lds_cptr vp0=shm3+LDS_V+((lane>>4)&1)*32+(lane&3)*8+(4*hi+((lane&15)>>2))*64;
  const int NT=(q0+QB)/KVBLK;
  bf16x8 qr[4];
  #pragma unroll
  for(int d0=0;d0<4;++d0)qr[d0]=*(const GAS bf16x8*)(&Qw[(long)r32*DM+d0*16+hi*8]);
  DMA_K(0,0);DMA_V(0,0);DMA_K(1,SLOTB);
  constexpr bool NEGM=(MODE==2);
  float mhat=0.f,l_reg=0.f;f32x16 o[2];o[0]=f32x16{};o[1]=f32x16{};f32x16 o2[2];o2[0]=f32x16{};o2[1]=f32x16{};f32x16 ZERO16=f32x16{}; if(NEGM){asm volatile("":"+v"(ZERO16));}
  const int qrel=wid*QBLK+r32;
  #define CMASK(P0,P1,t) do{ if(MODE!=2){ int jb_=(t)-(NT-4); if(jb_>=0){ if(MODE==0)chunkmask(P0,P1,jb_,wid); else cmask(P0,P1,jb_,qrel,hi);} } }while(0)
  const __attribute__((address_space(3))) float*ctab=(const __attribute__((address_space(3))) float*)(shm3c+LDS_CBT)+4*hi;
  const unsigned long long*mwave=masks+((size_t)(b*(SEQ/32)+(q0>>5)+wid)*(SEQ/64))*32;
  const float NEGINF=-INFINITY;
  #define CND(x,m) asm volatile("v_cndmask_b32_e64 %0, %2, %0, %1":"+v"(x):"s"(m),"v"(NEGINF))
  #define HOOK(P0,P1,t) do{ \
    if(MODE==1){ _Pragma("unroll") for(int g_=0;g_<4;++g_){ const f32x4_t b0_=*(const __attribute__((address_space(3))) f32x4_t*)(ctab+64*(t)+8*g_), b1_=*(const __attribute__((address_space(3))) f32x4_t*)(ctab+64*(t)+8*g_+32); \
        _Pragma("unroll") for(int i_=0;i_<4;i_+=2){ f32x2_t a_={P0[4*g_+i_],P0[4*g_+i_+1]}, c_={P1[4*g_+i_],P1[4*g_+i_+1]}; const f32x2_t x_={b0_[i_],b0_[i_+1]}, y_={b1_[i_],b1_[i_+1]}; a_=a_-x_; c_=c_-y_; \
          P0[4*g_+i_]=a_[0];P0[4*g_+i_+1]=a_[1];P1[4*g_+i_]=c_[0];P1[4*g_+i_+1]=c_[1]; } asm volatile("":::"memory"); } } \
    if(MODE==2){ asm volatile("s_waitcnt lgkmcnt(0)":::"memory"); \
      _Pragma("unroll") for(int r_=0;r_<8;++r_){ CND(P0[r_],mk0_[r_]); CND(P0[8+r_],mk1_[r_]); CND(P1[r_],mk2_[r_]); CND(P1[8+r_],mk3_[r_]); } } }while(0)
  u64x8 mk0_,mk1_,mk2_,mk3_;
  #define HOOK_ISSUE(t) do{ if(MODE==2){ const unsigned long long*mp_=mwave+(size_t)(t)*32; \
      const unsigned lo_=__builtin_amdgcn_readfirstlane((unsigned)(uintptr_t)mp_), hi_=__builtin_amdgcn_readfirstlane((unsigned)((uintptr_t)mp_>>32)); \
      const unsigned long long ma_=((unsigned long long)hi_<<32)|lo_; \
      asm volatile("s_load_dwordx16 %0, %4, 0x0\n\ts_load_dwordx16 %1, %4, 0x40\n\ts_load_dwordx16 %2, %4, 0x80\n\ts_load_dwordx16 %3, %4, 0xc0":"=&s"(mk0_),"=&s"(mk1_),"=&s"(mk2_),"=&s"(mk3_):"s"(ma_):"memory"); } }while(0)
  bool resc=false;
  #define START(P0,P1) do{ const float rm=rowmax(P0,P1); resc=false; \
    { const float dl=__builtin_fmaxf(rm,-256.f); mhat=fadd_s(mhat,dl); \
      _Pragma("unroll") for(int r=0;r<16;++r){P0[r]=fsub_s(P0[r],dl);P1[r]=fsub_s(P1[r],dl);} \
      if(NEGM){ _Pragma("unroll") for(int r=0;r<16;++r)ZERO16[r]=-mhat; asm volatile("":"+v"(ZERO16)); } } \
    _Pragma("unroll") for(int r=0;r<16;++r)P0[r]=__builtin_amdgcn_exp2f(P0[r]); }while(0)
  #define RESC() do{ if(resc){ asm volatile("s_waitcnt lgkmcnt(0)":::"memory"); \
      _Pragma("unroll") for(int d_=0;d_<2;++d_) _Pragma("unroll") for(int r=0;r<16;++r){ const float f_=wsf[crow(r,hi)]; o[d_][r]*=f_; if(DV2)o2[d_][r]*=f_; } } }while(0)
  f32x16 pA0,pA1,pB0,pB1;
  int sl_prev=0,sl_cur=0,sl_next=SLOTB;
  #define ROT() do{sl_prev=sl_cur;sl_cur=sl_next;sl_next=(sl_next==(NSLOT-1)*SLOTB)?0:sl_next+SLOTB;}while(0)
  DMA_K(2,2*SLOTB);
  WAIT_BAR2(3,4);
  HOOK_ISSUE(0); qkt(pA0,pA1,Kbase,qr,r32,hi);asm volatile("s_nop 15\n\ts_nop 7":"+v"(pA0),"+v"(pA1));HOOK(pA0,pA1,0);CMASK(pA0,pA1,0);
  START(pA0,pA1);
  _Pragma("unroll") for(int r=0;r<16;++r)pA1[r]=__builtin_amdgcn_exp2f(pA1[r]);
  WAIT_BAR(0);
  DMA_K(3,0);DMA_V(1,SLOTB);
  ROT();
  kload8(kf,kp0+sl_cur);
  WAIT_BAR2(2,3);
  s16x4 vlo[8],vhi[8]; u32x4 pw0,pw1,pw2,pw3;
  #define PKW(P,B) cvtpk_s(P[B],P[B+1])
  #define PAF(k) __builtin_bit_cast(bf16x8,pw##k)
  #define VFR(i) (bf16x8){vlo[i][0],vlo[i][1],vlo[i][2],vlo[i][3],vhi[i][0],vhi[i][1],vhi[i][2],vhi[i][3]}
  #define PIN(x) asm volatile("":"+v"(x))
  #define MX3(a,b,c) __builtin_fmaxf(__builtin_fmaxf((a),(b)),(c))
  #define GAPA(MF,A0,A1,A2,A3,W0,W1,PW) do{ MF; sacc+=A0; sacc+=A1; sacc+=A2; sacc+=A3; PIN(sacc); W0; W1; PIN(PW); SBAR(); }while(0)
  #define EX(v) __builtin_amdgcn_exp2f(v)
  #define GAPB(MF,X,B) do{ MF; X[B]=EX(X[B]); X[B+1]=EX(X[B+1]); X[B+2]=EX(X[B+2]); X[B+3]=EX(X[B+3]); PIN(X); SBAR(); }while(0)
  #define VRD(i) do{ vlo[i]=vtr(vp_+(((i)>>2)*4096+((i)&3)*1024)); vhi[i]=vtr(vp_+(((i)>>2)*4096+((i)&3)*1024+512)); }while(0)
  #define VRD2(i) do{ vlo[i]=vtr(vp_+8192+(((i)>>2)*4096+((i)&3)*1024)); vhi[i]=vtr(vp_+8192+(((i)>>2)*4096+((i)&3)*1024+512)); }while(0)
  #define KRD(G,j) do{ if(G){ kload2(kf,kp0+sl_next,j); SBAR(); } }while(0)
  #define STEP(C0,C1,P0,P1,t,GK,GV,GL) do{ SBAR(); HOOK_ISSUE(t); \
    const lds_cptr vp_=vp0+2*sl_prev; \
    VRD(0); SBAR(); float sacc=(P0[0]+P0[1]); \
    GAPA(C0=__builtin_amdgcn_mfma_f32_32x32x16_bf16(kf[0],qr[0],ZERO16,0,0,0), P0[2],P0[3],P0[4],P0[5],     pw0[0]=PKW(P0,0), pw0[1]=PKW(P0,2), pw0); \
    VRD(4); SBAR(); GAPA(C1=__builtin_amdgcn_mfma_f32_32x32x16_bf16(kf[1],qr[0],ZERO16,0,0,0), P0[6],P0[7],P0[8],P0[9],     pw0[2]=PKW(P0,4), pw0[3]=PKW(P0,6), pw0); \
    VRD(1); SBAR(); GAPA(C0=__builtin_amdgcn_mfma_f32_32x32x16_bf16(kf[2],qr[1],C0,0,0,0),   P0[10],P0[11],P0[12],P0[13], pw1[0]=PKW(P0,8), pw1[1]=PKW(P0,10), pw1); \
    VRD(5); SBAR(); GAPA(C1=__builtin_amdgcn_mfma_f32_32x32x16_bf16(kf[3],qr[1],C1,0,0,0),   P0[14],P0[15],P1[0],P1[1],   pw1[2]=PKW(P0,12),pw1[3]=PKW(P0,14), pw1); \
    VRD(2); SBAR(); GAPA(C0=__builtin_amdgcn_mfma_f32_32x32x16_bf16(kf[4],qr[2],C0,0,0,0),   P1[2],P1[3],P1[4],P1[5],     pw2[0]=PKW(P1,0), pw2[1]=PKW(P1,2), pw2); \
    VRD(6); SBAR(); GAPA(C1=__builtin_amdgcn_mfma_f32_32x32x16_bf16(kf[5],qr[2],C1,0,0,0),   P1[6],P1[7],P1[8],P1[9],     pw2[2]=PKW(P1,4), pw2[3]=PKW(P1,6), pw2); \
    VRD(3); SBAR(); GAPA(C0=__builtin_amdgcn_mfma_f32_32x32x16_bf16(kf[6],qr[3],C0,0,0,0),   P1[10],P1[11],P1[12],P1[13], pw3[0]=PKW(P1,8), pw3[1]=PKW(P1,10), pw3); \
    VRD(7); SBAR(); GAPA(C1=__builtin_amdgcn_mfma_f32_32x32x16_bf16(kf[7],qr[3],C1,0,0,0),   P1[14],P1[15],0.f,0.f,       pw3[2]=PKW(P1,12),pw3[3]=PKW(P1,14), pw3); \
    l_reg+=sacc; \
    if(GK){DMA_K((t)+3,sl_cur);} if(GV){DMA_V((t)+1,sl_next);} \
    if(!NEGM){ const f32x2_t mh2_={mhat,mhat}; _Pragma("unroll") for(int r=0;r<16;r+=2){ f32x2_t a_={C0[r],C0[r+1]}, b_={C1[r],C1[r+1]}; a_=a_-mh2_; b_=b_-mh2_; C0[r]=a_[0];C0[r+1]=a_[1];C1[r]=b_[0];C1[r+1]=b_[1]; } } \
    if(NEGM&&MODE==2){ asm volatile("s_nop 15\n\ts_nop 7":"+v"(C0),"+v"(C1)); }     \
    HOOK(C0,C1,t); CMASK(C0,C1,t); \
    { float a=MX3(C0[0],C0[1],C1[0]),b=MX3(C0[2],C0[3],C1[1]); a=MX3(a,C1[2],C1[3]); \
      _Pragma("unroll") for(int r=4;r<16;r+=4){a=MX3(a,C0[r],C0[r+1]);b=MX3(b,C0[r+2],C0[r+3]);a=MX3(a,C1[r],C1[r+1]);b=MX3(b,C1[r+2],C1[r+3]);} \
      float rm=__builtin_fmaxf(a,b); { auto rr=__builtin_amdgcn_permlane32_swap(__float_as_uint(rm),__float_as_uint(rm),false,false); rm=__builtin_fmaxf(__uint_as_float(rr[0]),__uint_as_float(rr[1])); } \
      resc=false; \
      if(__builtin_expect(__any(rm>(float)THRL),0)){ const float dl=__builtin_fmaxf(rm,0.f); mhat+=dl; \
        _Pragma("unroll") for(int r=0;r<16;++r){C0[r]-=dl;C1[r]-=dl;} \
        if(NEGM){ _Pragma("unroll") for(int r=0;r<16;++r)ZERO16[r]=-mhat; asm volatile("":"+v"(ZERO16)); } \
        const float f=__builtin_amdgcn_exp2f(-dl); l_reg*=f; if(hi==0)wsf[r32]=f; resc=true; } } \
    SBAR(); \
    GAPB(o[0]=__builtin_amdgcn_mfma_f32_32x32x16_bf16(PAF(0),VFR(0),o[0],0,0,0), C0,0); \
    GAPB(o[1]=__builtin_amdgcn_mfma_f32_32x32x16_bf16(PAF(0),VFR(4),o[1],0,0,0), C0,4); \
    KRD(GL,0); GAPB(o[0]=__builtin_amdgcn_mfma_f32_32x32x16_bf16(PAF(1),VFR(1),o[0],0,0,0), C0,8); \
    KRD(GL,1); GAPB(o[1]=__builtin_amdgcn_mfma_f32_32x32x16_bf16(PAF(1),VFR(5),o[1],0,0,0), C0,12); \
    KRD(GL,2); GAPB(o[0]=__builtin_amdgcn_mfma_f32_32x32x16_bf16(PAF(2),VFR(2),o[0],0,0,0), C1,0); \
    KRD(GL,3); GAPB(o[1]=__builtin_amdgcn_mfma_f32_32x32x16_bf16(PAF(2),VFR(6),o[1],0,0,0), C1,4); \
    GAPB(o[0]=__builtin_amdgcn_mfma_f32_32x32x16_bf16(PAF(3),VFR(3),o[0],0,0,0), C1,8); \
    GAPB(o[1]=__builtin_amdgcn_mfma_f32_32x32x16_bf16(PAF(3),VFR(7),o[1],0,0,0), C1,12); \
    if(DV2){   \
      VRD2(0);VRD2(4);VRD2(1);VRD2(5);VRD2(2);VRD2(6);VRD2(3);VRD2(7); SBAR(); \
      o2[0]=__builtin_amdgcn_mfma_f32_32x32x16_bf16(PAF(0),VFR(0),o2[0],0,0,0); o2[1]=__builtin_amdgcn_mfma_f32_32x32x16_bf16(PAF(0),VFR(4),o2[1],0,0,0); \
      o2[0]=__builtin_amdgcn_mfma_f32_32x32x16_bf16(PAF(1),VFR(1),o2[0],0,0,0); o2[1]=__builtin_amdgcn_mfma_f32_32x32x16_bf16(PAF(1),VFR(5),o2[1],0,0,0); \
      o2[0]=__builtin_amdgcn_mfma_f32_32x32x16_bf16(PAF(2),VFR(2),o2[0],0,0,0); o2[1]=__builtin_amdgcn_mfma_f32_32x32x16_bf16(PAF(2),VFR(6),o2[1],0,0,0); \
      o2[0]=__builtin_amdgcn_mfma_f32_32x32x16_bf16(PAF(3),VFR(3),o2[0],0,0,0); o2[1]=__builtin_amdgcn_mfma_f32_32x32x16_bf16(PAF(3),VFR(7),o2[1],0,0,0); SBAR(); } \
    }while(0)
  int t=1;
  #undef CMASK
  #define CMASK(P0,P1,t) do{}while(0)
  for(;t+5<NT;t+=2){
    STEP(pB0,pB1,pA0,pA1,t,true,true,true);     WAIT_BAR2(2,3); RESC(); ROT();
    STEP(pA0,pA1,pB0,pB1,t+1,true,true,true);   WAIT_BAR2(2,3); RESC(); ROT();
  }
  #undef CMASK
  #define CMASK(P0,P1,t) do{ if(MODE!=2){ int jb_=(t)-(NT-4); if(jb_>=0){ if(MODE==0)chunkmask(P0,P1,jb_,wid); else cmask(P0,P1,jb_,qrel,hi);} } }while(0)
  #define ENDW(tt) do{ if((tt)+3<NT){WAIT_BAR2(2,3);} else if((tt)+2<NT){WAIT_BAR2(1,2);} else {WAIT_BAR(0);} }while(0)
  for(;t+1<NT;t+=2){
    STEP(pB0,pB1,pA0,pA1,t,(t+3<NT),(t+1<NT),(t+1<NT));       ENDW(t);   RESC(); ROT();
    STEP(pA0,pA1,pB0,pB1,t+1,(t+4<NT),(t+2<NT),(t+2<NT));     ENDW(t+1); RESC(); ROT();
  }
  STEP(pB0,pB1,pA0,pA1,NT-1,false,false,false); RESC();
  { float sacc=pB0[0]+pB0[1]; _Pragma("unroll") for(int r=2;r<16;++r)sacc+=pB0[r]; _Pragma("unroll") for(int r=0;r<16;++r)sacc+=pB1[r]; l_reg+=sacc;
    pw0=(u32x4){PKW(pB0,0),PKW(pB0,2),PKW(pB0,4),PKW(pB0,6)};pw1=(u32x4){PKW(pB0,8),PKW(pB0,10),PKW(pB0,12),PKW(pB0,14)};pw2=(u32x4){PKW(pB1,0),PKW(pB1,2),PKW(pB1,4),PKW(pB1,6)};pw3=(u32x4){PKW(pB1,8),PKW(pB1,10),PKW(pB1,12),PKW(pB1,14)};
    SBAR(); pv(o,vb0+2*sl_cur,PAF(0),PAF(1),PAF(2),PAF(3)); if(DV2){ SBAR(); pv(o2,vb0+2*sl_cur+8192,PAF(0),PAF(1),PAF(2),PAF(3)); } }
  #undef PKW
  #undef PAF
  #undef VFR
  #undef PIN
  #undef MX3
  #undef GAPA
  #undef GAPB
  #undef EX
  #undef VRD
  #undef VRD2
  #undef KRD
  #undef STEP
  #undef ENDW
  {auto rr=__builtin_amdgcn_permlane32_swap(__float_as_uint(l_reg),__float_as_uint(l_reg),false,false);l_reg=__uint_as_float(rr[0])+__uint_as_float(rr[1]);}
  if(hi==0)wsf[32+r32]=l_reg;asm volatile("s_waitcnt lgkmcnt(0)":::"memory");
  float rli[16];
  #pragma unroll
  for(int r=0;r<16;++r)rli[r]=__builtin_amdgcn_rcpf(wsf[32+crow(r,hi)]);
  bf16*Ow=O+(rowbase+q0+wid*QBLK)*PO;
  { bf16*stg=(bf16*)(shm+LDS_OST)+wid*2048;
    #pragma unroll
    for(int r=0;r<16;++r){const int orow=crow(r,hi);
      #pragma unroll
      for(int d0=0;d0<2;++d0)stg[orow*64+d0*32+r32]=__float2bfloat16(o[d0][r]*rli[r]);}
    asm volatile("s_waitcnt lgkmcnt(0)":::"memory");
    #pragma unroll
    for(int i=0;i<4;++i){const int row=i*8+(lane>>3),ch=lane&7; const u32x4 v=*(const u32x4*)(stg+row*64+ch*8); ATTN_STORE16(Ow+(long)row*PO+ch*8,v);}
    if(DV2){ asm volatile("s_waitcnt lgkmcnt(0)":::"memory");
      #pragma unroll
      for(int r=0;r<16;++r){const int orow=crow(r,hi);
        #pragma unroll
        for(int d0=0;d0<2;++d0)stg[orow*64+d0*32+r32]=__float2bfloat16(o2[d0][r]*rli[r]);}
      asm volatile("s_waitcnt lgkmcnt(0)":::"memory");
      #pragma unroll
      for(int i=0;i<4;++i){const int row=i*8+(lane>>3),ch=lane&7; const u32x4 v=*(const u32x4*)(stg+row*64+ch*8); ATTN_STORE16(Ow+(long)row*PO+64+ch*8,v);} } }
  asm volatile("s_waitcnt lgkmcnt(0)\n\ts_barrier":::"memory");
  #undef DMA_K
  #undef DMA_V
  #undef CMASK
  #undef HOOK
  #undef HOOK_ISSUE
  #undef CND
  #undef START
  #undef RESC
  #undef ROT
}
constexpr int ATTN_LDS_BYTES=LDS_BYTES;
static_assert(LDS_BYTES <= 131072, "attention scratch fits the 128 KiB phase region");
#undef SBAR
#undef WAIT_BAR
}

__device__ __forceinline__ void attention_phase(Frame& F, char* lds_g, int amask, int l) {
    using namespace attn_body;
    typedef attn_body::bf16 abf;
    const int v = F.vcu, b = v >> 5, j = v & 31;
    unsigned char* ws = F.ws;
#ifndef AMODES
#define AMODES 7
#endif
    if ((AMODES & 1) && (amask & 1)) {
        const int hm = j >> 2, p0 = 2 * (j & 3);
        const abf* Q = (const abf*)(ws + WS_Z) + hm * 64; const abf* K = (const abf*)(ws + WS_Z + ZG) + hm * 64; const abf* V = (const abf*)(ws + WS_Z + 2 * ZG) + (hm >> 1) * 128;
        abf* O = (abf*)(ws + WS_OD) + hm * 128;
        for (int i = 0; i < 4; ++i) { const int p = p0 + (i >> 1), qb = (i & 1) ? p : 15 - p; attn_unit<16, 0, 1024>(b, qb, Q, K, V, O, lds_g, nullptr, F.tid); }
    }
    if ((AMODES & 2) && (amask & 2)) {
        const int h = j >> 2, p0 = 2 * (j & 3);
        const abf* Q = (const abf*)(ws + WS_Z + 3 * ZG) + h * 64; const abf* K = (const abf*)(ws + WS_Z + 4 * ZG) + h * 64; const abf* V = (const abf*)(ws + WS_Z + 5 * ZG) + h * 64;
        abf* O = (abf*)(ws + WS_OS) + h * 64;
        for (int i = 0; i < 4; ++i) { const int p = p0 + (i >> 1), qb = (i & 1) ? p : 15 - p; attn_unit<16, 2, 512>(b, qb, Q, K, V, O, lds_g, (const unsigned long long*)(ws + (l == 0 ? WS_MASK : WS_MASK1)), F.tid); }
    }
    if ((AMODES & 4) && (amask & 4)) {
        const int h = j >> 2, p0 = 2 * (j & 3);
        { LAS float* ct = (LAS float*)(F.lds + RING_OFF + LDS_CBT); const float* cb = (const float*)(ws + WS_CB) + (size_t)(b * 8 + h) * S;
          { float cv_[S / (NWAVES * 64)];
#pragma unroll
            for (int k = 0; k < S / (NWAVES * 64); ++k) cv_[k] = ((const GAS float*)cb)[F.tid + k * NWAVES * 64];
#pragma unroll
            for (int k = 0; k < S / (NWAVES * 64); ++k) ct[F.tid + k * NWAVES * 64] = cv_[k]; }
          __syncthreads(); }
        const abf* Q = (const abf*)(ws + WS_Z + 6 * ZG) + h * 64; const abf* K = (const abf*)(ws + WS_Z + 7 * ZG) + h * 64; const abf* V = (const abf*)(ws + WS_Z + 8 * ZG) + h * 64;
        abf* O = (abf*)(ws + WS_OF) + h * 64;
        for (int i = 0; i < 4; ++i) { const int p = p0 + (i >> 1), qb = (i & 1) ? p : 15 - p; attn_unit<24, 1, 512>(b, qb, Q, K, V, O, lds_g, nullptr, F.tid);   }
    }
}
namespace dsa_sel {
typedef float f32x16 __attribute__((ext_vector_type(16)));
constexpr int HP = 257, CAP = 32;
constexpr int L_HIST = 0, L_PREFIX = 64 * HP * 4, L_KK = L_PREFIX + 256, L_TAU = L_KK + 256, L_NEED = L_TAU + 256, L_TSEL = L_NEED + 256, L_IDXT = L_TSEL + 256, L_FLAG = L_IDXT + 256, L_QF = L_FLAG + 256, L_LCNT = L_QF + 32768, L_LIST = L_LCNT + 256;
__device__ __forceinline__ unsigned f2key(float f) { const unsigned u = __float_as_uint(f); return u ^ ((unsigned)((int)u >> 31) | 0x80000000u); }
__device__ __forceinline__ float relu1(float x) { const int b = __builtin_bit_cast(int, x); return __builtin_bit_cast(float, b > 0 ? b : 0); }
__device__ __forceinline__ int crow(int r, int hi) { return (r & 3) + 8 * (r >> 2) + 4 * hi; }

template <int PM>
__device__ __forceinline__ void sweep(const unsigned short* ikb  , const LAS bf16x8* qfl0  , const f32x4& iw, int ntile, int kq, int lane, int ql  , int qg, int rot_seed,
                                      LAS unsigned* lds32, int shift, unsigned long long* mout  , unsigned inc = 1u) {
    asm volatile("" : "+v"(lane), "+v"(ql));
    const int i32 = lane & 31, hi = lane >> 5;
    const LAS bf16x8* qfl = qfl0 + qg * 1024 + lane;
    LAS unsigned* hist = lds32 + (L_HIST / 4) + ql * HP;
    unsigned prefix = 0, tau = 0, need = 0, tsel = 0, idxt = 0;
    if (PM == 0) prefix = lds32[L_PREFIX / 4 + ql];
    const unsigned pbase = prefix << 8;
    if (PM >= 1 && PM != 4) tau = lds32[L_TAU / 4 + ql];
    if (PM == 4) tau = lds32[L_PREFIX / 4 + ql];
    if (PM == 2) tsel = lds32[L_TSEL / 4 + ql];
    if (PM == 3) idxt = lds32[L_IDXT / 4 + ql];
    (void)need;
    bf16x8 bufA[4], bufB[4];
    const int cnt = (ntile - kq + 3) >> 2;
    const int rot = cnt > 0 ? (int)(((unsigned)rot_seed * 5u) % (unsigned)cnt) : 0;
    if (cnt > 0) {
        const int t0 = kq + 4 * rot;
#pragma unroll
        for (int ds = 0; ds < 4; ++ds) { bufA[ds] = *(const GAS bf16x8*)(ikb + (size_t)t0 * 4096 + (size_t)((ds * 64 + lane) * 8));
                                         bufB[ds] = *(const GAS bf16x8*)(ikb + (size_t)t0 * 4096 + (size_t)(((4 + ds) * 64 + lane) * 8)); }
    }
    for (int k = 0; k < cnt; ++k) {
        int kr = k + rot; if (kr >= cnt) kr -= cnt;
        int kr1 = kr + 1; if (kr1 >= cnt) kr1 -= cnt;
        const int t = kq + 4 * kr, tnext = kq + 4 * kr1; const bool has_next = (k + 1 < cnt);
        unsigned long long mine = 0ull;
#pragma unroll
        for (int kh = 0; kh < 2; ++kh) {
            f32x16 sc;
#pragma unroll
            for (int hp = 0; hp < 2; ++hp) {
                f32x16 a0 = {}, a1 = {};
#pragma unroll
                for (int ds = 0; ds < 4; ++ds) {
                    const bf16x8 kfr = kh == 0 ? bufA[ds] : bufB[ds];
                    a0 = __builtin_amdgcn_mfma_f32_32x32x16_bf16(kfr, qfl[((2 * hp) * 4 + ds) * 64], a0, 0, 0, 0);
                    a1 = __builtin_amdgcn_mfma_f32_32x32x16_bf16(kfr, qfl[((2 * hp + 1) * 4 + ds) * 64], a1, 0, 0, 0);
                }
                if (hp == 1) {
#pragma unroll
                    for (int ds = 0; ds < 4; ++ds) { const bf16x8 nv = *(const GAS bf16x8*)(ikb + (size_t)tnext * 4096 + (size_t)(((kh * 4 + ds) * 64 + lane) * 8)); if (kh == 0) bufA[ds] = nv; else bufB[ds] = nv; }
                    __builtin_amdgcn_sched_barrier(0);
                }
                const float w0 = iw[2 * hp], w1 = iw[2 * hp + 1];
                if (hp == 0) {
#pragma unroll
                    for (int r = 0; r < 16; ++r) sc[r] = fmaf(w1, relu1(a1[r]), fmaf(w0, relu1(a0[r]), 0.0f));
                } else {
#pragma unroll
                    for (int r = 0; r < 16; ++r) sc[r] = fmaf(w1, relu1(a1[r]), fmaf(w0, relu1(a0[r]), sc[r]));
                }
            }
            const unsigned tz = (unsigned)(64 * t + 32 * kh + 4 * hi) << 11;
#pragma unroll
            for (int r = 0; r < 16; ++r) {
                unsigned key = f2key(sc[r]);
                key = (key == 0x80000000u) ? (0x80000000u | ((4095u - (unsigned)((r & 3) + 8 * (r >> 2))) << 11)) - tz : key;
                if (PM == 0) {
                    const unsigned dg = (key >> shift) - pbase;
                    __hip_atomic_fetch_add(hist + (dg < 256u ? dg : 256u), inc, __ATOMIC_RELAXED, __HIP_MEMORY_SCOPE_WORKGROUP);
                } else if (PM == 1) {
                    __hip_atomic_fetch_add(hist + (key == tau ? (unsigned)t : 256u), 1u, __ATOMIC_RELAXED, __HIP_MEMORY_SCOPE_WORKGROUP);
                } else if (PM == 2) {
                    __hip_atomic_fetch_add(hist + ((key == tau && (unsigned)t == tsel) ? (unsigned)(32 * kh + crow(r, hi)) : 256u), 1u, __ATOMIC_RELAXED, __HIP_MEMORY_SCOPE_WORKGROUP);
                } else if (PM == 3) {
                    const unsigned idx = (unsigned)(64 * t + 32 * kh + crow(r, hi));
                    const bool sel = key > tau || (key == tau && idx <= idxt);
                    const unsigned long long bal = __ballot(sel);
                    if (lane == kh * 16 + r) mine = bal;
                } else {
                    const unsigned top = key >> 16;
                    const unsigned long long bal = __ballot(top > tau);
                    if (lane == kh * 16 + r) mine = bal;
                    if (top == tau) {
                        const unsigned slot = __hip_atomic_fetch_add(lds32 + L_LCNT / 4 + ql, 1u, __ATOMIC_RELAXED, __HIP_MEMORY_SCOPE_WORKGROUP);
                        if (slot < (unsigned)CAP) { lds32[L_LIST / 4 + (ql * CAP + slot) * 2] = key; lds32[L_LIST / 4 + (ql * CAP + slot) * 2 + 1] = (unsigned)(64 * t + 32 * kh + crow(r, hi)); }
                    }
                }
            }
        }
        if (PM >= 3) { if (lane < 32) mout[(size_t)t * 32 + lane] = mine; }
    }
}

__device__ __forceinline__ void select_phase(Frame& F, int l) {
    const int tid = F.tid, lane = F.lane, wid = F.wave;
    const int v = F.vcu, b = v >> 5, s = v & 31;
    const int qg = wid & 1, kq = wid >> 1;
    const int rot_seed = (v & 31) + 1;
    LAS unsigned* lds32 = (LAS unsigned*)(F.lds + RING_OFF);
    unsigned char* ws = F.ws;
    const unsigned short* ikb = (const unsigned short*)(ws + WS_IK) + (size_t)b * S * 64;
    unsigned long long* masks = (unsigned long long*)(ws + (l == 0 ? WS_MASK : WS_MASK1));
    for (int uu = 0; uu < 2; ++uu) {
        const int c = uu == 0 ? 63 - s : s;
        const int ntile = c + 1, q0 = c * 64;
        const int ql = 32 * qg + (lane & 31);
        const size_t qrow = (size_t)b * S + q0 + ql;
        unsigned long long* mout = masks + ((size_t)(b * 128 + (q0 >> 5) + qg) * 64) * 32;
        const int tend = 4 * (c >> 2) + 4;
        for (int t = ntile + kq; t < tend; t += 4) { if (lane < 32) mout[(size_t)t * 32 + lane] = 0ull; }
        if (ntile <= 4) {
            for (int t = kq; t < ntile; t += 4) { if (lane < 32) mout[(size_t)t * 32 + lane] = ~0ull; }
            continue;
        }
        f32x4 iw;
        LAS bf16x8* qfl0 = (LAS bf16x8*)((LAS unsigned char*)lds32 + L_QF);
        LAS bf16x8* qfl = qfl0 + qg * 1024 + lane;
        {
            const unsigned short* iq = (const unsigned short*)(ws + WS_IQ) + qrow * 256;
            __syncthreads();
            if (kq == 0) {
                bf16x8 qt[16];
#pragma unroll
                for (int f = 0; f < 16; ++f) qt[f] = *(const GAS bf16x8*)(iq + (f >> 2) * 64 + 16 * (f & 3) + 8 * (lane >> 5));
                asm volatile("s_waitcnt vmcnt(0)" ::: "memory");
#pragma unroll
                for (int f = 0; f < 16; ++f) qfl[f * 64] = qt[f];
            }
            iw = *(const GAS f32x4*)((const float*)(ws + WS_IW) + qrow * 4);
        }
        if (tid < 64) { lds32[L_PREFIX / 4 + tid] = 0u; lds32[L_KK / 4 + tid] = 256u; }
        if (tid == 0) { lds32[L_FLAG / 4] = 0u; lds32[L_FLAG / 4 + 1] = 0u; }
        if (tid < 64) lds32[L_LCNT / 4 + tid] = 0u;
        bool fast = false;
        for (int pass = 0; pass < 4; ++pass) {
            if (pass == 2) {
#ifdef PROBE_FORCE_FAST
                fast = true;
#else
                fast = lds32[L_FLAG / 4 + 1] == 0u;
#endif
#ifdef PROBE_COUNT
                if (tid == 0 && c >= 32) __hip_atomic_fetch_add((unsigned*)(ws + WS_CTL) + 66 + (fast ? 0 : 1), 1u, RLX_AGENT);
#endif
                if (fast) break;
            }
            for (int i = tid; i < 64 * HP; i += NWAVES * 64) lds32[L_HIST / 4 + i] = 0u;
            __syncthreads();
            sweep<0>(ikb, qfl0, iw, ntile, kq, lane, ql, qg, rot_seed, lds32, 24 - 8 * pass, nullptr);
#ifdef PROBE_SWEEP2
            sweep<0>(ikb, qfl0, iw, ntile, kq, lane, ql, qg, rot_seed, lds32, 24 - 8 * pass, nullptr, (unsigned)pass >> 4);
#endif
            __syncthreads();
            for (int qq = 0; qq < 8; ++qq) {
                const int qi = wid * 8 + qq;
                LAS unsigned* hq = lds32 + (L_HIST / 4) + qi * HP;
                const unsigned kk = lds32[L_KK / 4 + qi];
                const unsigned h0 = hq[4 * lane], h1 = hq[4 * lane + 1], h2 = hq[4 * lane + 2], h3 = hq[4 * lane + 3];
                const unsigned own = h0 + h1 + h2 + h3;
                unsigned suf = own;
#pragma unroll
                for (int o = 1; o < 64; o <<= 1) { const unsigned n = __shfl_down(suf, o); if (lane + o < 64) suf += n; }
                const unsigned above = suf - own;
                const bool here = above < kk && suf >= kk;
                if (here) {
                    unsigned cum = above; int d = 4 * lane + 3; unsigned hv = h3;
                    if (cum + hv < kk) { cum += hv; d = 4 * lane + 2; hv = h2; if (cum + hv < kk) { cum += hv; d = 4 * lane + 1; hv = h1; if (cum + hv < kk) { cum += hv; d = 4 * lane; hv = h0; } } }
                    const unsigned np = (lds32[L_PREFIX / 4 + qi] << 8) | (unsigned)d, nk = kk - cum;
                    lds32[L_PREFIX / 4 + qi] = np; lds32[L_KK / 4 + qi] = nk;
                    if (pass == 1 && hv > (unsigned)CAP) __hip_atomic_fetch_or(lds32 + L_FLAG / 4 + 1, 1u, __ATOMIC_RELAXED, __HIP_MEMORY_SCOPE_WORKGROUP);
                    if (pass == 3) { lds32[L_TAU / 4 + qi] = np; lds32[L_NEED / 4 + qi] = nk; lds32[L_IDXT / 4 + qi] = 0xffffu;
                        if (hv != nk) __hip_atomic_fetch_or(lds32 + L_FLAG / 4, 1u, __ATOMIC_RELAXED, __HIP_MEMORY_SCOPE_WORKGROUP); }
                }
            }
            __syncthreads();
        }
        if (fast) {
            sweep<4>(ikb, qfl0, iw, ntile, kq, lane, ql, qg, rot_seed, lds32, 0, mout);
            asm volatile("s_waitcnt vmcnt(0)" ::: "memory");
            __syncthreads();
            unsigned* m32 = (unsigned*)(masks + ((size_t)(b * 128 + (q0 >> 5)) * 64) * 32);
            for (int i = tid; i < 64 * CAP; i += NWAVES * 64) {
                const int qi = i / CAP, ci = i - qi * CAP; const unsigned n = lds32[L_LCNT / 4 + qi];
                if ((unsigned)ci < n) {
                    const LAS unsigned* lst = lds32 + L_LIST / 4 + qi * CAP * 2;
                    const unsigned key = lst[ci * 2], idx = lst[ci * 2 + 1]; unsigned rank = 0;
                    for (unsigned jj = 0; jj < n; ++jj) { const unsigned kj = lst[jj * 2], ij = lst[jj * 2 + 1]; rank += (kj > key || (kj == key && ij < idx)) ? 1u : 0u; }
                    if (rank < lds32[L_KK / 4 + qi]) {
                        const unsigned tl = idx >> 6, ps = idx & 63u, kh = ps >> 5, p5 = ps & 31u, hi = (p5 >> 2) & 1u, r = (p5 & 3u) + 4u * (p5 >> 3);
                        unsigned* w = m32 + ((((size_t)(qi >> 5) * 64 + tl) * 32 + kh * 16 + r) * 2 + hi);
                        __hip_atomic_fetch_or(w, 1u << (qi & 31), RLX_AGENT);
                    }
                }
            }
            __syncthreads();
            continue;
        }
        if (lds32[L_FLAG / 4] != 0u) {
            for (int i = tid; i < 64 * HP; i += NWAVES * 64) lds32[L_HIST / 4 + i] = 0u;
            __syncthreads();
            sweep<1>(ikb, qfl0, iw, ntile, kq, lane, ql, qg, rot_seed, lds32, 0, nullptr);
            __syncthreads();
            if (tid < 64) {
                LAS unsigned* hq = lds32 + (L_HIST / 4) + tid * HP;
                const unsigned need = lds32[L_NEED / 4 + tid]; unsigned cum = 0; int d = 0;
                for (; d < 63; ++d) { const unsigned hv = hq[d]; if (cum + hv >= need) break; cum += hv; }
                lds32[L_TSEL / 4 + tid] = (unsigned)d; lds32[L_NEED / 4 + tid] = need - cum;
            }
            __syncthreads();
            for (int i = tid; i < 64 * HP; i += NWAVES * 64) lds32[L_HIST / 4 + i] = 0u;
            __syncthreads();
            sweep<2>(ikb, qfl0, iw, ntile, kq, lane, ql, qg, rot_seed, lds32, 0, nullptr);
            __syncthreads();
            if (tid < 64) {
                LAS unsigned* hq = lds32 + (L_HIST / 4) + tid * HP;
                const unsigned need = lds32[L_NEED / 4 + tid]; unsigned cum = 0; int d = 0;
                for (; d < 63; ++d) { const unsigned hv = hq[d]; if (cum + hv >= need) break; cum += hv; }
                lds32[L_IDXT / 4 + tid] = lds32[L_TSEL / 4 + tid] * 64u + (unsigned)d;
            }
            __syncthreads();
        }
        sweep<3>(ikb, qfl0, iw, ntile, kq, lane, ql, qg, rot_seed, lds32, 0, mout);
        __syncthreads();
    }
}
}
constexpr int N_PHASES = 1 + 12 * DEPTH;
#ifndef ALIGN_P1
#define ALIGN_P1 true
#endif
#ifndef ALIGN_P6
#define ALIGN_P6 true
#endif
struct Args { const float* in[19]; float* out; unsigned char* ws; int ph_lo, ph_hi, li, amask; };

#ifndef PHMASK
#define PHMASK 0xFFFF
#endif
#ifdef PROBE_BARRIER2
#define PROBE_BAR2(b) xcd_barrier(b)
#else
#define PROBE_BAR2(b) do { } while (0)
#endif
#define IN(k) (lo <= (k) && (k) < hi)
#define INL(j) (((PHMASK >> ((j) + 1)) & 1) && IN(pb + (j)))
#define SEAM(k) do { if (IN(k) && IN((k) + 1)) { XcdBarrier b_; b_.bar = (unsigned*)((gu32*)(ws_a + WS_CTL) + CW_BAR) + li * XCD_BAR_WORDS; b_.x = xb_xcc_id(); b_.tid = (unsigned)F.tid; \
        b_.st = (volatile LAS unsigned*)((LAS unsigned char*)lds + MISC_OFF) + 8; xcd_barrier(b_); PROBE_BAR2(b_); } } while (0)
#define FRESH() do { int l_ = (int)__builtin_amdgcn_mbcnt_hi(~0u, __builtin_amdgcn_mbcnt_lo(~0u, 0u)); asm volatile("" : "+v"(l_)); F.lane = l_; F.wave = wave0; F.tid = wave0 * 64 + l_; \
        { unsigned char* w_ = ws_a; asm volatile("" : "+s"(w_)); F.ws = w_; float* o_ = out_a; asm volatile("" : "+s"(o_)); F.out = o_; } \
        int b_ = blockIdx.x; asm volatile("" : "+s"(b_)); F.G = gridDim.x; F.vcu = (F.G % 8 == 0) ? (b_ % 8) * (F.G / 8) + b_ / 8 : b_; } while (0)
#ifdef PROBE_STAMP
#define STP ((LAS unsigned long long*)((LAS unsigned char*)lds + LDSCTL_OFF + 512))
#define STAMP(j) do { if (blockIdx.x == 0 && F.tid == 0) { const unsigned long long t_ = __builtin_amdgcn_s_memrealtime(); STP[1 + (j)] += t_ - STP[0]; STP[0] = t_; } } while (0)
#else
#define STAMP(j) do { } while (0)
#endif
template <int l>
__device__ __forceinline__ void layer_phases(Frame& F, const int lo, const int hi, const int li, const int amask, unsigned char* const ws_a, float* const out_a, const int wave0, unsigned char* const lds) {
    const int bx = (int)blockIdx.x;
        const int pb = 1 + 12 * l;

        if (INL(0)) { FRESH(); unsigned char* ws = F.ws;
#ifdef PROBE_STAGGER
            if ((bx >> 3) & 1) { for (int i_ = 0; i_ < PROBE_STAGGER; ++i_) __builtin_amdgcn_s_sleep(127); }
#endif
            GPlain g{(const char*)(ws + WS_XN), (const char*)(ws + WS_WIN), D, D};
            SchedGrid Sc{T / 256, NPROJ / 256, F.G, bx};
            EpiProj E{ws, F.in[I_BF] + l * 8};
#ifdef PROBE_EPI1
#if PROBE_EPIVAR > 0
            if (l == 0 && li == 0 && hi == 2) { EpiProjT<PROBE_EPIVAR> Ep{ws, F.in[I_BF] + l * 8}; pg8::gemm_phase<GPlain, EpiProjT<PROBE_EPIVAR>, SchedGrid, ALIGN_P1>(F.lds + RING_OFF, g, Sc, Ep, F.tid); } else
#else
            if (l == 0 && li == 0 && hi == 2) { EpiPlain Ep{(bf16*)(ws + WS_Z), NPROJ, 0}; pg8::gemm_phase<GPlain, EpiPlain, SchedGrid, ALIGN_P1>(F.lds + RING_OFF, g, Sc, Ep, F.tid); } else
#endif
#endif
            pg8::gemm_phase<GPlain, EpiProj, SchedGrid, ALIGN_P1>(F.lds + RING_OFF, g, Sc, E, F.tid);
            SEAM(pb + 0); STAMP(0);
        }
        if (INL(1)) { FRESH();
#ifndef PROBE_NOSCAN
            fox_scan(F);
#endif
#ifndef PROBE_NOSEL
            dsa_sel::select_phase(F, l);
#endif
            SEAM(pb + 1); STAMP(1); }
        if (INL(2)) { FRESH(); attention_phase(F, (char*)lds + RING_OFF, amask, l); SEAM(pb + 2); STAMP(2); }
        if (INL(3)) { FRESH(); diff_combine(F, l); SEAM(pb + 3); STAMP(3); }
        if (INL(4)) { FRESH(); unsigned char* ws = F.ws;
            GBranch g{(const char*)ws, (const char*)(ws + WS_WBR), 512, 512};
            SchedU Sc{F.G, bx};
            EpiPlain E{(bf16*)(ws + WS_U), 3072, 1024};
            pg8::gemm_phase<GBranch, EpiPlain, SchedU, true>(F.lds + RING_OFF, g, Sc, E, F.tid);
            SEAM(pb + 4); STAMP(4);
        }
        if (INL(5)) { FRESH(); unsigned char* ws = F.ws;
            GGate g{(const char*)(ws + WS_XN), (const char*)(ws + WS_WIN), D, D};
            SchedY Sc{F.G, bx};
            EpiGate E{(const bf16*)(ws + WS_U), (bf16*)(ws + WS_Y)};
            pg8::gemm_phase<GGate, EpiGate, SchedY, ALIGN_P6>(F.lds + RING_OFF, g, Sc, E, F.tid);
            SEAM(pb + 5); STAMP(5);
        }
        if (INL(6)) { FRESH(); unsigned char* ws = F.ws;
            GPlain g{(const char*)(ws + WS_Y), (const char*)(ws + WS_WO), D, D};
            SchedGrid Sc{T / 256, D / 256, F.G, bx};
            EpiResid E{(bf16*)(ws + WS_S1), (const bf16*)(ws + WS_XN)};
            pg8::gemm_phase<GPlain, EpiResid, SchedGrid, true>(F.lds + RING_OFF, g, Sc, E, F.tid);
            SEAM(pb + 6); STAMP(6);
        }
        if (INL(7)) { FRESH(); p8_ln1_router(F, l); SEAM(pb + 7); STAMP(7); }
        if (INL(8)) { FRESH(); p9_placement(F); SEAM(pb + 8); STAMP(8); }
        if (INL(9)) { FRESH(); unsigned char* ws = F.ws;
            const int* tile_e = (const int*)(ws + WS_TILEE);
            const int ntiles = __builtin_amdgcn_readfirstlane(__hip_atomic_load(tile_e + NRT_MAX, RLX_AGENT));
            LAS int* tab = (LAS int*)(F.lds + TAB_OFF); LAS int* tabe = (LAS int*)(F.lds + LDSCTL_OFF + 640);
            SchedMoe Sc{tabe, ntiles, F.G, bx};
            { Unit u; const int* row_tok = (const int*)(ws + WS_ROWTOK);
              if (F.tid < 8 && Sc.unit(F.tid, u)) tabe[F.tid] = __hip_atomic_load(tile_e + u.pm, RLX_AGENT);
              int rt_[4]; const int t_ = F.tid & 255, ih_ = F.tid >> 8;
#pragma unroll
              for (int k = 0; k < 4; ++k) { rt_[k] = 0; if (Sc.unit(2 * k + ih_, u)) rt_[k] = *(const GAS int*)(row_tok + u.pm * 256 + t_); }
#pragma unroll
              for (int k = 0; k < 4; ++k) tab[(2 * k + ih_) * 256 + t_] = rt_[k]; }
            __syncthreads();
            GMoe1 g{(const char*)(ws + WS_XN), (const char*)(ws + WS_EW), D, tab};
            EpiSwiglu E{(bf16*)(ws + WS_HID)};
            pg8::gemm_phase<GMoe1, EpiSwiglu, SchedMoe, true>(F.lds + RING_OFF, g, Sc, E, F.tid);
            SEAM(pb + 9); STAMP(9);
        }
        if (INL(10)) { FRESH(); unsigned char* ws = F.ws;
            const int* tile_e = (const int*)(ws + WS_TILEE);
            const int ntiles = __builtin_amdgcn_readfirstlane(__hip_atomic_load(tile_e + NRT_MAX, RLX_AGENT));
            LAS int* tabe = (LAS int*)(F.lds + LDSCTL_OFF + 640);
            SchedMoe Sc{tabe, ntiles, F.G, bx};
            { Unit u; if (F.tid < 8 && Sc.unit(F.tid, u)) tabe[F.tid] = __hip_atomic_load(tile_e + u.pm, RLX_AGENT); }
            __syncthreads();
            GMoe2 g{(const char*)(ws + WS_HID), (const char*)(ws + WS_EWD), DE, DE};
            EpiPlain E{(bf16*)(ws + WS_YR), D, 0};
            pg8::gemm_phase<GMoe2, EpiPlain, SchedMoe, true>(F.lds + RING_OFF, g, Sc, E, F.tid);
            SEAM(pb + 10); STAMP(10);
        }
        if (INL(11)) { FRESH();
#ifdef PROBE_P12
            p12_combine_ln2(F, l, args.li == 0);
#endif
            p12_combine_ln2(F, l); SEAM(pb + 11); STAMP(11); }
}
__global__ void __launch_bounds__(NWAVES * 64, 2) mk_fwd(Args args) {
    extern __shared__ __attribute__((aligned(16))) unsigned char lds[];
    Frame F;
    F.lds = (LAS unsigned char*)lds;
    F.MISC = (volatile LAS unsigned*)(F.lds + MISC_OFF);
    F.tid = threadIdx.x; F.lane = F.tid & 63; F.wave = __builtin_amdgcn_readfirstlane(F.tid >> 6);
    F.G = gridDim.x; { const int bx = blockIdx.x; F.vcu = (F.G % 8 == 0) ? (bx % 8) * (F.G / 8) + bx / 8 : bx; }
    F.ws = args.ws; F.out = args.out; F.in = args.in;
    F.ctl = (gu32*)(F.ws + WS_CTL);
    for (int u = F.tid; u < (LDS_BYTES - LDSCTL_OFF) / 4; u += NWAVES * 64) ((LAS unsigned*)(F.lds + LDSCTL_OFF))[u] = 0u;
    __syncthreads();
    const int wave0 = F.wave;
    (void)xcd_barrier_post((unsigned*)(F.ctl + CW_BAR) + args.li * XCD_BAR_WORDS, F.MISC + 8);
    const int lo = args.ph_lo, hi = args.ph_hi;
    unsigned char* const ws_a = args.ws; float* const out_a = args.out; const int li = args.li;
#ifdef PROBE_STAMP
    if (threadIdx.x == 0) { for (int i = 1; i < 16; ++i) STP[i] = 0ull; STP[0] = __builtin_amdgcn_s_memrealtime(); }
#endif
    if ((PHMASK & 1) && IN(0)) { FRESH(); p0_prologue(F); SEAM(0); STAMP(12); }

    layer_phases<0>(F, lo, hi, li, args.amask, ws_a, out_a, wave0, lds);
    layer_phases<1>(F, lo, hi, li, args.amask, ws_a, out_a, wave0, lds);
    static_assert(DEPTH == 2, "two layer instantiations");
#ifdef PROBE_STAMP
    {
        FRESH();
        if (blockIdx.x == 0 && F.tid == 0) { float sa = 0.f, sb = 0.f;
            for (int j = 0; j < 13; ++j) { const float us = (float)STP[1 + j] * 0.01f; if ((PROBE_SELA >> j) & 1) sa += us; if ((PROBE_SELB >> j) & 1) sb += us; }
#ifdef PROBE_COUNT
            sa = (float)__hip_atomic_load((unsigned*)(F.ws + WS_CTL) + 66, RLX_AGENT); sb = (float)__hip_atomic_load((unsigned*)(F.ws + WS_CTL) + 67, RLX_AGENT);
#endif
            sa = (float)PROBE_Q * floorf(sa / (float)PROBE_Q + 0.5f); sb = (float)PROBE_Q * floorf(sb / (float)PROBE_Q + 0.5f);
            __hip_atomic_store((float*)(F.ws + WS_CTL) + 64, sa, RLX_AGENT); __hip_atomic_store((float*)(F.ws + WS_CTL) + 65, sb, RLX_AGENT); }
        { XcdBarrier b_; b_.bar = (unsigned*)((gu32*)(ws_a + WS_CTL) + CW_BAR) + li * XCD_BAR_WORDS; b_.x = xb_xcc_id(); b_.tid = (unsigned)F.tid; b_.st = (volatile LAS unsigned*)((LAS unsigned char*)lds + MISC_OFF) + 8; xcd_barrier(b_); }
        const float sa = __hip_atomic_load((float*)(F.ws + WS_CTL) + 64, RLX_AGENT), sb = __hip_atomic_load((float*)(F.ws + WS_CTL) + 65, RLX_AGENT);
        for (size_t i = (size_t)blockIdx.x * 512 + F.tid; i < (size_t)T * D; i += (size_t)gridDim.x * 512) F.out[i] = (i == 0) ? sa + sb : sa;
    }
#endif

}

template <int MODE>
__global__ __launch_bounds__(64) void attn_naive_bf(unsigned char* ws, unsigned short* oalt) {
    const int chunk = blockIdx.x, he = blockIdx.y, b = blockIdx.z, lane = threadIdx.x;
    const int t = chunk * 64 + lane; const size_t rowb = (size_t)b * S;
    const bf16 *Q, *K, *V; bf16* O;
    if (MODE == 0) { const int hm = he >> 1, vh = he & 1; Q = (const bf16*)(ws + WS_Z) + hm * 64; K = (const bf16*)(ws + WS_Z + ZG) + hm * 64; V = (const bf16*)(ws + WS_Z + 2 * ZG) + (hm >> 1) * 128 + vh * 64; O = (oalt ? (bf16*)oalt : (bf16*)(ws + WS_OD)) + hm * 128 + vh * 64; }
    else if (MODE == 2) { Q = (const bf16*)(ws + WS_Z + 3 * ZG) + he * 64; K = (const bf16*)(ws + WS_Z + 4 * ZG) + he * 64; V = (const bf16*)(ws + WS_Z + 5 * ZG) + he * 64; O = (oalt ? (bf16*)oalt : (bf16*)(ws + WS_OS)) + he * 64; }
    else { Q = (const bf16*)(ws + WS_Z + 6 * ZG) + he * 64; K = (const bf16*)(ws + WS_Z + 7 * ZG) + he * 64; V = (const bf16*)(ws + WS_Z + 8 * ZG) + he * 64; O = (oalt ? (bf16*)oalt : (bf16*)(ws + WS_OF)) + he * 64; }
    float q[64];
    { const v4u* qp = (const v4u*)(Q + (rowb + t) * 512);
#pragma unroll
      for (int i = 0; i < 8; ++i) { const v4u w = qp[i]; q[8 * i] = bflo(w.x); q[8 * i + 1] = bfhi(w.x); q[8 * i + 2] = bflo(w.y); q[8 * i + 3] = bfhi(w.y); q[8 * i + 4] = bflo(w.z); q[8 * i + 5] = bfhi(w.z); q[8 * i + 6] = bflo(w.w); q[8 * i + 7] = bfhi(w.w); } }
    float acc[64];
#pragma unroll
    for (int i = 0; i < 64; ++i) acc[i] = 0.f;
    float m = -INFINITY, lsum = 0.f;
    const int kend = chunk * 64 + 64;
    const float* cb = (const float*)(ws + WS_CB) + (size_t)(b * 8 + he) * S;
    float cq = 0.f; if (MODE == 1) cq = cb[t];
    const unsigned* mask = (const unsigned*)(ws + (oalt ? WS_MASK1 : WS_MASK)) + (rowb + t) * 128;
    for (int j0 = 0; j0 < kend; j0 += 8) {
        float s[8]; unsigned mw = 0;
        if (MODE == 2) mw = mask[j0 >> 5] >> (j0 & 31);
#pragma unroll
        for (int jj = 0; jj < 8; ++jj) {
            const int j = j0 + jj; const v4u* kr = (const v4u*)(K + (rowb + j) * 512);
            float d = 0.f;
#pragma unroll
            for (int i = 0; i < 8; ++i) { const v4u w = kr[i];
                d = fmaf(q[8 * i], bflo(w.x), d); d = fmaf(q[8 * i + 1], bfhi(w.x), d); d = fmaf(q[8 * i + 2], bflo(w.y), d); d = fmaf(q[8 * i + 3], bfhi(w.y), d);
                d = fmaf(q[8 * i + 4], bflo(w.z), d); d = fmaf(q[8 * i + 5], bfhi(w.z), d); d = fmaf(q[8 * i + 6], bflo(w.w), d); d = fmaf(q[8 * i + 7], bfhi(w.w), d); }
            if (MODE == 1) { d += cq - cb[j]; if (j > t) d = -INFINITY; }
            if (MODE == 2) { if (!((mw >> jj) & 1u)) d = -INFINITY; }
            s[jj] = d;
        }
        float tm = s[0];
#pragma unroll
        for (int jj = 1; jj < 8; ++jj) tm = fmaxf(tm, s[jj]);
        const float mnew = fmaxf(m, tm);
        if (mnew > -INFINITY) {
            const float corr = exp2f(m - mnew);
            lsum *= corr;
#pragma unroll
            for (int i = 0; i < 64; ++i) acc[i] *= corr;
#pragma unroll
            for (int jj = 0; jj < 8; ++jj) {
                const float p = exp2f(s[jj] - mnew); lsum += p;
                const v4u* vr = (const v4u*)(V + (rowb + j0 + jj) * 512);
#pragma unroll
                for (int i = 0; i < 8; ++i) { const v4u w = vr[i];
                    acc[8 * i] = fmaf(p, bflo(w.x), acc[8 * i]); acc[8 * i + 1] = fmaf(p, bfhi(w.x), acc[8 * i + 1]); acc[8 * i + 2] = fmaf(p, bflo(w.y), acc[8 * i + 2]); acc[8 * i + 3] = fmaf(p, bfhi(w.y), acc[8 * i + 3]);
                    acc[8 * i + 4] = fmaf(p, bflo(w.z), acc[8 * i + 4]); acc[8 * i + 5] = fmaf(p, bfhi(w.z), acc[8 * i + 5]); acc[8 * i + 6] = fmaf(p, bflo(w.w), acc[8 * i + 6]); acc[8 * i + 7] = fmaf(p, bfhi(w.w), acc[8 * i + 7]); }
            }
            m = mnew;
        }
    }
    const float rl = 1.f / lsum;
    v4u* op = (v4u*)(O + (rowb + t) * (MODE == 0 ? 1024 : 512));
#pragma unroll
    for (int i = 0; i < 8; ++i) { v4u w; w.x = pk2(acc[8 * i] * rl, acc[8 * i + 1] * rl); w.y = pk2(acc[8 * i + 2] * rl, acc[8 * i + 3] * rl); w.z = pk2(acc[8 * i + 4] * rl, acc[8 * i + 5] * rl); w.w = pk2(acc[8 * i + 6] * rl, acc[8 * i + 7] * rl); op[i] = w; }
}
__device__ __forceinline__ unsigned f2key(float f) {
    unsigned u = __float_as_uint(f);
    if (u == 0x80000000u) u = 0u;
    return (u & 0x80000000u) ? ~u : (u | 0x80000000u);
}
__global__ __launch_bounds__(256) void dsa_naive_select(unsigned char* ws, int alt) {
    __shared__ unsigned keys[S];
    __shared__ float qv[256];
    __shared__ unsigned hist[256];
    __shared__ unsigned sh_prefix, sh_kk;
    __shared__ unsigned seg[256];
    const int qg = blockIdx.x, tid = threadIdx.x, b = qg / S, t = qg % S;
    const int nvis = (t / 64 + 1) * 64;
    qv[tid] = bf2f(((const bf16*)(ws + WS_IQ))[(size_t)qg * 256 + tid]);
    const f32x4 iw = *(const f32x4*)((const float*)(ws + WS_IW) + (size_t)qg * 4);
    __syncthreads();
    for (int j = tid; j < S; j += 256) {
        unsigned key = 0u;
        if (j < nvis) {
            const size_t grow = (size_t)b * S + j; const int kk_ = (int)(grow & 63);
            const bf16* kt = (const bf16*)(ws + WS_IK) + (grow >> 6) * 4096;
            float kv[64];
#pragma unroll
            for (int i = 0; i < 8; ++i) { const v4u w = *(const v4u*)(kt + ((((kk_ >> 5) * 4 + (i >> 1)) * 64 + (i & 1) * 32 + (kk_ & 31)) * 8)); kv[8 * i] = bflo(w.x); kv[8 * i + 1] = bfhi(w.x); kv[8 * i + 2] = bflo(w.y); kv[8 * i + 3] = bfhi(w.y); kv[8 * i + 4] = bflo(w.z); kv[8 * i + 5] = bfhi(w.z); kv[8 * i + 6] = bflo(w.w); kv[8 * i + 7] = bfhi(w.w); }
            float sc = 0.f;
#pragma unroll
            for (int hh = 0; hh < 4; ++hh) { float d = 0.f;
#pragma unroll
                for (int dd = 0; dd < 64; ++dd) d = fmaf(qv[hh * 64 + dd], kv[dd], d);
                sc = fmaf(iw[hh], fmaxf(d, 0.f), sc); }
            key = f2key(sc);
        }
        keys[j] = key;
    }
    __syncthreads();
    unsigned tau = 0, need = 0; const bool all_vis = nvis <= 256;
    if (!all_vis) {
        unsigned prefix = 0, kk = 256;
        for (int pass = 0; pass < 4; ++pass) {
            const int shift = 24 - 8 * pass;
            hist[tid] = 0;
            __syncthreads();
            for (int i = tid; i < nvis; i += 256) { const unsigned k = keys[i]; if (pass == 0 || (k >> (shift + 8)) == prefix) atomicAdd(&hist[(k >> shift) & 255u], 1u); }
            __syncthreads();
            if (tid == 0) { unsigned cum = 0; int d = 255; for (; d > 0; --d) { if (cum + hist[d] >= kk) break; cum += hist[d]; } sh_prefix = (prefix << 8) | (unsigned)d; sh_kk = kk - cum; }
            __syncthreads();
            prefix = sh_prefix; kk = sh_kk;
            __syncthreads();
        }
        tau = prefix; need = kk;
    }
    unsigned eqc = 0;
    if (!all_vis) {
#pragma unroll
        for (int i = 0; i < 16; ++i) { const int idx = tid * 16 + i; if (idx < nvis && keys[idx] == tau) ++eqc; }
    }
    seg[tid] = eqc;
    __syncthreads();
    if (tid == 0) { unsigned run = 0; for (int i = 0; i < 256; ++i) { const unsigned c = seg[i]; seg[i] = run; run += c; } }
    __syncthreads();
    unsigned rank = seg[tid], bits = 0;
#pragma unroll
    for (int i = 0; i < 16; ++i) {
        const int idx = tid * 16 + i; bool sel = false;
        if (idx < nvis) { if (all_vis) sel = true; else { const unsigned k = keys[idx]; if (k > tau) sel = true; else if (k == tau) { sel = rank < need; ++rank; } } }
        bits |= (sel ? 1u : 0u) << i;
    }
    const unsigned other = __shfl_down(bits, 1);
    if ((tid & 1) == 0) ((unsigned*)(ws + (alt ? WS_MASK1 : WS_MASK)))[(size_t)qg * 128 + (tid >> 1)] = bits | (other << 16);
}

#ifdef PROBE_CHECK_DIFF
__global__ void cmp_fill(const unsigned short* ref, const unsigned short* alt, size_t n, unsigned* red) {
    float m = 0.f;
    for (size_t i = (size_t)blockIdx.x * blockDim.x + threadIdx.x; i < n; i += (size_t)gridDim.x * blockDim.x) {
        const float a = bf2f(ref[i]), b = bf2f(alt[i]); m = fmaxf(m, fabsf(a - b)); }
    for (int o = 32; o > 0; o >>= 1) m = fmaxf(m, __shfl_xor(m, o));
    if ((threadIdx.x & 63) == 0) atomicMax(red, __float_as_uint(m));
}
__global__ void fill_out(float* out, const unsigned* red) { const float v = 1000.f * __uint_as_float(*red); for (size_t i = (size_t)blockIdx.x * blockDim.x + threadIdx.x; i < (size_t)T * D; i += (size_t)gridDim.x * blockDim.x) out[i] = v; }
#endif
extern "C" void kernel_launch(void* const* d_in, const int* in_sizes, int n_in, void* d_out, int out_size, void* d_ws, size_t ws_size, hipStream_t stream) {
    static int grid = 0;
    if (grid == 0) {
        if (n_in != 19 || out_size != T * D || ws_size < WS_END) { fprintf(stderr, "kernel_launch: unexpected shapes (n_in %d out %d ws %zu, need %zu); nothing launched\n", n_in, out_size, ws_size, (size_t)WS_END); grid = -1; return; }
        int dev = 0, cus = 0, per_cu = 0;
        if (hipGetDevice(&dev) != hipSuccess || hipDeviceGetAttribute(&cus, hipDeviceAttributeMultiprocessorCount, dev) != hipSuccess) { grid = -1; return; }
        if (hipFuncSetAttribute((const void*)mk_fwd, hipFuncAttributeMaxDynamicSharedMemorySize, LDS_BYTES) != hipSuccess) { fprintf(stderr, "kernel_launch: hipFuncSetAttribute failed\n"); grid = -1; return; }
        if (hipOccupancyMaxActiveBlocksPerMultiprocessor(&per_cu, (const void*)mk_fwd, NWAVES * 64, LDS_BYTES) != hipSuccess || per_cu < 1) { fprintf(stderr, "kernel_launch: occupancy query says %d\n", per_cu); }
        (void)hipGetLastError();
        if (cus < 256) { fprintf(stderr, "kernel_launch: needs 256 CUs, device has %d\n", cus); grid = -1; return; }
        grid = 256;
    }
    if (grid < 0) return;
    if (hipMemsetAsync((char*)d_ws + WS_CTL, 0, CTL_ZERO_BYTES, stream) != hipSuccess) return;
    Args a{};
    for (int i = 0; i < 19; ++i) a.in[i] = (const float*)d_in[i];
    a.out = (float*)d_out; a.ws = (unsigned char*)d_ws;
    unsigned char* ws = (unsigned char*)d_ws;
    a.amask = 7;
    auto run = [&](int lo, int hi, int li) { a.ph_lo = lo; a.ph_hi = hi; a.li = li; hipLaunchKernelGGL(mk_fwd, dim3(grid), dim3(NWAVES * 64), LDS_BYTES, stream, a); };
    auto naive = [&]() {
        hipLaunchKernelGGL(dsa_naive_select, dim3(T), dim3(256), 0, stream, ws, 0);
        hipLaunchKernelGGL(attn_naive_bf<2>, dim3(64, 8, NB), dim3(64), 0, stream, ws, (unsigned short*)nullptr);
    };
    (void)naive;
#ifdef PROBE_CHECK_DIFF
    run(0, 4, 0);
    {   unsigned short* alt = (unsigned short*)d_out; unsigned* red = (unsigned*)(ws + WS_CTL) + 70;
#if PROBE_CHECK_DIFF == 0
        hipLaunchKernelGGL(attn_naive_bf<0>, dim3(64, 16, NB), dim3(64), 0, stream, ws, alt);
        hipLaunchKernelGGL(cmp_fill, dim3(1024), dim3(256), 0, stream, (const unsigned short*)(ws + WS_OD), (const unsigned short*)alt, (size_t)T * 1024, red);
#elif PROBE_CHECK_DIFF == 1
        hipLaunchKernelGGL(attn_naive_bf<1>, dim3(64, 8, NB), dim3(64), 0, stream, ws, alt);
        hipLaunchKernelGGL(cmp_fill, dim3(1024), dim3(256), 0, stream, (const unsigned short*)(ws + WS_OF), (const unsigned short*)alt, (size_t)T * 512, red);
#else
        hipLaunchKernelGGL(dsa_naive_select, dim3(T), dim3(256), 0, stream, ws, 1);
        hipLaunchKernelGGL(attn_naive_bf<2>, dim3(64, 8, NB), dim3(64), 0, stream, ws, alt);
        hipLaunchKernelGGL(cmp_fill, dim3(1024), dim3(256), 0, stream, (const unsigned short*)(ws + WS_OS), (const unsigned short*)alt, (size_t)T * 512, red);
#endif
        hipLaunchKernelGGL(fill_out, dim3(1024), dim3(256), 0, stream, (float*)d_out, red); }
#elif defined(PROBE_K)
    run(0, PROBE_K + 1, 0); run(PROBE_K, N_PHASES, 1);
#else
    run(0, N_PHASES, 0);
#endif
}
```
